# Optimizing an MI355X kernel written in HIP

```python
import math
import jax, jax.numpy as jnp
from jax import lax
import numpy as np

D_MODEL = 1024
BATCH = 4
SEQ = 8192
DEPTH = 1

CHUNK = 64
EPS = 1e-6
FOX_HEADS = 8
FOX_DH = 64
Q_BLOCK = 128
GDN_HEADS = 4
GDN_DK = 128
GDN_DV = 128
CONV_W = 4
PEER_HEADS = 8
N_KEYS = 128
N_EXPERTS = N_KEYS * N_KEYS
PEER_DQ = 256
PEER_TOPK = 16
PEER_BLOCK = 128

FOX_W = FOX_HEADS * FOX_DH
GDN_KW = GDN_HEADS * GDN_DK
GDN_VW = GDN_HEADS * GDN_DV
SPLITS = (FOX_W, FOX_W, FOX_W, FOX_HEADS, GDN_KW, GDN_KW, GDN_VW, GDN_VW, GDN_HEADS, GDN_HEADS, D_MODEL, D_MODEL)
IN_W = sum(SPLITS)

kernel_name = "hybrid_fox_gdn_peer_block"


def rms_norm(x, g):
    xf = x.astype(jnp.float32)
    y = xf * lax.rsqrt(jnp.mean(xf * xf, axis=-1, keepdims=True) + EPS)
    return (y * g.astype(jnp.float32)).astype(x.dtype)


def l2_norm(t):
    tf = t.astype(jnp.float32)
    return tf * lax.rsqrt(jnp.sum(tf * tf, axis=-1, keepdims=True) + EPS)


def forgetting_attention(q, k, v, log_f):
    B, S, H, dh = q.shape
    nb = S // Q_BLOCK
    cum = jnp.cumsum(log_f.astype(jnp.float32), axis=1).transpose(0, 2, 1)
    kh = k.transpose(0, 2, 1, 3)
    vh = v.transpose(0, 2, 1, 3)
    qb = q.reshape(B, nb, Q_BLOCK, H, dh).transpose(1, 0, 3, 2, 4)
    cq = cum.reshape(B, H, nb, Q_BLOCK).transpose(2, 0, 1, 3)
    pos_k = jnp.arange(S)
    scale = dh ** -0.5

    def block(args):
        i, qi, ci = args
        s = jnp.einsum('bhqd,bhkd->bhqk', qi, kh).astype(jnp.float32) * scale
        s = s + ci[..., :, None] - cum[..., None, :]
        pos_q = i * Q_BLOCK + jnp.arange(Q_BLOCK)
        mask = pos_k[None, :] <= pos_q[:, None]
        s = jnp.where(mask, s, -jnp.inf)
        p = jax.nn.softmax(s, axis=-1).astype(vh.dtype)
        return jnp.einsum('bhqk,bhkd->bhqd', p, vh)

    o = lax.map(block, (jnp.arange(nb), qb, cq))
    return o.transpose(1, 0, 3, 2, 4).reshape(B, S, H * dh)


def causal_short_conv(x, w):
    S = x.shape[1]
    xp = jnp.pad(x, ((0, 0), (CONV_W - 1, 0), (0, 0)))
    y = sum(w[i] * xp[:, i:i + S] for i in range(CONV_W))
    return jax.nn.silu(y)


def gated_delta_rule(q, k, v, g, beta):
    B, S, H, dk = q.shape
    dv = v.shape[-1]
    nc = S // CHUNK
    f32 = jnp.float32

    def chunked(t):
        t = t.reshape((B, nc, CHUNK, H) + t.shape[3:])
        return jnp.moveaxis(t, 3, 1)

    q = chunked(q.astype(f32)) * (dk ** -0.5)
    k = chunked(k.astype(f32))
    v = chunked(v.astype(f32))
    g = jnp.cumsum(chunked(g.astype(f32)), axis=-1)
    beta = chunked(beta.astype(f32))
    idx = jnp.arange(CHUNK)
    causal = idx[:, None] >= idx[None, :]
    strict = idx[:, None] > idx[None, :]
    diff = g[..., :, None] - g[..., None, :]
    decay = jnp.where(causal, jnp.exp(jnp.where(causal, diff, 0.0)), 0.0)
    kb = k * beta[..., None]
    L = jnp.where(strict, jnp.einsum('bhnid,bhnjd->bhnij', kb, k) * decay, 0.0)
    A = L + jnp.eye(CHUNK, dtype=f32)
    rhs = jnp.concatenate([v * beta[..., None], kb * jnp.exp(g)[..., None]], axis=-1)
    sol = lax.linalg.triangular_solve(A, rhs, left_side=True, lower=True, unit_diagonal=True)
    u, w = sol[..., :dv], sol[..., dv:]
    attn_intra = jnp.einsum('bhnid,bhnjd->bhnij', q, k) * decay
    q_dec = q * jnp.exp(g)[..., None]
    g_last = g[..., -1]
    k_dec = k * jnp.exp(g_last[..., None] - g)[..., None]
    xs = tuple(jnp.moveaxis(t, 2, 0) for t in (u, w, attn_intra, q_dec, k_dec, g_last))

    def step(state, inp):
        u_c, w_c, a_c, qd_c, kd_c, gl_c = inp
        v_new = u_c - jnp.einsum('bhcd,bhde->bhce', w_c, state)
        o_c = jnp.einsum('bhcd,bhde->bhce', qd_c, state) + jnp.einsum('bhij,bhje->bhie', a_c, v_new)
        state = state * jnp.exp(gl_c)[..., None, None] + jnp.einsum('bhcd,bhce->bhde', kd_c, v_new)
        return state, o_c

    s0 = jnp.zeros((B, H, dk, dv), f32)
    _, o = lax.scan(step, s0, xs)
    o = jnp.moveaxis(o, 0, 2)
    return jnp.moveaxis(o, 1, 3).reshape(B, S, H, dv)


def peer(h, w_query, keys1, keys2, expert_down, expert_up):
    B, S, D = h.shape
    nb = (B * S) // PEER_BLOCK
    xt = h.reshape(nb, PEER_BLOCK, D)

    def block(xb):
        qy = (xb @ w_query).reshape(PEER_BLOCK, PEER_HEADS, 2, PEER_DQ // 2)
        s1 = jnp.einsum('thd,kd->thk', qy[:, :, 0], keys1).astype(jnp.float32)
        s2 = jnp.einsum('thd,kd->thk', qy[:, :, 1], keys2).astype(jnp.float32)
        v1, i1 = lax.top_k(s1, PEER_TOPK)
        v2, i2 = lax.top_k(s2, PEER_TOPK)
        cand = (v1[..., :, None] + v2[..., None, :]).reshape(PEER_BLOCK, PEER_HEADS, PEER_TOPK * PEER_TOPK)
        cidx = (i1[..., :, None] * N_KEYS + i2[..., None, :]).reshape(PEER_BLOCK, PEER_HEADS, PEER_TOPK * PEER_TOPK)
        top_s, pos = lax.top_k(cand, PEER_TOPK)
        eidx = jnp.take_along_axis(cidx, pos, axis=-1)
        gates = jax.nn.softmax(top_s, axis=-1)
        u = expert_down[eidx]
        act = jax.nn.gelu(jnp.einsum('td,thkd->thk', xb, u).astype(jnp.float32), approximate=False)
        ve = expert_up[eidx]
        return jnp.einsum('thk,thkd->td', (gates * act).astype(xb.dtype), ve)

    return lax.map(block, xt).reshape(B, S, D)


def setup_inputs(seed: int = 0) -> dict:
    key = jax.random.key(seed)
    ks = jax.random.split(key, 24)
    f32 = jnp.float32
    D = D_MODEL

    def nrm(k, shape, scale):
        return jax.random.normal(k, shape, f32) * scale

    def gain(k, shape):
        return 1.0 + 0.01 * jax.random.normal(k, shape, f32)

    dt = jnp.exp(jax.random.uniform(ks[9], (DEPTH, GDN_HEADS), f32, math.log(1e-3), math.log(0.1)))
    return {
        "x": nrm(ks[0], (BATCH, SEQ, D), 1.0),
        "c": nrm(ks[1], (BATCH, D), 1.0),
        "w_ada": nrm(ks[2], (DEPTH, D, 6 * D), 0.5 * D ** -0.5),
        "b_ada": nrm(ks[3], (DEPTH, 6 * D), 0.02),
        "g_pre_mix": gain(ks[4], (DEPTH, D)),
        "g_post_mix": gain(ks[5], (DEPTH, D)),
        "w_in": nrm(ks[6], (DEPTH, D, IN_W), D ** -0.5),
        "b_fgate": 3.0 + 0.1 * jax.random.normal(ks[7], (DEPTH, FOX_HEADS), f32),
        "fox_w_o": nrm(ks[8], (DEPTH, FOX_W, D), FOX_W ** -0.5),
        "conv_w": nrm(ks[10], (DEPTH, CONV_W, 2 * GDN_KW + GDN_VW), CONV_W ** -0.5),
        "a_log": jnp.log(jax.random.uniform(ks[11], (DEPTH, GDN_HEADS), f32, 1.0, 16.0)),
        "dt_bias": dt + jnp.log(-jnp.expm1(-dt)),
        "gdn_norm_w": gain(ks[12], (DEPTH, GDN_DV)),
        "gdn_w_o": nrm(ks[13], (DEPTH, GDN_VW, D), GDN_VW ** -0.5),
        "b_branch_gate": nrm(ks[14], (DEPTH, 2, D), 0.02),
        "w_out": nrm(ks[15], (DEPTH, D, D), D ** -0.5),
        "g_pre_ffn": gain(ks[16], (DEPTH, D)),
        "g_post_ffn": gain(ks[17], (DEPTH, D)),
        "peer_w_query": nrm(ks[18], (DEPTH, D, PEER_HEADS * PEER_DQ), D ** -0.5),
        "peer_keys1": nrm(ks[19], (DEPTH, N_KEYS, PEER_DQ // 2), (PEER_DQ // 2) ** -0.5),
        "peer_keys2": nrm(ks[20], (DEPTH, N_KEYS, PEER_DQ // 2), (PEER_DQ // 2) ** -0.5),
        "peer_u": nrm(ks[21], (DEPTH, N_EXPERTS, D), D ** -0.5),
        "peer_v": nrm(ks[22], (DEPTH, N_EXPERTS, D), D ** -0.5),
    }


def reference(x, c, w_ada, b_ada, g_pre_mix, g_post_mix, w_in, b_fgate, fox_w_o, conv_w, a_log,
              dt_bias, gdn_norm_w, gdn_w_o, b_branch_gate, w_out, g_pre_ffn, g_post_ffn,
              peer_w_query, peer_keys1, peer_keys2, peer_u, peer_v):
    B, S, D = x.shape
    split_idx = np.cumsum(SPLITS)[:-1].tolist()
    for l in range(DEPTH):
        mod = jax.nn.silu(c) @ w_ada[l] + b_ada[l]
        sh1, sc1, gt1, sh2, sc2, gt2 = [m[:, None, :] for m in jnp.split(mod, 6, axis=-1)]

        h = rms_norm(x, g_pre_mix[l]) * (1.0 + sc1) + sh1
        proj = h @ w_in[l]
        fq, fk, fv, f_logit, gq, gk, gv, gz, b_logit, a_logit, ga, gb = jnp.split(proj, split_idx, axis=-1)

        log_f = jax.nn.log_sigmoid((f_logit + b_fgate[l]).astype(jnp.float32))
        ya = forgetting_attention(fq.reshape(B, S, FOX_HEADS, FOX_DH),
                                  fk.reshape(B, S, FOX_HEADS, FOX_DH),
                                  fv.reshape(B, S, FOX_HEADS, FOX_DH), log_f)
        ya = ya @ fox_w_o[l]

        qkv = causal_short_conv(jnp.concatenate([gq, gk, gv], axis=-1), conv_w[l])
        cq, ck, cv = jnp.split(qkv, [GDN_KW, 2 * GDN_KW], axis=-1)
        q_b = l2_norm(cq.reshape(B, S, GDN_HEADS, GDN_DK))
        k_b = l2_norm(ck.reshape(B, S, GDN_HEADS, GDN_DK))
        v_b = cv.reshape(B, S, GDN_HEADS, GDN_DV)
        beta = jax.nn.sigmoid(b_logit.astype(jnp.float32))
        g_dec = -jnp.exp(a_log[l].astype(jnp.float32)) * jax.nn.softplus((a_logit + dt_bias[l]).astype(jnp.float32))
        ob = gated_delta_rule(q_b, k_b, v_b, g_dec, beta)
        ob = rms_norm(ob, gdn_norm_w[l]) * jax.nn.silu(gz.reshape(B, S, GDN_HEADS, GDN_DV).astype(jnp.float32))
        yb = ob.reshape(B, S, GDN_VW).astype(x.dtype) @ gdn_w_o[l]

        gate_a = jax.nn.sigmoid(ga + b_branch_gate[l, 0])
        gate_b = jax.nn.sigmoid(gb + b_branch_gate[l, 1])
        mix = (gate_a * ya + gate_b * yb) @ w_out[l]
        x = x + gt1 * rms_norm(mix, g_post_mix[l])

        h2 = rms_norm(x, g_pre_ffn[l]) * (1.0 + sc2) + sh2
        y2 = peer(h2, peer_w_query[l], peer_keys1[l], peer_keys2[l], peer_u[l], peer_v[l])
        x = x + gt2 * rms_norm(y2, g_post_ffn[l])
    return x
```

```cpp
#include <hip/hip_runtime.h>
#include <hip/hip_cooperative_groups.h>
#include <stdint.h>
#include <math.h>
#include <cstdio>

#define DI __device__ __forceinline__
#define LAS __attribute__((address_space(3)))
typedef unsigned short bf16_t;
typedef short bf16x8 __attribute__((ext_vector_type(8)));
typedef short s16x4 __attribute__((ext_vector_type(4)));
typedef float f32x4 __attribute__((ext_vector_type(4)));
typedef float f32x16 __attribute__((ext_vector_type(16)));
typedef float f32x2 __attribute__((ext_vector_type(2)));
typedef unsigned u32x4 __attribute__((ext_vector_type(4)));
typedef unsigned u32x2 __attribute__((ext_vector_type(2)));
typedef __bf16 bf16x2_t __attribute__((ext_vector_type(2)));

constexpr int NT = 256;
constexpr int T_ = 32768, S_ = 8192;
constexpr int PP = 5632;
constexpr int NPAD = 5760;
constexpr float LOG2E = 1.4426950408889634f;
constexpr size_t MiB = 1u << 20;

constexpr size_t WS_MOD = 1 * MiB;
constexpr size_t WS_WIN = 2 * MiB;
constexpr size_t WS_WFO = 14 * MiB;
constexpr size_t WS_WGO = 15 * MiB;
constexpr size_t WS_WOUT = 16 * MiB;
constexpr size_t WS_WQ = 18 * MiB;
constexpr size_t WS_KEYS = 22 * MiB;
constexpr size_t WS_SMALL = 23 * MiB;
constexpr size_t WS_FNEG = 25 * MiB;
constexpr size_t WS_GL = 26 * MiB;
constexpr size_t WS_H = 32 * MiB;
constexpr size_t WS_P = 96 * MiB;
constexpr size_t WS_UF = 448 * MiB;
constexpr size_t WS_WF = 480 * MiB;
constexpr size_t WS_QY = 96 * MiB;
constexpr size_t WS_PU = 224 * MiB;
constexpr size_t WS_PV = 256 * MiB;
constexpr size_t WS_EIDX = 288 * MiB;
constexpr size_t WS_GATE = 304 * MiB;

DI unsigned pk2(float lo, float hi) { f32x2 v = {lo, hi}; bf16x2_t b = __builtin_convertvector(v, bf16x2_t); return __builtin_bit_cast(unsigned, b); }
DI bf16_t f2bf(float x) { return (bf16_t)(pk2(x, 0.f) & 0xffffu); }
DI float bf2f(bf16_t v) { return __uint_as_float(((unsigned)v) << 16); }
DI float bflo(unsigned u) { return __uint_as_float(u << 16); }
DI float bfhi(unsigned u) { return __uint_as_float(u & 0xffff0000u); }
DI float wave_sum(float v) {
#pragma unroll
  for (int d = 32; d >= 1; d >>= 1) v += __shfl_xor(v, d);
  return v;
}
DI unsigned wave_max_u(unsigned v) {
#pragma unroll
  for (int d = 32; d >= 1; d >>= 1) { unsigned o = (unsigned)__shfl_xor((int)v, d); v = o > v ? o : v; }
  return v;
}
DI float sigmoidf_(float x) { return 1.f / (1.f + __expf(-x)); }
DI float softplusf_(float x) { return fmaxf(x, 0.f) + log1pf(__expf(-fabsf(x))); }
DI int crow(int r, int hi) { return (r & 3) + 8 * (r >> 2) + 4 * hi; }
#define MFMA16(a, b, c) __builtin_amdgcn_mfma_f32_16x16x32_bf16((a), (b), (c), 0, 0, 0)
#define MFMA32(a, b, c) __builtin_amdgcn_mfma_f32_32x32x16_bf16((a), (b), (c), 0, 0, 0)
DI s16x4 tr16(const LAS char* p) { typedef short v4i16_t __attribute__((ext_vector_type(4))); return __builtin_bit_cast(s16x4, __builtin_amdgcn_ds_read_tr16_b64_v4i16((LAS v4i16_t*)p)); }
DI bf16x8 cat8(s16x4 lo, s16x4 hi) { return __builtin_shufflevector(lo, hi, 0, 1, 2, 3, 4, 5, 6, 7); }
DI bf16x8 pack8(float a0, float a1, float a2, float a3, float a4, float a5, float a6, float a7) {
  u32x4 p = {pk2(a0, a1), pk2(a2, a3), pk2(a4, a5), pk2(a6, a7)}; return __builtin_bit_cast(bf16x8, p);
}

struct Params {
  const float *x, *c, *w_ada, *b_ada, *g_pre_mix, *g_post_mix, *w_in, *b_fgate, *fox_w_o, *conv_w, *a_log, *dt_bias, *gdn_norm_w, *gdn_w_o,
      *b_branch_gate, *w_out, *g_pre_ffn, *g_post_ffn, *peer_w_query, *peer_keys1, *peer_keys2, *peer_u, *peer_v;
  float* out; char* ws;
};

DI void phase_mod(const Params& p, int bid, int nb, char* lds) {
  float* sc = (float*)lds;
  float* part = sc + 4096;
  const int tid = threadIdx.x;
  for (int i = tid; i < 4096; i += NT) { float v = p.c[i]; sc[i] = v / (1.f + __expf(-v)); }
  __syncthreads();
  float* mod = (float*)(p.ws + WS_MOD);
  for (int g = bid; g < 96; g += nb) {
    const int cc = tid & 63, kg = tid >> 6, col = g * 64 + cc;
    float a0 = 0.f, a1 = 0.f, a2 = 0.f, a3 = 0.f;
#pragma unroll 8
    for (int k = kg; k < 1024; k += 4) { const float w = p.w_ada[(size_t)k * 6144 + col]; a0 += sc[k] * w; a1 += sc[1024 + k] * w; a2 += sc[2048 + k] * w; a3 += sc[3072 + k] * w; }
    part[(kg * 4 + 0) * 64 + cc] = a0; part[(kg * 4 + 1) * 64 + cc] = a1; part[(kg * 4 + 2) * 64 + cc] = a2; part[(kg * 4 + 3) * 64 + cc] = a3;
    __syncthreads();
    { const int b = tid >> 6; float s = part[(0 * 4 + b) * 64 + cc] + part[(1 * 4 + b) * 64 + cc] + part[(2 * 4 + b) * 64 + cc] + part[(3 * 4 + b) * 64 + cc];
      mod[b * 6144 + col] = s + p.b_ada[col]; }
    __syncthreads();
  }
}

DI int inproj_colmap(int n) {
  if (n < 1536) return n;
  if (n < 3584) return 1544 + (n - 1536);
  if (n < 5632) return 3600 + (n - 3584);
  if (n < 5640) return 1536 + (n - 5632);
  if (n < 5648) return 3592 + (n - 5640);
  return -1;
}
DI void transpose_tile(const float* src, int ldsrc, bf16_t* dst, int K, int n0, int k0, bool permute, float* tile) {
  const int tid = threadIdx.x, tx = tid & 63, ty = tid >> 6;
  const int n = n0 + tx; const int oc = permute ? inproj_colmap(n) : n;
#pragma unroll 4
  for (int i = 0; i < 16; ++i) { const int ky = ty + 4 * i; tile[ky * 65 + tx] = (oc >= 0) ? src[(size_t)(k0 + ky) * ldsrc + oc] : 0.f; }
  __syncthreads();
#pragma unroll 4
  for (int i = 0; i < 16; ++i) { const int ny = ty + 4 * i; dst[(size_t)(n0 + ny) * K + k0 + tx] = f2bf(tile[tx * 65 + ny]); }
  __syncthreads();
}
DI void phase_wconv(const Params& p, int bid, int nb, char* lds) {
  float* tile = (float*)lds;
  for (int t = bid; t < 2464; t += nb) {
    if (t < 1440) transpose_tile(p.w_in, 5648, (bf16_t*)(p.ws + WS_WIN), 1024, (t / 16) * 64, (t % 16) * 64, true, tile);
    else if (t < 1568) { const int u = t - 1440; transpose_tile(p.fox_w_o, 1024, (bf16_t*)(p.ws + WS_WFO), 512, (u / 8) * 64, (u % 8) * 64, false, tile); }
    else if (t < 1696) { const int u = t - 1568; transpose_tile(p.gdn_w_o, 1024, (bf16_t*)(p.ws + WS_WGO), 512, (u / 8) * 64, (u % 8) * 64, false, tile); }
    else if (t < 1952) { const int u = t - 1696; transpose_tile(p.w_out, 1024, (bf16_t*)(p.ws + WS_WOUT), 1024, (u / 16) * 64, (u % 16) * 64, false, tile); }
    else { const int u = t - 1952; transpose_tile(p.peer_w_query, 2048, (bf16_t*)(p.ws + WS_WQ), 1024, (u / 16) * 64, (u % 16) * 64, false, tile); }
  }
  bf16_t* kd = (bf16_t*)(p.ws + WS_KEYS);
  for (int i = bid * NT + threadIdx.x; i < 32768; i += nb * NT) kd[i] = f2bf(i < 16384 ? p.peer_keys1[i] : p.peer_keys2[i - 16384]);
}
DI void phase_tabconv(const Params& p, int bid, int nb) {
  const size_t n8 = (size_t)16384 * 1024 / 8;
  for (size_t i = (size_t)bid * NT + threadIdx.x; i < 2 * n8; i += (size_t)nb * NT) {
    const bool second = i >= n8; const size_t j = second ? i - n8 : i;
    const float* src = (second ? p.peer_v : p.peer_u) + j * 8;
    const f32x4 a = *(const f32x4*)src, b = *(const f32x4*)(src + 4);
    u32x4 o = {pk2(a[0], a[1]), pk2(a[2], a[3]), pk2(b[0], b[1]), pk2(b[2], b[3])};
    *(u32x4*)(p.ws + (second ? WS_PV : WS_PU) + j * 16) = o;
  }
}

DI void phase_xnorm(const Params& p, int bid, int nb) {
  const int lane = threadIdx.x & 63, gw = bid * 4 + (threadIdx.x >> 6), nw = nb * 4;
  const float* mod = (const float*)(p.ws + WS_MOD);
  bf16_t* h = (bf16_t*)(p.ws + WS_H);
  for (int row = gw; row < T_; row += nw) {
    const int b = row >> 13;
    const f32x4* xr = (const f32x4*)(p.x + (size_t)row * 1024);
    f32x4 v[4]; float ss = 0.f;
#pragma unroll
    for (int i = 0; i < 4; ++i) { v[i] = xr[lane + 64 * i]; ss += v[i][0] * v[i][0] + v[i][1] * v[i][1] + v[i][2] * v[i][2] + v[i][3] * v[i][3]; }
    ss = wave_sum(ss);
    const float rstd = rsqrtf(ss * (1.f / 1024.f) + 1e-6f);
#pragma unroll
    for (int i = 0; i < 4; ++i) {
      const int col = 4 * lane + 256 * i;
      const f32x4 g4 = *(const f32x4*)(p.g_pre_mix + col), sh = *(const f32x4*)(mod + b * 6144 + col), sc = *(const f32x4*)(mod + b * 6144 + 1024 + col);
      const f32x4 y = (v[i] * rstd * g4) * (1.f + sc) + sh;
      u32x2 o = {pk2(y[0], y[1]), pk2(y[2], y[3])};
      *(u32x2*)(h + (size_t)row * 1024 + col) = o;
    }
  }
}

struct GemmArgs { const bf16_t* A; int lda; const bf16_t* Bt; int ldb; int K; };
DI int swz(int row, int c) { return row * 128 + ((c ^ ((row >> 1) & 7)) << 4); }
template <class Epi>
DI void gemm_tile(const GemmArgs& g, int m0, int n0, char* lds, const Epi& epi) {
  const int tid = threadIdx.x, lane = tid & 63, wid = tid >> 6, wr = wid >> 1, wc = wid & 1, fr = lane & 15, fq = lane >> 4;
  char* As = lds; char* Bs = lds + 16384;
  f32x4 acc[4][4];
#pragma unroll
  for (int i = 0; i < 4; ++i)
#pragma unroll
    for (int j = 0; j < 4; ++j) acc[i][j] = (f32x4){0.f, 0.f, 0.f, 0.f};
  const int srow = tid >> 3, sc = tid & 7;
  const bf16_t* ag = g.A + (size_t)(m0 + srow) * g.lda + sc * 8;
  const bf16_t* bg = g.Bt + (size_t)(n0 + srow) * g.ldb + sc * 8;
  u32x4 ra[4], rb[4];
#pragma unroll
  for (int i = 0; i < 4; ++i) { ra[i] = *(const u32x4*)(ag + (size_t)(32 * i) * g.lda); rb[i] = *(const u32x4*)(bg + (size_t)(32 * i) * g.ldb); }
  const int nk = g.K / 64;
  for (int kt = 0; kt < nk; ++kt) {
    __syncthreads();
#pragma unroll
    for (int i = 0; i < 4; ++i) { const int off = swz(srow + 32 * i, sc); *(u32x4*)(As + off) = ra[i]; *(u32x4*)(Bs + off) = rb[i]; }
    __syncthreads();
    if (kt + 1 < nk) {
#pragma unroll
      for (int i = 0; i < 4; ++i) { ra[i] = *(const u32x4*)(ag + (size_t)(32 * i) * g.lda + (kt + 1) * 64); rb[i] = *(const u32x4*)(bg + (size_t)(32 * i) * g.ldb + (kt + 1) * 64); }
    }
#pragma unroll
    for (int kk = 0; kk < 2; ++kk) {
      bf16x8 af[4], bfm[4];
#pragma unroll
      for (int i = 0; i < 4; ++i) { af[i] = *(const bf16x8*)(As + swz(wr * 64 + i * 16 + fr, kk * 4 + fq)); bfm[i] = *(const bf16x8*)(Bs + swz(wc * 64 + i * 16 + fr, kk * 4 + fq)); }
#pragma unroll
      for (int i = 0; i < 4; ++i)
#pragma unroll
        for (int j = 0; j < 4; ++j) acc[i][j] = MFMA16(bfm[j], af[i], acc[i][j]);
    }
  }
#pragma unroll
  for (int i = 0; i < 4; ++i)
#pragma unroll
    for (int j = 0; j < 4; ++j) epi(m0 + wr * 64 + i * 16 + fr, n0 + wc * 64 + j * 16 + 4 * fq, acc[i][j]);
}

struct EpiInproj {
  bf16_t* proj; float* small; const float *bbg, *b_fgate, *a_log, *dt_bias;
  DI void operator()(int row, int col, f32x4 v) const {
    if (col < 3584) { u32x2 o = {pk2(v[0], v[1]), pk2(v[2], v[3])}; *(u32x2*)(proj + (size_t)row * PP + col) = o; }
    else if (col < 5632) {
      const f32x4 b = *(const f32x4*)(bbg + (col - 3584));
      u32x2 o = {pk2(sigmoidf_(v[0] + b[0]), sigmoidf_(v[1] + b[1])), pk2(sigmoidf_(v[2] + b[2]), sigmoidf_(v[3] + b[3]))};
      *(u32x2*)(proj + (size_t)row * PP + col) = o;
    } else if (col < 5648) {
      const int j0 = col - 5632;
#pragma unroll
      for (int e = 0; e < 4; ++e) { const int j = j0 + e; float r;
        if (j < 8) r = -softplusf_(-(v[e] + b_fgate[j]));
        else if (j < 12) r = sigmoidf_(v[e]);
        else r = -__expf(a_log[j - 12]) * softplusf_(v[e] + dt_bias[j - 12]);
        small[(size_t)row * 16 + j] = r; }
    }
  }
};
DI void phase_inproj(const Params& p, int bid, int nb, char* lds) {
  GemmArgs g = {(const bf16_t*)(p.ws + WS_H), 1024, (const bf16_t*)(p.ws + WS_WIN), 1024, 1024};
  EpiInproj e = {(bf16_t*)(p.ws + WS_P), (float*)(p.ws + WS_SMALL), p.b_branch_gate, p.b_fgate, p.a_log, p.dt_bias};
  for (int t = bid; t < 256 * 45; t += nb) gemm_tile(g, (t / 45) * 128, (t % 45) * 128, lds, e);
}

DI void phase_foxcum(const Params& p, int bid, int nb, char* lds) {
  float* tot = (float*)lds;
  const float* small = (const float*)(p.ws + WS_SMALL);
  float* fneg = (float*)(p.ws + WS_FNEG);
  const int tid = threadIdx.x;
  for (int bh = bid; bh < 32; bh += nb) {
    const int b = bh >> 3, h = bh & 7;
    float v[32]; float run = 0.f;
#pragma unroll
    for (int i = 0; i < 32; ++i) { run += small[((size_t)b * S_ + tid * 32 + i) * 16 + h]; v[i] = run; }
    tot[tid] = run; __syncthreads();
    float off = 0.f; for (int j = 0; j < tid; ++j) off += tot[j];
#pragma unroll
    for (int i = 0; i < 32; ++i) fneg[(size_t)bh * S_ + tid * 32 + i] = -(v[i] + off) * LOG2E;
    __syncthreads();
  }
}

DI int swzv(int row, int c) { return row * 128 + ((c ^ (((row >> 1) & 7) ^ ((row & 2) << 1))) << 4); }
DI void attn_unit(const Params& p, int bh, int qb, char* lds) {
  const int tid = threadIdx.x, lane = tid & 63, wid = tid >> 6, r32 = lane & 31, hi = lane >> 5;
  const int b = bh >> 3, h = bh & 7;
  bf16_t* proj = (bf16_t*)(p.ws + WS_P);
  const float* fneg = (const float*)(p.ws + WS_FNEG) + (size_t)bh * S_;
  const size_t rowbase = (size_t)b * S_;
  char* Ks = lds; char* Vs = lds + 8192; float* Fs = (float*)(lds + 16384);
  const LAS char* Vs3 = (const LAS char*)Vs;
  const int qrow = qb * 128 + wid * 32 + r32;
  bf16_t* qptr = proj + (rowbase + qrow) * PP + h * 64;
  bf16x8 qr[4];
  {
    const float c2 = 0.125f * LOG2E;
#pragma unroll
    for (int ks = 0; ks < 4; ++ks) { const u32x4 w = *(const u32x4*)(qptr + ks * 16 + hi * 8);
      qr[ks] = pack8(bflo(w[0]) * c2, bfhi(w[0]) * c2, bflo(w[1]) * c2, bfhi(w[1]) * c2, bflo(w[2]) * c2, bfhi(w[2]) * c2, bflo(w[3]) * c2, bfhi(w[3]) * c2); }
  }
  f32x16 o0, o1;
#pragma unroll
  for (int r = 0; r < 16; ++r) { o0[r] = 0.f; o1[r] = 0.f; }
  float m = -1e30f, l = 0.f;
  const int ntiles = 2 * qb + 2;
  const int srow = tid >> 3, sc = tid & 7;
  const bf16_t* kg = proj + (rowbase + srow) * PP + 512 + h * 64 + sc * 8;
  const bf16_t* vg = proj + (rowbase + srow) * PP + 1024 + h * 64 + sc * 8;
  u32x4 rk[2], rv[2]; f32x4 rf = {0.f, 0.f, 0.f, 0.f};
#pragma unroll
  for (int i = 0; i < 2; ++i) { rk[i] = *(const u32x4*)(kg + (size_t)(32 * i) * PP); rv[i] = *(const u32x4*)(vg + (size_t)(32 * i) * PP); }
  if (tid < 16) rf = *(const f32x4*)(fneg + tid * 4);
  const int wave_maxrow = qb * 128 + wid * 32 + 31;
  for (int j = 0; j < ntiles; ++j) {
    __syncthreads();
#pragma unroll
    for (int i = 0; i < 2; ++i) { *(u32x4*)(Ks + swz(srow + 32 * i, sc)) = rk[i]; *(u32x4*)(Vs + swzv(srow + 32 * i, sc)) = rv[i]; }
    if (tid < 16) *(f32x4*)(Fs + tid * 4) = rf;
    __syncthreads();
    if (j + 1 < ntiles) {
#pragma unroll
      for (int i = 0; i < 2; ++i) { rk[i] = *(const u32x4*)(kg + (size_t)((j + 1) * 64 + 32 * i) * PP); rv[i] = *(const u32x4*)(vg + (size_t)((j + 1) * 64 + 32 * i) * PP); }
      if (tid < 16) rf = *(const f32x4*)(fneg + (j + 1) * 64 + tid * 4);
    }
    if (j * 64 > wave_maxrow) continue;
    f32x16 p0, p1;
#pragma unroll
    for (int g = 0; g < 4; ++g) { const f32x4 a = *(const f32x4*)(Fs + 8 * g + 4 * hi), c = *(const f32x4*)(Fs + 32 + 8 * g + 4 * hi);
#pragma unroll
      for (int e = 0; e < 4; ++e) { p0[4 * g + e] = a[e]; p1[4 * g + e] = c[e]; } }
#pragma unroll
    for (int ks = 0; ks < 4; ++ks) {
      const bf16x8 k0 = *(const bf16x8*)(Ks + swz(r32, 2 * ks + hi)), k1 = *(const bf16x8*)(Ks + swz(32 + r32, 2 * ks + hi));
      p0 = MFMA32(k0, qr[ks], p0); p1 = MFMA32(k1, qr[ks], p1);
    }
    if (j >= 2 * qb) {
      const int kb = j * 64;
#pragma unroll
      for (int r = 0; r < 16; ++r) { const int kv = kb + crow(r, hi); if (kv > qrow) p0[r] = -INFINITY; if (kv + 32 > qrow) p1[r] = -INFINITY; }
    }
    float mx = fmaxf(p0[0], p1[0]);
#pragma unroll
    for (int r = 1; r < 16; ++r) mx = fmaxf(mx, fmaxf(p0[r], p1[r]));
    mx = fmaxf(mx, __shfl_xor(mx, 32));
    const float mn = fmaxf(m, mx), alpha = exp2f(m - mn); m = mn;
    float ps = 0.f;
#pragma unroll
    for (int r = 0; r < 16; ++r) { p0[r] = exp2f(p0[r] - mn); p1[r] = exp2f(p1[r] - mn); ps += p0[r] + p1[r]; }
    l = l * alpha + ps;
#pragma unroll
    for (int r = 0; r < 16; ++r) { o0[r] *= alpha; o1[r] *= alpha; }
    bf16x8 pf[2][2];
    pf[0][0] = pack8(p0[0], p0[1], p0[2], p0[3], p0[4], p0[5], p0[6], p0[7]);
    pf[0][1] = pack8(p0[8], p0[9], p0[10], p0[11], p0[12], p0[13], p0[14], p0[15]);
    pf[1][0] = pack8(p1[0], p1[1], p1[2], p1[3], p1[4], p1[5], p1[6], p1[7]);
    pf[1][1] = pack8(p1[8], p1[9], p1[10], p1[11], p1[12], p1[13], p1[14], p1[15]);
#pragma unroll
    for (int pb = 0; pb < 2; ++pb)
#pragma unroll
      for (int s = 0; s < 2; ++s) {
        const int rowa = 32 * pb + 16 * s + 4 * hi + ((lane & 15) >> 2);
#pragma unroll
        for (int d0 = 0; d0 < 2; ++d0) {
          const int cl = 4 * d0 + 2 * ((lane >> 4) & 1) + ((lane & 3) >> 1), sub = 8 * (lane & 1);
          const s16x4 lo = tr16(Vs3 + swzv(rowa, cl) + sub), hi4 = tr16(Vs3 + swzv(rowa + 8, cl) + sub);
          const bf16x8 vf = cat8(lo, hi4);
          if (d0 == 0) o0 = MFMA32(vf, pf[pb][s], o0); else o1 = MFMA32(vf, pf[pb][s], o1);
        }
      }
  }
  l += __shfl_xor(l, 32);
  const float inv = 1.f / l;
#pragma unroll
  for (int g = 0; g < 4; ++g) {
    u32x2 a = {pk2(o0[4 * g] * inv, o0[4 * g + 1] * inv), pk2(o0[4 * g + 2] * inv, o0[4 * g + 3] * inv)};
    u32x2 c = {pk2(o1[4 * g] * inv, o1[4 * g + 1] * inv), pk2(o1[4 * g + 2] * inv, o1[4 * g + 3] * inv)};
    *(u32x2*)(qptr + 8 * g + 4 * hi) = a; *(u32x2*)(qptr + 32 + 8 * g + 4 * hi) = c;
  }
}
DI void phase_attn(const Params& p, int bid, int nb, char* lds) {
  for (int u = bid; u < 2048; u += nb) attn_unit(p, u & 31, 63 - (u >> 5), lds);
}

constexpr int QP = 136;
DI void gdn_prep_unit(const Params& p, int U, char* lds) {
  const int tid = threadIdx.x, lane = tid & 63, wid = tid >> 6, fr = lane & 15, fq = lane >> 4;
  const int b = U >> 9, h = (U >> 7) & 3, c = U & 127;
  const size_t t0 = (size_t)b * S_ + c * 64;
  const int s0 = c * 64;
  const bf16_t* proj = (const bf16_t*)(p.ws + WS_P);
  const float* small = (const float*)(p.ws + WS_SMALL);
  bf16_t* q_s = (bf16_t*)lds; bf16_t* k_s = q_s + 64 * QP; bf16_t* v_s = k_s + 64 * QP;
  float* Lm = (float*)(lds + 3 * 17408);
  bf16_t* T1 = (bf16_t*)Lm; bf16_t* T2 = T1 + 64 * 72;
  float* gcs = (float*)(lds + 3 * 17408 + 18432);
  bf16_t* QF = (bf16_t*)((char*)p.out) + (size_t)U * 8192;
  bf16_t* KF = (bf16_t*)((char*)p.out + 32 * MiB) + (size_t)U * 8192;
  bf16_t* AF = (bf16_t*)((char*)p.out + 64 * MiB) + (size_t)U * 4096;
  bf16_t* UF = (bf16_t*)(p.ws + WS_UF) + (size_t)U * 8192;
  bf16_t* WF = (bf16_t*)(p.ws + WS_WF) + (size_t)U * 8192;
  __syncthreads();
  if (wid == 0) {
    const float g = small[(t0 + lane) * 16 + 12 + h], bt = small[(t0 + lane) * 16 + 8 + h];
    float cs = g;
#pragma unroll
    for (int d = 1; d < 64; d <<= 1) { const float n = __shfl_up(cs, d); if (lane >= d) cs += n; }
    const float gl = __shfl(cs, 63);
    gcs[lane] = cs; gcs[64 + lane] = bt; gcs[128 + lane] = __expf(cs); gcs[192 + lane] = __expf(gl - cs);
    if (lane == 0) { gcs[256] = __expf(gl); ((float*)(p.ws + WS_GL))[U] = __expf(gl); }
  }
  __syncthreads();
  {
#pragma unroll
    for (int X = 0; X < 3; ++X) {
      const int col = 1536 + 512 * X + h * 128 + 2 * lane, cb = 512 * X + h * 128 + 2 * lane;
      float w0[4], w1[4];
#pragma unroll
      for (int j = 0; j < 4; ++j) { w0[j] = p.conv_w[j * 1536 + cb]; w1[j] = p.conv_w[j * 1536 + cb + 1]; }
      bf16_t* dst = X == 0 ? q_s : (X == 1 ? k_s : v_s);
      float xa[4], xb[4];
      const int i0 = 16 * wid;
#pragma unroll
      for (int j = 0; j < 3; ++j) { const int rr = i0 - 3 + j; unsigned u = 0u; if (s0 + rr >= 0) u = *(const unsigned*)(proj + (size_t)((long)t0 + rr) * PP + col); xa[j + 1] = bflo(u); xb[j + 1] = bfhi(u); }
      for (int i = i0; i < i0 + 16; ++i) {
        xa[0] = xa[1]; xa[1] = xa[2]; xa[2] = xa[3]; xb[0] = xb[1]; xb[1] = xb[2]; xb[2] = xb[3];
        const unsigned u = *(const unsigned*)(proj + (t0 + i) * PP + col); xa[3] = bflo(u); xb[3] = bfhi(u);
        float y0 = w0[0] * xa[0] + w0[1] * xa[1] + w0[2] * xa[2] + w0[3] * xa[3];
        float y1 = w1[0] * xb[0] + w1[1] * xb[1] + w1[2] * xb[2] + w1[3] * xb[3];
        y0 = y0 * sigmoidf_(y0); y1 = y1 * sigmoidf_(y1);
        if (X < 2) { const float ss = wave_sum(y0 * y0 + y1 * y1); const float rn = rsqrtf(ss + 1e-6f); y0 *= rn; y1 *= rn; }
        *(unsigned*)(dst + i * QP + 2 * lane) = pk2(y0, y1);
        if (X == 0) {
          const float f = 0.08838834764831845f * gcs[128 + i];
          const int d = 2 * lane, mm = d >> 5, ss2 = (d >> 4) & 1, aa = (d >> 3) & 1, hh = (d >> 2) & 1, bb = d & 3;
          const int lp = (i & 31) + 32 * hh;
          *(unsigned*)(QF + (size_t)(((((i >> 5) * 4 + mm) * 2 + ss2) * 64 + lp) * 8 + 4 * aa + bb)) = pk2(y0 * f, y1 * f);
        }
      }
    }
  }
  __syncthreads();
  {
    bf16x8 ka[4];
#pragma unroll
    for (int kk = 0; kk < 4; ++kk) ka[kk] = *(const bf16x8*)(k_s + (16 * wid + fr) * QP + kk * 32 + fq * 8);
#pragma unroll
    for (int ni = 0; ni < 4; ++ni) {
      f32x4 dkk = {0.f, 0.f, 0.f, 0.f}, dqk = {0.f, 0.f, 0.f, 0.f};
      const int i = 16 * ni + fr, jj0 = 16 * wid + 4 * fq;
      if (ni >= wid) {
#pragma unroll
        for (int kk = 0; kk < 4; ++kk) {
          const bf16x8 bk = *(const bf16x8*)(k_s + (16 * ni + fr) * QP + kk * 32 + fq * 8), bq = *(const bf16x8*)(q_s + (16 * ni + fr) * QP + kk * 32 + fq * 8);
          dkk = MFMA16(ka[kk], bk, dkk); dqk = MFMA16(ka[kk], bq, dqk);
        }
      }
      const float gi = gcs[i], bi = gcs[64 + i];
      f32x4 lv, av;
#pragma unroll
      for (int r = 0; r < 4; ++r) { const int jj = jj0 + r; const float dec = __expf(fminf(gi - gcs[jj], 0.f));
        lv[r] = (jj < i) ? bi * dkk[r] * dec : 0.f; av[r] = (jj <= i) ? dqk[r] * 0.08838834764831845f * dec : 0.f; }
      *(f32x4*)(Lm + i * 68 + jj0) = lv;
      const int lp = (i & 31) + 32 * (fq & 1);
      u32x2 o = {pk2(av[0], av[1]), pk2(av[2], av[3])};
      *(u32x2*)(AF + (size_t)((((((i >> 5) * 2 + (wid >> 1)) * 2 + (wid & 1)) * 64 + lp) * 8) + 4 * (fq >> 1))) = o;
    }
    for (int it = tid; it < 2048; it += NT) {
      const int d = it & 127, jg = it >> 7;
      float v4[4];
#pragma unroll
      for (int e = 0; e < 4; ++e) { const int jj = 4 * jg + e; v4[e] = bf2f(k_s[jj * QP + d]) * gcs[192 + jj]; }
      const int lp = (d & 31) + 32 * (jg & 1);
      u32x2 o = {pk2(v4[0], v4[1]), pk2(v4[2], v4[3])};
      *(u32x2*)(KF + (size_t)((((((d >> 5) * 2 + (jg >> 3)) * 2 + ((jg >> 2) & 1)) * 64 + lp) * 8) + 4 * ((jg >> 1) & 1))) = o;
    }
  }
  __syncthreads();
  if (wid == 0) {
    float Tc[64];
#pragma unroll
    for (int i = 0; i < 64; ++i) {
      float a0 = (lane == i) ? 1.f : 0.f, a1 = 0.f;
#pragma unroll
      for (int g = 0; 4 * g < i; ++g) {
        const f32x4 Lv = *(const f32x4*)(Lm + i * 68 + 4 * g);
#pragma unroll
        for (int e = 0; e < 4; ++e) { const int j = 4 * g + e; if (j < i) { if (e & 1) a1 -= Lv[e] * Tc[j]; else a0 -= Lv[e] * Tc[j]; } }
      }
      Tc[i] = a0 + a1;
    }
    const float f1 = gcs[64 + lane], f2 = f1 * gcs[128 + lane];
    asm volatile("" ::: "memory");
#pragma unroll
    for (int i = 0; i < 64; ++i) { T1[i * 72 + lane] = f2bf(Tc[i] * f1); T2[i * 72 + lane] = f2bf(Tc[i] * f2); }
  }
  __syncthreads();
  {
    const LAS char* v3 = (const LAS char*)v_s; const LAS char* k3 = (const LAS char*)k_s;
    bf16x8 ta[2], tb[2];
#pragma unroll
    for (int kk = 0; kk < 2; ++kk) { ta[kk] = *(const bf16x8*)(T1 + (16 * wid + fr) * 72 + kk * 32 + fq * 8); tb[kk] = *(const bf16x8*)(T2 + (16 * wid + fr) * 72 + kk * 32 + fq * 8); }
#pragma unroll
    for (int nj = 0; nj < 8; ++nj) {
      f32x4 du = {0.f, 0.f, 0.f, 0.f}, dw = {0.f, 0.f, 0.f, 0.f};
#pragma unroll
      for (int kk = 0; kk < 2; ++kk) {
        const int jr = 32 * kk + 8 * fq + ((lane & 15) >> 2), cc = 16 * nj + 4 * (lane & 3);
        const bf16x8 vb = cat8(tr16(v3 + (jr * QP + cc) * 2), tr16(v3 + ((jr + 4) * QP + cc) * 2));
        const bf16x8 kb = cat8(tr16(k3 + (jr * QP + cc) * 2), tr16(k3 + ((jr + 4) * QP + cc) * 2));
        du = MFMA16(ta[kk], vb, du);
        dw = MFMA16(kb, tb[kk], dw);
      }
      {
        const int lp = 16 * (nj & 1) + fr + 32 * (fq & 1);
        u32x2 o = {pk2(du[0], du[1]), pk2(du[2], du[3])};
        *(u32x2*)(UF + (size_t)(((((wid >> 1) * 4 + (nj >> 1)) * 64 + lp) * 16) + 4 * (2 * (wid & 1) + (fq >> 1)))) = o;
      }
      {
        const int lp = 16 * (wid & 1) + fr + 32 * (fq & 1);
        u32x2 o = {pk2(-dw[0], -dw[1]), pk2(-dw[2], -dw[3])};
        *(u32x2*)(WF + (size_t)((((((wid >> 1) * 4 + (nj >> 1)) * 2 + (nj & 1)) * 64 + lp) * 8) + 4 * (fq >> 1))) = o;
      }
    }
  }
}
DI void phase_gdnprep(const Params& p, int bid, int nb, char* lds) {
  for (int U = bid; U < 2048; U += nb) gdn_prep_unit(p, U, lds);
}

DI bf16x8 packS(const f32x16& x, int s) { return pack8(x[8 * s], x[8 * s + 1], x[8 * s + 2], x[8 * s + 3], x[8 * s + 4], x[8 * s + 5], x[8 * s + 6], x[8 * s + 7]); }
DI void gdn_scan_seq(const Params& p, int bh16) {
  const int tid = threadIdx.x, lane = tid & 63, wv = tid >> 6, r32 = lane & 31, hi = lane >> 5;
  const int b = bh16 >> 2, h = bh16 & 3;
  bf16_t* proj = (bf16_t*)(p.ws + WS_P);
  const float* glp = (const float*)(p.ws + WS_GL);
  f32x16 S[4];
#pragma unroll
  for (int m = 0; m < 4; ++m)
#pragma unroll
    for (int r = 0; r < 16; ++r) S[m][r] = 0.f;
  for (int c = 0; c < 128; ++c) {
    const int U = bh16 * 128 + c;
    const bf16x8* QF = (const bf16x8*)((const bf16_t*)((char*)p.out) + (size_t)U * 8192) + lane;
    const bf16x8* KF = (const bf16x8*)((const bf16_t*)((char*)p.out + 32 * MiB) + (size_t)U * 8192) + lane;
    const bf16x8* AF = (const bf16x8*)((const bf16_t*)((char*)p.out + 64 * MiB) + (size_t)U * 4096) + lane;
    const bf16x8* WF = (const bf16x8*)((const bf16_t*)(p.ws + WS_WF) + (size_t)U * 8192) + lane;
    const bf16_t* UF = (const bf16_t*)(p.ws + WS_UF) + (size_t)U * 8192;
    const float gl = glp[U];
    bf16x8 Sb[4][2];
#pragma unroll
    for (int m = 0; m < 4; ++m) { Sb[m][0] = packS(S[m], 0); Sb[m][1] = packS(S[m], 1); }
    f32x16 vn[2], o[2];
#pragma unroll
    for (int i2 = 0; i2 < 2; ++i2) {
      const u32x4 ua = *(const u32x4*)(UF + (size_t)((i2 * 4 + wv) * 64 + lane) * 16), ub = *(const u32x4*)(UF + (size_t)((i2 * 4 + wv) * 64 + lane) * 16 + 8);
#pragma unroll
      for (int e = 0; e < 4; ++e) { vn[i2][2 * e] = bflo(ua[e]); vn[i2][2 * e + 1] = bfhi(ua[e]); vn[i2][8 + 2 * e] = bflo(ub[e]); vn[i2][8 + 2 * e + 1] = bfhi(ub[e]); }
#pragma unroll
      for (int r = 0; r < 16; ++r) o[i2][r] = 0.f;
#pragma unroll
      for (int m = 0; m < 4; ++m)
#pragma unroll
        for (int s = 0; s < 2; ++s) {
          vn[i2] = MFMA32(WF[((i2 * 4 + m) * 2 + s) * 64], Sb[m][s], vn[i2]);
          o[i2] = MFMA32(QF[((i2 * 4 + m) * 2 + s) * 64], Sb[m][s], o[i2]);
        }
    }
    bf16x8 Vb[2][2];
#pragma unroll
    for (int j2 = 0; j2 < 2; ++j2) { Vb[j2][0] = packS(vn[j2], 0); Vb[j2][1] = packS(vn[j2], 1); }
#pragma unroll
    for (int i2 = 0; i2 < 2; ++i2)
#pragma unroll
      for (int j2 = 0; j2 <= i2; ++j2)
#pragma unroll
        for (int s = 0; s < 2; ++s) o[i2] = MFMA32(AF[((i2 * 2 + j2) * 2 + s) * 64], Vb[j2][s], o[i2]);
#pragma unroll
    for (int m = 0; m < 4; ++m) {
#pragma unroll
      for (int r = 0; r < 16; ++r) S[m][r] *= gl;
#pragma unroll
      for (int j2 = 0; j2 < 2; ++j2)
#pragma unroll
        for (int s = 0; s < 2; ++s) S[m] = MFMA32(KF[((m * 2 + j2) * 2 + s) * 64], Vb[j2][s], S[m]);
    }
    const size_t t0 = (size_t)b * S_ + c * 64;
#pragma unroll
    for (int i2 = 0; i2 < 2; ++i2)
#pragma unroll
      for (int r = 0; r < 16; ++r) proj[(t0 + 32 * i2 + crow(r, hi)) * PP + 1536 + h * 128 + 32 * wv + r32] = f2bf(o[i2][r]);
  }
}
DI void phase_gdnscan(const Params& p, int bid, int nb) {
  for (int s = bid; s < 16; s += nb) gdn_scan_seq(p, s);
}
DI void phase_gdnout(const Params& p, int bid, int nb) {
  const int lane = threadIdx.x & 63, gw = bid * 4 + (threadIdx.x >> 6), nw = nb * 4;
  bf16_t* proj = (bf16_t*)(p.ws + WS_P);
  const f32x4 w0 = *(const f32x4*)(p.gdn_norm_w + (lane & 15) * 8), w1 = *(const f32x4*)(p.gdn_norm_w + (lane & 15) * 8 + 4);
  for (int row = gw; row < T_; row += nw) {
    bf16_t* op = proj + (size_t)row * PP + 1536 + lane * 8;
    const u32x4 ov = *(const u32x4*)op, zv = *(const u32x4*)(proj + (size_t)row * PP + 3072 + lane * 8);
    float o[8], z[8];
#pragma unroll
    for (int e = 0; e < 4; ++e) { o[2 * e] = bflo(ov[e]); o[2 * e + 1] = bfhi(ov[e]); z[2 * e] = bflo(zv[e]); z[2 * e + 1] = bfhi(zv[e]); }
    float ss = 0.f;
#pragma unroll
    for (int e = 0; e < 8; ++e) ss += o[e] * o[e];
    ss += __shfl_xor(ss, 1); ss += __shfl_xor(ss, 2); ss += __shfl_xor(ss, 4); ss += __shfl_xor(ss, 8);
    const float rstd = rsqrtf(ss * (1.f / 128.f) + 1e-6f);
    float y[8];
#pragma unroll
    for (int e = 0; e < 8; ++e) { const float w = e < 4 ? w0[e] : w1[e - 4]; y[e] = o[e] * rstd * w * (z[e] * sigmoidf_(z[e])); }
    u32x4 r = {pk2(y[0], y[1]), pk2(y[2], y[3]), pk2(y[4], y[5]), pk2(y[6], y[7])};
    *(u32x4*)op = r;
  }
}

struct EpiMergeA {
  const bf16_t* proj; bf16_t* mp;
  DI void operator()(int row, int col, f32x4 v) const {
    const u32x2 g = *(const u32x2*)(proj + (size_t)row * PP + 3584 + col);
    u32x2 o = {pk2(v[0] * bflo(g[0]), v[1] * bfhi(g[0])), pk2(v[2] * bflo(g[1]), v[3] * bfhi(g[1]))};
    *(u32x2*)(mp + (size_t)row * 1024 + col) = o;
  }
};
struct EpiMergeB {
  const bf16_t* proj; bf16_t* mp;
  DI void operator()(int row, int col, f32x4 v) const {
    const u32x2 g = *(const u32x2*)(proj + (size_t)row * PP + 4608 + col);
    const u32x2 q = *(const u32x2*)(mp + (size_t)row * 1024 + col);
    u32x2 o = {pk2(bflo(q[0]) + v[0] * bflo(g[0]), bfhi(q[0]) + v[1] * bfhi(g[0])), pk2(bflo(q[1]) + v[2] * bflo(g[1]), bfhi(q[1]) + v[3] * bfhi(g[1]))};
    *(u32x2*)(mp + (size_t)row * 1024 + col) = o;
  }
};
struct EpiF32 { float* out; int ld; DI void operator()(int row, int col, f32x4 v) const { *(f32x4*)(out + (size_t)row * ld + col) = v; } };
struct EpiBf16 { bf16_t* out; int ld; DI void operator()(int row, int col, f32x4 v) const { u32x2 o = {pk2(v[0], v[1]), pk2(v[2], v[3])}; *(u32x2*)(out + (size_t)row * ld + col) = o; } };
DI void phase_mergeA(const Params& p, int bid, int nb, char* lds) {
  const bf16_t* proj = (const bf16_t*)(p.ws + WS_P);
  GemmArgs g = {proj, PP, (const bf16_t*)(p.ws + WS_WFO), 512, 512};
  EpiMergeA e = {proj, (bf16_t*)(p.ws + WS_H)};
  for (int t = bid; t < 256 * 8; t += nb) gemm_tile(g, (t >> 3) * 128, (t & 7) * 128, lds, e);
}
DI void phase_mergeB(const Params& p, int bid, int nb, char* lds) {
  const bf16_t* proj = (const bf16_t*)(p.ws + WS_P);
  GemmArgs g = {proj + 1536, PP, (const bf16_t*)(p.ws + WS_WGO), 512, 512};
  EpiMergeB e = {proj, (bf16_t*)(p.ws + WS_H)};
  for (int t = bid; t < 256 * 8; t += nb) gemm_tile(g, (t >> 3) * 128, (t & 7) * 128, lds, e);
}
DI void phase_wout(const Params& p, int bid, int nb, char* lds) {
  GemmArgs g = {(const bf16_t*)(p.ws + WS_H), 1024, (const bf16_t*)(p.ws + WS_WOUT), 1024, 1024};
  EpiF32 e = {p.out, 1024};
  for (int t = bid; t < 256 * 8; t += nb) gemm_tile(g, (t >> 3) * 128, (t & 7) * 128, lds, e);
}
DI void phase_rows1(const Params& p, int bid, int nb) {
  const int lane = threadIdx.x & 63, gw = bid * 4 + (threadIdx.x >> 6), nw = nb * 4;
  const float* mod = (const float*)(p.ws + WS_MOD);
  bf16_t* h2 = (bf16_t*)(p.ws + WS_H);
  for (int row = gw; row < T_; row += nw) {
    const int b = row >> 13;
    f32x4* mr = (f32x4*)(p.out + (size_t)row * 1024);
    const f32x4* xr = (const f32x4*)(p.x + (size_t)row * 1024);
    f32x4 v[4]; float ss = 0.f;
#pragma unroll
    for (int i = 0; i < 4; ++i) { v[i] = mr[lane + 64 * i]; ss += v[i][0] * v[i][0] + v[i][1] * v[i][1] + v[i][2] * v[i][2] + v[i][3] * v[i][3]; }
    ss = wave_sum(ss);
    const float rstd = rsqrtf(ss * (1.f / 1024.f) + 1e-6f);
    float s2 = 0.f;
#pragma unroll
    for (int i = 0; i < 4; ++i) {
      const int col = 4 * lane + 256 * i;
      const f32x4 g4 = *(const f32x4*)(p.g_post_mix + col), gt = *(const f32x4*)(mod + b * 6144 + 2048 + col);
      v[i] = xr[lane + 64 * i] + gt * (v[i] * rstd * g4);
      mr[lane + 64 * i] = v[i];
      s2 += v[i][0] * v[i][0] + v[i][1] * v[i][1] + v[i][2] * v[i][2] + v[i][3] * v[i][3];
    }
    s2 = wave_sum(s2);
    const float rstd2 = rsqrtf(s2 * (1.f / 1024.f) + 1e-6f);
#pragma unroll
    for (int i = 0; i < 4; ++i) {
      const int col = 4 * lane + 256 * i;
      const f32x4 g4 = *(const f32x4*)(p.g_pre_ffn + col), sh = *(const f32x4*)(mod + b * 6144 + 3072 + col), sc = *(const f32x4*)(mod + b * 6144 + 4096 + col);
      const f32x4 y = (v[i] * rstd2 * g4) * (1.f + sc) + sh;
      u32x2 o = {pk2(y[0], y[1]), pk2(y[2], y[3])};
      *(u32x2*)(h2 + (size_t)row * 1024 + col) = o;
    }
  }
}

DI void phase_peerq(const Params& p, int bid, int nb, char* lds) {
  GemmArgs g = {(const bf16_t*)(p.ws + WS_H), 1024, (const bf16_t*)(p.ws + WS_WQ), 1024, 1024};
  EpiBf16 e = {(bf16_t*)(p.ws + WS_QY), 2048};
  for (int t = bid; t < 256 * 16; t += nb) gemm_tile(g, (t >> 4) * 128, (t & 15) * 128, lds, e);
}
DI unsigned ordkey(float f) { const unsigned u = __float_as_uint(f); return (u & 0x80000000u) ? ~u : (u | 0x80000000u); }
DI void peer_select_unit(const Params& p, int unit, char* lds) {
  const int tid = threadIdx.x, lane = tid & 63, wid = tid >> 6, fr = lane & 15, fq = lane >> 4;
  const int h = unit & 7, t0 = (unit >> 3) * 32;
  float* sc = (float*)lds;
  float* topv = (float*)(lds + 2 * 32 * 132 * 4);
  int* topi = (int*)(topv + 2 * 32 * 16);
  const bf16_t* qy = (const bf16_t*)(p.ws + WS_QY);
  const bf16_t* keys = (const bf16_t*)(p.ws + WS_KEYS);
  __syncthreads();
  {
    const int set = wid >> 1, ts = wid & 1;
    bf16x8 qa[4];
#pragma unroll
    for (int kk = 0; kk < 4; ++kk) qa[kk] = *(const bf16x8*)(qy + (size_t)(t0 + 16 * ts + fr) * 2048 + h * 256 + set * 128 + kk * 32 + fq * 8);
#pragma unroll
    for (int nj = 0; nj < 8; ++nj) {
      f32x4 d = {0.f, 0.f, 0.f, 0.f};
#pragma unroll
      for (int kk = 0; kk < 4; ++kk) { const bf16x8 kb = *(const bf16x8*)(keys + set * 16384 + (16 * nj + fr) * 128 + kk * 32 + fq * 8); d = MFMA16(qa[kk], kb, d); }
#pragma unroll
      for (int r = 0; r < 4; ++r) sc[(set * 32 + 16 * ts + 4 * fq + r) * 132 + 16 * nj + fr] = d[r];
    }
  }
  __syncthreads();
  for (int it = 0; it < 16; ++it) {
    const int rr = 16 * wid + it;
    const float* srow = sc + rr * 132;
    unsigned k0 = (ordkey(srow[lane]) & ~127u) | (unsigned)(127 - lane), k1 = (ordkey(srow[lane + 64]) & ~127u) | (unsigned)(63 - lane);
    int myidx = 0;
    for (int rd = 0; rd < 16; ++rd) {
      const unsigned km = wave_max_u(k0 > k1 ? k0 : k1);
      const int idx = 127 - (int)(km & 127u);
      if (lane == (idx & 63)) { if (idx < 64) k0 = 0u; else k1 = 0u; }
      if (lane == rd) myidx = idx;
    }
    if (lane < 16) { topv[rr * 16 + lane] = srow[myidx]; topi[rr * 16 + lane] = myidx; }
  }
  __syncthreads();
  for (int it = 0; it < 8; ++it) {
    const int tok = 8 * wid + it;
    const float* v1 = topv + tok * 16; const float* v2 = topv + (32 + tok) * 16;
    const int a = lane >> 2, b0 = 4 * (lane & 3);
    unsigned kc[4];
#pragma unroll
    for (int e = 0; e < 4; ++e) kc[e] = (ordkey(v1[a] + v2[b0 + e]) & ~255u) | (unsigned)(255 - (a * 16 + b0 + e));
    int mypos = 0;
    for (int rd = 0; rd < 16; ++rd) {
      unsigned mloc = kc[0] > kc[1] ? kc[0] : kc[1]; const unsigned m2 = kc[2] > kc[3] ? kc[2] : kc[3]; mloc = mloc > m2 ? mloc : m2;
      const unsigned km = wave_max_u(mloc);
      const int pos = 255 - (int)(km & 255u);
      if (lane == (pos >> 2)) {
#pragma unroll
        for (int e = 0; e < 4; ++e) if ((pos & 3) == e) kc[e] = 0u;
      }
      if (lane == rd) mypos = pos;
    }
    const float val = v1[mypos >> 4] + v2[mypos & 15];
    const int ei = topi[tok * 16 + (mypos >> 4)] * 128 + topi[(32 + tok) * 16 + (mypos & 15)];
    const float mx = __shfl(val, 0);
    const float ex = __expf(val - mx);
    float sm = ex; sm += __shfl_xor(sm, 1); sm += __shfl_xor(sm, 2); sm += __shfl_xor(sm, 4); sm += __shfl_xor(sm, 8);
    if (lane < 16) {
      const size_t o = ((size_t)(t0 + tok) * 8 + h) * 16 + lane;
      ((int*)(p.ws + WS_EIDX))[o] = ei; ((float*)(p.ws + WS_GATE))[o] = ex / sm;
    }
  }
}
DI void phase_peersel(const Params& p, int bid, int nb, char* lds) {
  for (int u = bid; u < 8192; u += nb) peer_select_unit(p, u, lds);
}
DI void phase_peergather(const Params& p, int bid, int nb) {
  const int lane = threadIdx.x & 63, gw = bid * 4 + (threadIdx.x >> 6), nw = nb * 4;
  const float* mod = (const float*)(p.ws + WS_MOD);
  const bf16_t* h2 = (const bf16_t*)(p.ws + WS_H);
  const bf16_t* pu = (const bf16_t*)(p.ws + WS_PU); const bf16_t* pv = (const bf16_t*)(p.ws + WS_PV);
  const int* eidx = (const int*)(p.ws + WS_EIDX); const float* gate = (const float*)(p.ws + WS_GATE);
  for (int t = gw; t < T_; t += nw) {
    const int b = t >> 13;
    float hx[16];
    { const u32x4 a = *(const u32x4*)(h2 + (size_t)t * 1024 + 8 * lane), c = *(const u32x4*)(h2 + (size_t)t * 1024 + 512 + 8 * lane);
#pragma unroll
      for (int e = 0; e < 4; ++e) { hx[2 * e] = bflo(a[e]); hx[2 * e + 1] = bfhi(a[e]); hx[8 + 2 * e] = bflo(c[e]); hx[8 + 2 * e + 1] = bfhi(c[e]); } }
    const int e0 = eidx[(size_t)t * 128 + lane], e1 = eidx[(size_t)t * 128 + 64 + lane];
    const float g0 = gate[(size_t)t * 128 + lane], g1 = gate[(size_t)t * 128 + 64 + lane];
    float y[16];
#pragma unroll
    for (int e = 0; e < 16; ++e) y[e] = 0.f;
    for (int sl = 0; sl < 128; sl += 4) {
      int ex[4]; float gx[4]; u32x4 ua[4], ub[4];
#pragma unroll
      for (int q = 0; q < 4; ++q) {
        const int s = sl + q;
        ex[q] = __builtin_amdgcn_readlane(s < 64 ? e0 : e1, s & 63);
        gx[q] = __uint_as_float(__builtin_amdgcn_readlane(__float_as_uint(s < 64 ? g0 : g1), s & 63));
        ua[q] = *(const u32x4*)(pu + (size_t)ex[q] * 1024 + 8 * lane); ub[q] = *(const u32x4*)(pu + (size_t)ex[q] * 1024 + 512 + 8 * lane);
      }
      float coef[4];
#pragma unroll
      for (int q = 0; q < 4; ++q) {
        float d = 0.f;
#pragma unroll
        for (int e = 0; e < 4; ++e) { d += hx[2 * e] * bflo(ua[q][e]) + hx[2 * e + 1] * bfhi(ua[q][e]); d += hx[8 + 2 * e] * bflo(ub[q][e]) + hx[8 + 2 * e + 1] * bfhi(ub[q][e]); }
        d = wave_sum(d);
        coef[q] = gx[q] * 0.5f * d * (1.f + erff(d * 0.70710678118654752f));
      }
#pragma unroll
      for (int q = 0; q < 4; ++q) {
        const u32x4 va = *(const u32x4*)(pv + (size_t)ex[q] * 1024 + 8 * lane), vb = *(const u32x4*)(pv + (size_t)ex[q] * 1024 + 512 + 8 * lane);
#pragma unroll
        for (int e = 0; e < 4; ++e) { y[2 * e] += coef[q] * bflo(va[e]); y[2 * e + 1] += coef[q] * bfhi(va[e]); y[8 + 2 * e] += coef[q] * bflo(vb[e]); y[8 + 2 * e + 1] += coef[q] * bfhi(vb[e]); }
      }
    }
    float ss = 0.f;
#pragma unroll
    for (int e = 0; e < 16; ++e) ss += y[e] * y[e];
    ss = wave_sum(ss);
    const float rstd = rsqrtf(ss * (1.f / 1024.f) + 1e-6f);
    float* orow = p.out + (size_t)t * 1024;
#pragma unroll
    for (int hf = 0; hf < 2; ++hf)
#pragma unroll
      for (int q = 0; q < 2; ++q) {
        const int col = 512 * hf + 8 * lane + 4 * q;
        const f32x4 g4 = *(const f32x4*)(p.g_post_ffn + col), gt = *(const f32x4*)(mod + b * 6144 + 5120 + col);
        f32x4 x1 = *(const f32x4*)(orow + col);
        const f32x4 yy = {y[8 * hf + 4 * q], y[8 * hf + 4 * q + 1], y[8 * hf + 4 * q + 2], y[8 * hf + 4 * q + 3]};
        x1 = x1 + gt * (yy * rstd * g4);
        *(f32x4*)(orow + col) = x1;
      }
  }
}

constexpr int LDS_BYTES = 72704;
#define KERNEL(name, body) __global__ void __launch_bounds__(NT) name(Params p) { extern __shared__ __attribute__((aligned(16))) char lds[]; const int bid = blockIdx.x, nb = gridDim.x; (void)lds; (void)bid; (void)nb; body; }
KERNEL(k_mod, { phase_mod(p, bid, nb, lds); phase_wconv(p, bid, nb, lds); })
KERNEL(k_xnorm, phase_xnorm(p, bid, nb))
KERNEL(k_inproj, phase_inproj(p, bid, nb, lds))
KERNEL(k_foxcum, phase_foxcum(p, bid, nb, lds))
KERNEL(k_attn, phase_attn(p, bid, nb, lds))
KERNEL(k_gdnprep, phase_gdnprep(p, bid, nb, lds))
KERNEL(k_gdnscan, phase_gdnscan(p, bid, nb))
KERNEL(k_gdnout, phase_gdnout(p, bid, nb))
KERNEL(k_mergeA, phase_mergeA(p, bid, nb, lds))
KERNEL(k_mergeB, phase_mergeB(p, bid, nb, lds))
KERNEL(k_wout, { phase_wout(p, bid, nb, lds); phase_tabconv(p, bid, nb); })
KERNEL(k_rows1, phase_rows1(p, bid, nb))
KERNEL(k_peerq, phase_peerq(p, bid, nb, lds))
KERNEL(k_peersel, phase_peersel(p, bid, nb, lds))
KERNEL(k_peergather, phase_peergather(p, bid, nb))

extern "C" void kernel_launch(void* const* d_in, const int* in_sizes, int n_in, void* d_out, int out_size, void* d_ws, size_t ws_size, hipStream_t stream) {
  Params p{};
  const float** f = (const float**)&p;
  for (int i = 0; i < 23; ++i) f[i] = (const float*)d_in[i];
  p.out = (float*)d_out; p.ws = (char*)d_ws;
  const int G = 512;
#define LAUNCH(k, grid) do { static bool once_##k = false; if (!once_##k) { once_##k = true; (void)hipFuncSetAttribute((const void*)k, hipFuncAttributeMaxDynamicSharedMemorySize, LDS_BYTES); } \
    hipLaunchKernelGGL(k, dim3(grid), dim3(NT), LDS_BYTES, stream, p); } while (0)
  LAUNCH(k_mod, G);
  LAUNCH(k_xnorm, 2048);
  LAUNCH(k_inproj, 2048);
  LAUNCH(k_foxcum, 32);
  LAUNCH(k_attn, 2048);
  LAUNCH(k_gdnprep, 2048);
  LAUNCH(k_gdnscan, 16);
  LAUNCH(k_gdnout, 2048);
  LAUNCH(k_mergeA, 2048);
  LAUNCH(k_mergeB, 2048);
  LAUNCH(k_wout, 2048);
  LAUNCH(k_rows1, 2048);
  LAUNCH(k_peerq, 2048);
  LAUNCH(k_peersel, 2048);
  LAUNCH(k_peergather, 2048);
}
```

```cpp
#include <hip/hip_runtime.h>
#include <hip/hip_cooperative_groups.h>
#include <stdint.h>
#include <math.h>
#include <cstdio>

#define DI __device__ __forceinline__
#define LAS __attribute__((address_space(3)))
typedef unsigned short bf16_t;
typedef short bf16x8 __attribute__((ext_vector_type(8)));
typedef short s16x4 __attribute__((ext_vector_type(4)));
typedef float f32x4 __attribute__((ext_vector_type(4)));
typedef float f32x16 __attribute__((ext_vector_type(16)));
typedef float f32x2 __attribute__((ext_vector_type(2)));
typedef unsigned u32x4 __attribute__((ext_vector_type(4)));
typedef unsigned u32x2 __attribute__((ext_vector_type(2)));
typedef __bf16 bf16x2_t __attribute__((ext_vector_type(2)));

constexpr int NT = 256;
constexpr int T_ = 32768, S_ = 8192;
constexpr int PP = 5632;
constexpr int NPAD = 5760;
constexpr float LOG2E = 1.4426950408889634f;
constexpr size_t MiB = 1u << 20;

constexpr size_t WS_MOD = 1 * MiB;
constexpr size_t WS_WIN = 2 * MiB;
constexpr size_t WS_WFO = 14 * MiB;
constexpr size_t WS_WGO = 15 * MiB;
constexpr size_t WS_WOUT = 16 * MiB;
constexpr size_t WS_WQ = 18 * MiB;
constexpr size_t WS_KEYS = 22 * MiB;
constexpr size_t WS_SMALL = 23 * MiB;
constexpr size_t WS_FNEG = 25 * MiB;
constexpr size_t WS_GL = 26 * MiB;
constexpr size_t WS_H = 32 * MiB;
constexpr size_t WS_P = 96 * MiB;
constexpr size_t WS_UF = 448 * MiB;
constexpr size_t WS_WF = 480 * MiB;
constexpr size_t WS_QY = 96 * MiB;
constexpr size_t WS_PU = 224 * MiB;
constexpr size_t WS_PV = 256 * MiB;
constexpr size_t WS_EIDX = 288 * MiB;
constexpr size_t WS_GATE = 304 * MiB;

DI unsigned pk2(float lo, float hi) { f32x2 v = {lo, hi}; bf16x2_t b = __builtin_convertvector(v, bf16x2_t); return __builtin_bit_cast(unsigned, b); }
DI bf16_t f2bf(float x) { return (bf16_t)(pk2(x, 0.f) & 0xffffu); }
DI float bf2f(bf16_t v) { return __uint_as_float(((unsigned)v) << 16); }
DI float bflo(unsigned u) { return __uint_as_float(u << 16); }
DI float bfhi(unsigned u) { return __uint_as_float(u & 0xffff0000u); }
DI float wave_sum(float v) {
#pragma unroll
  for (int d = 32; d >= 1; d >>= 1) v += __shfl_xor(v, d);
  return v;
}
DI unsigned wave_max_u(unsigned v) {
#pragma unroll
  for (int d = 32; d >= 1; d >>= 1) { unsigned o = (unsigned)__shfl_xor((int)v, d); v = o > v ? o : v; }
  return v;
}
DI float sigmoidf_(float x) { return 1.f / (1.f + __expf(-x)); }
DI float softplusf_(float x) { return fmaxf(x, 0.f) + log1pf(__expf(-fabsf(x))); }
DI int crow(int r, int hi) { return (r & 3) + 8 * (r >> 2) + 4 * hi; }
#define MFMA16(a, b, c) __builtin_amdgcn_mfma_f32_16x16x32_bf16((a), (b), (c), 0, 0, 0)
#define MFMA32(a, b, c) __builtin_amdgcn_mfma_f32_32x32x16_bf16((a), (b), (c), 0, 0, 0)
DI s16x4 tr16(const LAS char* p) { typedef short v4i16_t __attribute__((ext_vector_type(4))); return __builtin_bit_cast(s16x4, __builtin_amdgcn_ds_read_tr16_b64_v4i16((LAS v4i16_t*)p)); }
DI bf16x8 cat8(s16x4 lo, s16x4 hi) { return __builtin_shufflevector(lo, hi, 0, 1, 2, 3, 4, 5, 6, 7); }
DI bf16x8 pack8(float a0, float a1, float a2, float a3, float a4, float a5, float a6, float a7) {
  u32x4 p = {pk2(a0, a1), pk2(a2, a3), pk2(a4, a5), pk2(a6, a7)}; return __builtin_bit_cast(bf16x8, p);
}

struct Params {
  const float *x, *c, *w_ada, *b_ada, *g_pre_mix, *g_post_mix, *w_in, *b_fgate, *fox_w_o, *conv_w, *a_log, *dt_bias, *gdn_norm_w, *gdn_w_o,
      *b_branch_gate, *w_out, *g_pre_ffn, *g_post_ffn, *peer_w_query, *peer_keys1, *peer_keys2, *peer_u, *peer_v;
  float* out; char* ws;
};

DI void phase_mod(const Params& p, int bid, int nb, char* lds) {
  float* sc = (float*)lds;
  float* part = sc + 4096;
  const int tid = threadIdx.x;
  for (int i = tid; i < 4096; i += NT) { float v = p.c[i]; sc[i] = v / (1.f + __expf(-v)); }
  __syncthreads();
  float* mod = (float*)(p.ws + WS_MOD);
  for (int g = bid; g < 96; g += nb) {
    const int cc = tid & 63, kg = tid >> 6, col = g * 64 + cc;
    float a0 = 0.f, a1 = 0.f, a2 = 0.f, a3 = 0.f;
#pragma unroll 8
    for (int k = kg; k < 1024; k += 4) { const float w = p.w_ada[(size_t)k * 6144 + col]; a0 += sc[k] * w; a1 += sc[1024 + k] * w; a2 += sc[2048 + k] * w; a3 += sc[3072 + k] * w; }
    part[(kg * 4 + 0) * 64 + cc] = a0; part[(kg * 4 + 1) * 64 + cc] = a1; part[(kg * 4 + 2) * 64 + cc] = a2; part[(kg * 4 + 3) * 64 + cc] = a3;
    __syncthreads();
    { const int b = tid >> 6; float s = part[(0 * 4 + b) * 64 + cc] + part[(1 * 4 + b) * 64 + cc] + part[(2 * 4 + b) * 64 + cc] + part[(3 * 4 + b) * 64 + cc];
      mod[b * 6144 + col] = s + p.b_ada[col]; }
    __syncthreads();
  }
}

DI int inproj_colmap(int n) {
  if (n < 1536) return n;
  if (n < 3584) return 1544 + (n - 1536);
  if (n < 5632) return 3600 + (n - 3584);
  if (n < 5640) return 1536 + (n - 5632);
  if (n < 5648) return 3592 + (n - 5640);
  return -1;
}
DI void transpose_tile(const float* src, int ldsrc, bf16_t* dst, int K, int n0, int k0, bool permute, float* tile) {
  const int tid = threadIdx.x, tx = tid & 63, ty = tid >> 6;
  const int n = n0 + tx; const int oc = permute ? inproj_colmap(n) : n;
#pragma unroll 4
  for (int i = 0; i < 16; ++i) { const int ky = ty + 4 * i; tile[ky * 65 + tx] = (oc >= 0) ? src[(size_t)(k0 + ky) * ldsrc + oc] : 0.f; }
  __syncthreads();
#pragma unroll 4
  for (int i = 0; i < 16; ++i) { const int ny = ty + 4 * i; dst[(size_t)(n0 + ny) * K + k0 + tx] = f2bf(tile[tx * 65 + ny]); }
  __syncthreads();
}
DI void phase_wconv(const Params& p, int bid, int nb, char* lds) {
  float* tile = (float*)lds;
  for (int t = bid; t < 2464; t += nb) {
    if (t < 1440) transpose_tile(p.w_in, 5648, (bf16_t*)(p.ws + WS_WIN), 1024, (t / 16) * 64, (t % 16) * 64, true, tile);
    else if (t < 1568) { const int u = t - 1440; transpose_tile(p.fox_w_o, 1024, (bf16_t*)(p.ws + WS_WFO), 512, (u / 8) * 64, (u % 8) * 64, false, tile); }
    else if (t < 1696) { const int u = t - 1568; transpose_tile(p.gdn_w_o, 1024, (bf16_t*)(p.ws + WS_WGO), 512, (u / 8) * 64, (u % 8) * 64, false, tile); }
    else if (t < 1952) { const int u = t - 1696; transpose_tile(p.w_out, 1024, (bf16_t*)(p.ws + WS_WOUT), 1024, (u / 16) * 64, (u % 16) * 64, false, tile); }
    else { const int u = t - 1952; transpose_tile(p.peer_w_query, 2048, (bf16_t*)(p.ws + WS_WQ), 1024, (u / 16) * 64, (u % 16) * 64, false, tile); }
  }
  bf16_t* kd = (bf16_t*)(p.ws + WS_KEYS);
  for (int i = bid * NT + threadIdx.x; i < 32768; i += nb * NT) kd[i] = f2bf(i < 16384 ? p.peer_keys1[i] : p.peer_keys2[i - 16384]);
}
DI void phase_tabconv(const Params& p, int bid, int nb) {
  const size_t n8 = (size_t)16384 * 1024 / 8;
  for (size_t i = (size_t)bid * NT + threadIdx.x; i < 2 * n8; i += (size_t)nb * NT) {
    const bool second = i >= n8; const size_t j = second ? i - n8 : i;
    const float* src = (second ? p.peer_v : p.peer_u) + j * 8;
    const f32x4 a = *(const f32x4*)src, b = *(const f32x4*)(src + 4);
    u32x4 o = {pk2(a[0], a[1]), pk2(a[2], a[3]), pk2(b[0], b[1]), pk2(b[2], b[3])};
    *(u32x4*)(p.ws + (second ? WS_PV : WS_PU) + j * 16) = o;
  }
}

DI void phase_xnorm(const Params& p, int bid, int nb) {
  const int lane = threadIdx.x & 63, gw = bid * 4 + (threadIdx.x >> 6), nw = nb * 4;
  const float* mod = (const float*)(p.ws + WS_MOD);
  bf16_t* h = (bf16_t*)(p.ws + WS_H);
  for (int row = gw; row < T_; row += nw) {
    const int b = row >> 13;
    const f32x4* xr = (const f32x4*)(p.x + (size_t)row * 1024);
    f32x4 v[4]; float ss = 0.f;
#pragma unroll
    for (int i = 0; i < 4; ++i) { v[i] = xr[lane + 64 * i]; ss += v[i][0] * v[i][0] + v[i][1] * v[i][1] + v[i][2] * v[i][2] + v[i][3] * v[i][3]; }
    ss = wave_sum(ss);
    const float rstd = rsqrtf(ss * (1.f / 1024.f) + 1e-6f);
#pragma unroll
    for (int i = 0; i < 4; ++i) {
      const int col = 4 * lane + 256 * i;
      const f32x4 g4 = *(const f32x4*)(p.g_pre_mix + col), sh = *(const f32x4*)(mod + b * 6144 + col), sc = *(const f32x4*)(mod + b * 6144 + 1024 + col);
      const f32x4 y = (v[i] * rstd * g4) * (1.f + sc) + sh;
      u32x2 o = {pk2(y[0], y[1]), pk2(y[2], y[3])};
      *(u32x2*)(h + (size_t)row * 1024 + col) = o;
    }
  }
}

struct GemmArgs { const bf16_t* A; int lda; const bf16_t* Bt; int ldb; int K; };
DI int swz(int row, int c) { return row * 128 + ((c ^ ((row >> 1) & 7)) << 4); }
template <class Epi>
DI void gemm_tile(const GemmArgs& g, int m0, int n0, char* lds, const Epi& epi) {
  const int tid = threadIdx.x, lane = tid & 63, wid = tid >> 6, wr = wid >> 1, wc = wid & 1, fr = lane & 15, fq = lane >> 4;
  char* As = lds; char* Bs = lds + 16384;
  f32x4 acc[4][4];
#pragma unroll
  for (int i = 0; i < 4; ++i)
#pragma unroll
    for (int j = 0; j < 4; ++j) acc[i][j] = (f32x4){0.f, 0.f, 0.f, 0.f};
  const int srow = tid >> 3, sc = tid & 7;
  const bf16_t* ag = g.A + (size_t)(m0 + srow) * g.lda + sc * 8;
  const bf16_t* bg = g.Bt + (size_t)(n0 + srow) * g.ldb + sc * 8;
  u32x4 ra[4], rb[4];
#pragma unroll
  for (int i = 0; i < 4; ++i) { ra[i] = *(const u32x4*)(ag + (size_t)(32 * i) * g.lda); rb[i] = *(const u32x4*)(bg + (size_t)(32 * i) * g.ldb); }
  const int nk = g.K / 64;
  for (int kt = 0; kt < nk; ++kt) {
    __syncthreads();
#pragma unroll
    for (int i = 0; i < 4; ++i) { const int off = swz(srow + 32 * i, sc); *(u32x4*)(As + off) = ra[i]; *(u32x4*)(Bs + off) = rb[i]; }
    __syncthreads();
    if (kt + 1 < nk) {
#pragma unroll
      for (int i = 0; i < 4; ++i) { ra[i] = *(const u32x4*)(ag + (size_t)(32 * i) * g.lda + (kt + 1) * 64); rb[i] = *(const u32x4*)(bg + (size_t)(32 * i) * g.ldb + (kt + 1) * 64); }
    }
#pragma unroll
    for (int kk = 0; kk < 2; ++kk) {
      bf16x8 af[4], bfm[4];
#pragma unroll
      for (int i = 0; i < 4; ++i) { af[i] = *(const bf16x8*)(As + swz(wr * 64 + i * 16 + fr, kk * 4 + fq)); bfm[i] = *(const bf16x8*)(Bs + swz(wc * 64 + i * 16 + fr, kk * 4 + fq)); }
#pragma unroll
      for (int i = 0; i < 4; ++i)
#pragma unroll
        for (int j = 0; j < 4; ++j) acc[i][j] = MFMA16(bfm[j], af[i], acc[i][j]);
    }
  }
#pragma unroll
  for (int i = 0; i < 4; ++i)
#pragma unroll
    for (int j = 0; j < 4; ++j) epi(m0 + wr * 64 + i * 16 + fr, n0 + wc * 64 + j * 16 + 4 * fq, acc[i][j]);
}

struct EpiInproj {
  bf16_t* proj; float* small; const float *bbg, *b_fgate, *a_log, *dt_bias;
  DI void operator()(int row, int col, f32x4 v) const {
    if (col < 3584) { u32x2 o = {pk2(v[0], v[1]), pk2(v[2], v[3])}; *(u32x2*)(proj + (size_t)row * PP + col) = o; }
    else if (col < 5632) {
      const f32x4 b = *(const f32x4*)(bbg + (col - 3584));
      u32x2 o = {pk2(sigmoidf_(v[0] + b[0]), sigmoidf_(v[1] + b[1])), pk2(sigmoidf_(v[2] + b[2]), sigmoidf_(v[3] + b[3]))};
      *(u32x2*)(proj + (size_t)row * PP + col) = o;
    } else if (col < 5648) {
      const int j0 = col - 5632;
#pragma unroll
      for (int e = 0; e < 4; ++e) { const int j = j0 + e; float r;
        if (j < 8) r = -softplusf_(-(v[e] + b_fgate[j]));
        else if (j < 12) r = sigmoidf_(v[e]);
        else r = -__expf(a_log[j - 12]) * softplusf_(v[e] + dt_bias[j - 12]);
        small[(size_t)row * 16 + j] = r; }
    }
  }
};
DI void phase_inproj(const Params& p, int bid, int nb, char* lds) {
  GemmArgs g = {(const bf16_t*)(p.ws + WS_H), 1024, (const bf16_t*)(p.ws + WS_WIN), 1024, 1024};
  EpiInproj e = {(bf16_t*)(p.ws + WS_P), (float*)(p.ws + WS_SMALL), p.b_branch_gate, p.b_fgate, p.a_log, p.dt_bias};
  for (int t = bid; t < 256 * 45; t += nb) gemm_tile(g, (t / 45) * 128, (t % 45) * 128, lds, e);
}

DI void phase_foxcum(const Params& p, int bid, int nb, char* lds) {
  float* tot = (float*)lds;
  const float* small = (const float*)(p.ws + WS_SMALL);
  float* fneg = (float*)(p.ws + WS_FNEG);
  const int tid = threadIdx.x;
  for (int bh = bid; bh < 32; bh += nb) {
    const int b = bh >> 3, h = bh & 7;
    float v[32]; float run = 0.f;
#pragma unroll
    for (int i = 0; i < 32; ++i) { run += small[((size_t)b * S_ + tid * 32 + i) * 16 + h]; v[i] = run; }
    tot[tid] = run; __syncthreads();
    float off = 0.f; for (int j = 0; j < tid; ++j) off += tot[j];
#pragma unroll
    for (int i = 0; i < 32; ++i) fneg[(size_t)bh * S_ + tid * 32 + i] = -(v[i] + off) * LOG2E;
    __syncthreads();
  }
}

DI int swzv(int row, int c) { return row * 128 + ((c ^ (((row >> 1) & 7) ^ ((row & 2) << 1))) << 4); }
DI void attn_unit(const Params& p, int bh, int qb, char* lds) {
  const int tid = threadIdx.x, lane = tid & 63, wid = tid >> 6, r32 = lane & 31, hi = lane >> 5;
  const int b = bh >> 3, h = bh & 7;
  bf16_t* proj = (bf16_t*)(p.ws + WS_P);
  const float* fneg = (const float*)(p.ws + WS_FNEG) + (size_t)bh * S_;
  const size_t rowbase = (size_t)b * S_;
  char* Ks = lds; char* Vs = lds + 8192; float* Fs = (float*)(lds + 16384);
  const LAS char* Vs3 = (const LAS char*)Vs;
  const int qrow = qb * 128 + wid * 32 + r32;
  bf16_t* qptr = proj + (rowbase + qrow) * PP + h * 64;
  bf16x8 qr[4];
  {
    const float c2 = 0.125f * LOG2E;
#pragma unroll
    for (int ks = 0; ks < 4; ++ks) { const u32x4 w = *(const u32x4*)(qptr + ks * 16 + hi * 8);
      qr[ks] = pack8(bflo(w[0]) * c2, bfhi(w[0]) * c2, bflo(w[1]) * c2, bfhi(w[1]) * c2, bflo(w[2]) * c2, bfhi(w[2]) * c2, bflo(w[3]) * c2, bfhi(w[3]) * c2); }
  }
  f32x16 o0, o1;
#pragma unroll
  for (int r = 0; r < 16; ++r) { o0[r] = 0.f; o1[r] = 0.f; }
  float m = -1e30f, l = 0.f;
  const int ntiles = 2 * qb + 2;
  const int srow = tid >> 3, sc = tid & 7;
  const bf16_t* kg = proj + (rowbase + srow) * PP + 512 + h * 64 + sc * 8;
  const bf16_t* vg = proj + (rowbase + srow) * PP + 1024 + h * 64 + sc * 8;
  u32x4 rk[2], rv[2]; f32x4 rf = {0.f, 0.f, 0.f, 0.f};
#pragma unroll
  for (int i = 0; i < 2; ++i) { rk[i] = *(const u32x4*)(kg + (size_t)(32 * i) * PP); rv[i] = *(const u32x4*)(vg + (size_t)(32 * i) * PP); }
  if (tid < 16) rf = *(const f32x4*)(fneg + tid * 4);
  const int wave_maxrow = qb * 128 + wid * 32 + 31;
  for (int j = 0; j < ntiles; ++j) {
    __syncthreads();
#pragma unroll
    for (int i = 0; i < 2; ++i) { *(u32x4*)(Ks + swz(srow + 32 * i, sc)) = rk[i]; *(u32x4*)(Vs + swzv(srow + 32 * i, sc)) = rv[i]; }
    if (tid < 16) *(f32x4*)(Fs + tid * 4) = rf;
    __syncthreads();
    if (j + 1 < ntiles) {
#pragma unroll
      for (int i = 0; i < 2; ++i) { rk[i] = *(const u32x4*)(kg + (size_t)((j + 1) * 64 + 32 * i) * PP); rv[i] = *(const u32x4*)(vg + (size_t)((j + 1) * 64 + 32 * i) * PP); }
      if (tid < 16) rf = *(const f32x4*)(fneg + (j + 1) * 64 + tid * 4);
    }
    if (j * 64 > wave_maxrow) continue;
    f32x16 p0, p1;
#pragma unroll
    for (int g = 0; g < 4; ++g) { const f32x4 a = *(const f32x4*)(Fs + 8 * g + 4 * hi), c = *(const f32x4*)(Fs + 32 + 8 * g + 4 * hi);
#pragma unroll
      for (int e = 0; e < 4; ++e) { p0[4 * g + e] = a[e]; p1[4 * g + e] = c[e]; } }
#pragma unroll
    for (int ks = 0; ks < 4; ++ks) {
      const bf16x8 k0 = *(const bf16x8*)(Ks + swz(r32, 2 * ks + hi)), k1 = *(const bf16x8*)(Ks + swz(32 + r32, 2 * ks + hi));
      p0 = MFMA32(k0, qr[ks], p0); p1 = MFMA32(k1, qr[ks], p1);
    }
    if (j >= 2 * qb) {
      const int kb = j * 64;
#pragma unroll
      for (int r = 0; r < 16; ++r) { const int kv = kb + crow(r, hi); if (kv > qrow) p0[r] = -INFINITY; if (kv + 32 > qrow) p1[r] = -INFINITY; }
    }
    float mx = fmaxf(p0[0], p1[0]);
#pragma unroll
    for (int r = 1; r < 16; ++r) mx = fmaxf(mx, fmaxf(p0[r], p1[r]));
    mx = fmaxf(mx, __shfl_xor(mx, 32));
    const float mn = fmaxf(m, mx), alpha = exp2f(m - mn); m = mn;
    float ps = 0.f;
#pragma unroll
    for (int r = 0; r < 16; ++r) { p0[r] = exp2f(p0[r] - mn); p1[r] = exp2f(p1[r] - mn); ps += p0[r] + p1[r]; }
    l = l * alpha + ps;
#pragma unroll
    for (int r = 0; r < 16; ++r) { o0[r] *= alpha; o1[r] *= alpha; }
    bf16x8 pf[2][2];
    pf[0][0] = pack8(p0[0], p0[1], p0[2], p0[3], p0[4], p0[5], p0[6], p0[7]);
    pf[0][1] = pack8(p0[8], p0[9], p0[10], p0[11], p0[12], p0[13], p0[14], p0[15]);
    pf[1][0] = pack8(p1[0], p1[1], p1[2], p1[3], p1[4], p1[5], p1[6], p1[7]);
    pf[1][1] = pack8(p1[8], p1[9], p1[10], p1[11], p1[12], p1[13], p1[14], p1[15]);
#pragma unroll
    for (int pb = 0; pb < 2; ++pb)
#pragma unroll
      for (int s = 0; s < 2; ++s) {
        const int rowa = 32 * pb + 16 * s + 4 * hi + ((lane & 15) >> 2);
#pragma unroll
        for (int d0 = 0; d0 < 2; ++d0) {
          const int cl = 4 * d0 + 2 * ((lane >> 4) & 1) + ((lane & 3) >> 1), sub = 8 * (lane & 1);
          const s16x4 lo = tr16(Vs3 + swzv(rowa, cl) + sub), hi4 = tr16(Vs3 + swzv(rowa + 8, cl) + sub);
          const bf16x8 vf = cat8(lo, hi4);
          if (d0 == 0) o0 = MFMA32(vf, pf[pb][s], o0); else o1 = MFMA32(vf, pf[pb][s], o1);
        }
      }
  }
  l += __shfl_xor(l, 32);
  const float inv = 1.f / l;
#pragma unroll
  for (int g = 0; g < 4; ++g) {
    u32x2 a = {pk2(o0[4 * g] * inv, o0[4 * g + 1] * inv), pk2(o0[4 * g + 2] * inv, o0[4 * g + 3] * inv)};
    u32x2 c = {pk2(o1[4 * g] * inv, o1[4 * g + 1] * inv), pk2(o1[4 * g + 2] * inv, o1[4 * g + 3] * inv)};
    *(u32x2*)(qptr + 8 * g + 4 * hi) = a; *(u32x2*)(qptr + 32 + 8 * g + 4 * hi) = c;
  }
}
DI void phase_attn(const Params& p, int bid, int nb, char* lds) {
  for (int u = bid; u < 2048; u += nb) attn_unit(p, u & 31, 63 - (u >> 5), lds);
}

constexpr int QP = 136;
DI void gdn_prep_unit(const Params& p, int U, char* lds) {
  const int tid = threadIdx.x, lane = tid & 63, wid = tid >> 6, fr = lane & 15, fq = lane >> 4;
  const int b = U >> 9, h = (U >> 7) & 3, c = U & 127;
  const size_t t0 = (size_t)b * S_ + c * 64;
  const int s0 = c * 64;
  const bf16_t* proj = (const bf16_t*)(p.ws + WS_P);
  const float* small = (const float*)(p.ws + WS_SMALL);
  bf16_t* q_s = (bf16_t*)lds; bf16_t* k_s = q_s + 64 * QP; bf16_t* v_s = k_s + 64 * QP;
  float* Lm = (float*)(lds + 3 * 17408);
  bf16_t* T1 = (bf16_t*)Lm; bf16_t* T2 = T1 + 64 * 72;
  float* gcs = (float*)(lds + 3 * 17408 + 18432);
  bf16_t* QF = (bf16_t*)((char*)p.out) + (size_t)U * 8192;
  bf16_t* KF = (bf16_t*)((char*)p.out + 32 * MiB) + (size_t)U * 8192;
  bf16_t* AF = (bf16_t*)((char*)p.out + 64 * MiB) + (size_t)U * 4096;
  bf16_t* UF = (bf16_t*)(p.ws + WS_UF) + (size_t)U * 8192;
  bf16_t* WF = (bf16_t*)(p.ws + WS_WF) + (size_t)U * 8192;
  __syncthreads();
  if (wid == 0) {
    const float g = small[(t0 + lane) * 16 + 12 + h], bt = small[(t0 + lane) * 16 + 8 + h];
    float cs = g;
#pragma unroll
    for (int d = 1; d < 64; d <<= 1) { const float n = __shfl_up(cs, d); if (lane >= d) cs += n; }
    const float gl = __shfl(cs, 63);
    gcs[lane] = cs; gcs[64 + lane] = bt; gcs[128 + lane] = __expf(cs); gcs[192 + lane] = __expf(gl - cs);
    if (lane == 0) { gcs[256] = __expf(gl); ((float*)(p.ws + WS_GL))[U] = __expf(gl); }
  }
  __syncthreads();
  {
#pragma unroll
    for (int X = 0; X < 3; ++X) {
      const int col = 1536 + 512 * X + h * 128 + 2 * lane, cb = 512 * X + h * 128 + 2 * lane;
      float w0[4], w1[4];
#pragma unroll
      for (int j = 0; j < 4; ++j) { w0[j] = p.conv_w[j * 1536 + cb]; w1[j] = p.conv_w[j * 1536 + cb + 1]; }
      bf16_t* dst = X == 0 ? q_s : (X == 1 ? k_s : v_s);
      float xa[4], xb[4];
      const int i0 = 16 * wid;
#pragma unroll
      for (int j = 0; j < 3; ++j) { const int rr = i0 - 3 + j; unsigned u = 0u; if (s0 + rr >= 0) u = *(const unsigned*)(proj + (size_t)((long)t0 + rr) * PP + col); xa[j + 1] = bflo(u); xb[j + 1] = bfhi(u); }
      for (int i = i0; i < i0 + 16; ++i) {
        xa[0] = xa[1]; xa[1] = xa[2]; xa[2] = xa[3]; xb[0] = xb[1]; xb[1] = xb[2]; xb[2] = xb[3];
        const unsigned u = *(const unsigned*)(proj + (t0 + i) * PP + col); xa[3] = bflo(u); xb[3] = bfhi(u);
        float y0 = w0[0] * xa[0] + w0[1] * xa[1] + w0[2] * xa[2] + w0[3] * xa[3];
        float y1 = w1[0] * xb[0] + w1[1] * xb[1] + w1[2] * xb[2] + w1[3] * xb[3];
        y0 = y0 * sigmoidf_(y0); y1 = y1 * sigmoidf_(y1);
        if (X < 2) { const float ss = wave_sum(y0 * y0 + y1 * y1); const float rn = rsqrtf(ss + 1e-6f); y0 *= rn; y1 *= rn; }
        *(unsigned*)(dst + i * QP + 2 * lane) = pk2(y0, y1);
        if (X == 0) {
          const float f = 0.08838834764831845f * gcs[128 + i];
          const int d = 2 * lane, mm = d >> 5, ss2 = (d >> 4) & 1, aa = (d >> 3) & 1, hh = (d >> 2) & 1, bb = d & 3;
          const int lp = (i & 31) + 32 * hh;
          *(unsigned*)(QF + (size_t)(((((i >> 5) * 4 + mm) * 2 + ss2) * 64 + lp) * 8 + 4 * aa + bb)) = pk2(y0 * f, y1 * f);
        }
      }
    }
  }
  __syncthreads();
  {
    bf16x8 ka[4];
#pragma unroll
    for (int kk = 0; kk < 4; ++kk) ka[kk] = *(const bf16x8*)(k_s + (16 * wid + fr) * QP + kk * 32 + fq * 8);
#pragma unroll
    for (int ni = 0; ni < 4; ++ni) {
      f32x4 dkk = {0.f, 0.f, 0.f, 0.f}, dqk = {0.f, 0.f, 0.f, 0.f};
      const int i = 16 * ni + fr, jj0 = 16 * wid + 4 * fq;
      if (ni >= wid) {
#pragma unroll
        for (int kk = 0; kk < 4; ++kk) {
          const bf16x8 bk = *(const bf16x8*)(k_s + (16 * ni + fr) * QP + kk * 32 + fq * 8), bq = *(const bf16x8*)(q_s + (16 * ni + fr) * QP + kk * 32 + fq * 8);
          dkk = MFMA16(ka[kk], bk, dkk); dqk = MFMA16(ka[kk], bq, dqk);
        }
      }
      const float gi = gcs[i], bi = gcs[64 + i];
      f32x4 lv, av;
#pragma unroll
      for (int r = 0; r < 4; ++r) { const int jj = jj0 + r; const float dec = __expf(fminf(gi - gcs[jj], 0.f));
        lv[r] = (jj < i) ? bi * dkk[r] * dec : 0.f; av[r] = (jj <= i) ? dqk[r] * 0.08838834764831845f * dec : 0.f; }
      *(f32x4*)(Lm + i * 68 + jj0) = lv;
      const int lp = (i & 31) + 32 * (fq & 1);
      u32x2 o = {pk2(av[0], av[1]), pk2(av[2], av[3])};
      *(u32x2*)(AF + (size_t)((((((i >> 5) * 2 + (wid >> 1)) * 2 + (wid & 1)) * 64 + lp) * 8) + 4 * (fq >> 1))) = o;
    }
    for (int it = tid; it < 2048; it += NT) {
      const int d = it & 127, jg = it >> 7;
      float v4[4];
#pragma unroll
      for (int e = 0; e < 4; ++e) { const int jj = 4 * jg + e; v4[e] = bf2f(k_s[jj * QP + d]) * gcs[192 + jj]; }
      const int lp = (d & 31) + 32 * (jg & 1);
      u32x2 o = {pk2(v4[0], v4[1]), pk2(v4[2], v4[3])};
      *(u32x2*)(KF + (size_t)((((((d >> 5) * 2 + (jg >> 3)) * 2 + ((jg >> 2) & 1)) * 64 + lp) * 8) + 4 * ((jg >> 1) & 1))) = o;
    }
  }
  __syncthreads();
  if (wid == 0) {
    float* Ts = (float*)q_s;
    for (int i = 0; i < 64; ++i) {
      float a0 = (lane == i) ? 1.f : 0.f, a1 = 0.f, a2 = 0.f, a3 = 0.f;
      const float* Li = Lm + i * 68;
      int j = 0;
#pragma unroll 4
      for (; j + 4 <= i; j += 4) {
        const f32x4 Lv = *(const f32x4*)(Li + j);
        a0 -= Lv[0] * Ts[j * 64 + lane]; a1 -= Lv[1] * Ts[(j + 1) * 64 + lane]; a2 -= Lv[2] * Ts[(j + 2) * 64 + lane]; a3 -= Lv[3] * Ts[(j + 3) * 64 + lane];
      }
      for (; j < i; ++j) a0 -= Li[j] * Ts[j * 64 + lane];
      Ts[i * 64 + lane] = (a0 + a1) + (a2 + a3);
    }
    const float f1 = gcs[64 + lane], f2 = f1 * gcs[128 + lane];
    asm volatile("" ::: "memory");
    for (int i = 0; i < 64; ++i) { const float t = Ts[i * 64 + lane]; T1[i * 72 + lane] = f2bf(t * f1); T2[i * 72 + lane] = f2bf(t * f2); }
  }
  __syncthreads();
  {
    const LAS char* v3 = (const LAS char*)v_s; const LAS char* k3 = (const LAS char*)k_s;
    bf16x8 ta[2], tb[2];
#pragma unroll
    for (int kk = 0; kk < 2; ++kk) { ta[kk] = *(const bf16x8*)(T1 + (16 * wid + fr) * 72 + kk * 32 + fq * 8); tb[kk] = *(const bf16x8*)(T2 + (16 * wid + fr) * 72 + kk * 32 + fq * 8); }
#pragma unroll
    for (int nj = 0; nj < 8; ++nj) {
      f32x4 du = {0.f, 0.f, 0.f, 0.f}, dw = {0.f, 0.f, 0.f, 0.f};
#pragma unroll
      for (int kk = 0; kk < 2; ++kk) {
        const int jr = 32 * kk + 8 * fq + ((lane & 15) >> 2), cc = 16 * nj + 4 * (lane & 3);
        const bf16x8 vb = cat8(tr16(v3 + (jr * QP + cc) * 2), tr16(v3 + ((jr + 4) * QP + cc) * 2));
        const bf16x8 kb = cat8(tr16(k3 + (jr * QP + cc) * 2), tr16(k3 + ((jr + 4) * QP + cc) * 2));
        du = MFMA16(ta[kk], vb, du);
        dw = MFMA16(kb, tb[kk], dw);
      }
      {
        const int lp = 16 * (nj & 1) + fr + 32 * (fq & 1);
        u32x2 o = {pk2(du[0], du[1]), pk2(du[2], du[3])};
        *(u32x2*)(UF + (size_t)(((((wid >> 1) * 4 + (nj >> 1)) * 64 + lp) * 16) + 4 * (2 * (wid & 1) + (fq >> 1)))) = o;
      }
      {
        const int lp = 16 * (wid & 1) + fr + 32 * (fq & 1);
        u32x2 o = {pk2(-dw[0], -dw[1]), pk2(-dw[2], -dw[3])};
        *(u32x2*)(WF + (size_t)((((((wid >> 1) * 4 + (nj >> 1)) * 2 + (nj & 1)) * 64 + lp) * 8) + 4 * (fq >> 1))) = o;
      }
    }
  }
}
DI void phase_gdnprep(const Params& p, int bid, int nb, char* lds) {
  for (int U = bid; U < 2048; U += nb) gdn_prep_unit(p, U, lds);
}

DI bf16x8 packS(const f32x16& x, int s) { return pack8(x[8 * s], x[8 * s + 1], x[8 * s + 2], x[8 * s + 3], x[8 * s + 4], x[8 * s + 5], x[8 * s + 6], x[8 * s + 7]); }
DI void gdn_scan_seq(const Params& p, int bh16) {
  const int tid = threadIdx.x, lane = tid & 63, wv = tid >> 6, r32 = lane & 31, hi = lane >> 5;
  const int b = bh16 >> 2, h = bh16 & 3;
  bf16_t* proj = (bf16_t*)(p.ws + WS_P);
  const float* glp = (const float*)(p.ws + WS_GL);
  f32x16 S[4];
#pragma unroll
  for (int m = 0; m < 4; ++m)
#pragma unroll
    for (int r = 0; r < 16; ++r) S[m][r] = 0.f;
  for (int c = 0; c < 128; ++c) {
    const int U = bh16 * 128 + c;
    const bf16x8* QF = (const bf16x8*)((const bf16_t*)((char*)p.out) + (size_t)U * 8192) + lane;
    const bf16x8* KF = (const bf16x8*)((const bf16_t*)((char*)p.out + 32 * MiB) + (size_t)U * 8192) + lane;
    const bf16x8* AF = (const bf16x8*)((const bf16_t*)((char*)p.out + 64 * MiB) + (size_t)U * 4096) + lane;
    const bf16x8* WF = (const bf16x8*)((const bf16_t*)(p.ws + WS_WF) + (size_t)U * 8192) + lane;
    const bf16_t* UF = (const bf16_t*)(p.ws + WS_UF) + (size_t)U * 8192;
    const float gl = glp[U];
    bf16x8 Sb[4][2];
#pragma unroll
    for (int m = 0; m < 4; ++m) { Sb[m][0] = packS(S[m], 0); Sb[m][1] = packS(S[m], 1); }
    f32x16 vn[2], o[2];
#pragma unroll
    for (int i2 = 0; i2 < 2; ++i2) {
      const u32x4 ua = *(const u32x4*)(UF + (size_t)((i2 * 4 + wv) * 64 + lane) * 16), ub = *(const u32x4*)(UF + (size_t)((i2 * 4 + wv) * 64 + lane) * 16 + 8);
#pragma unroll
      for (int e = 0; e < 4; ++e) { vn[i2][2 * e] = bflo(ua[e]); vn[i2][2 * e + 1] = bfhi(ua[e]); vn[i2][8 + 2 * e] = bflo(ub[e]); vn[i2][8 + 2 * e + 1] = bfhi(ub[e]); }
#pragma unroll
      for (int m = 0; m < 4; ++m)
#pragma unroll
        for (int s = 0; s < 2; ++s) vn[i2] = MFMA32(WF[((i2 * 4 + m) * 2 + s) * 64], Sb[m][s], vn[i2]);
      asm volatile("" ::: "memory");
    }
#pragma unroll
    for (int i2 = 0; i2 < 2; ++i2) {
#pragma unroll
      for (int r = 0; r < 16; ++r) o[i2][r] = 0.f;
#pragma unroll
      for (int m = 0; m < 4; ++m)
#pragma unroll
        for (int s = 0; s < 2; ++s) o[i2] = MFMA32(QF[((i2 * 4 + m) * 2 + s) * 64], Sb[m][s], o[i2]);
      asm volatile("" ::: "memory");
    }
    bf16x8 Vb[2][2];
#pragma unroll
    for (int j2 = 0; j2 < 2; ++j2) { Vb[j2][0] = packS(vn[j2], 0); Vb[j2][1] = packS(vn[j2], 1); }
#pragma unroll
    for (int i2 = 0; i2 < 2; ++i2)
#pragma unroll
      for (int j2 = 0; j2 <= i2; ++j2)
#pragma unroll
        for (int s = 0; s < 2; ++s) o[i2] = MFMA32(AF[((i2 * 2 + j2) * 2 + s) * 64], Vb[j2][s], o[i2]);
    asm volatile("" ::: "memory");
#pragma unroll
    for (int m = 0; m < 4; ++m) {
      asm volatile("" ::: "memory");
#pragma unroll
      for (int r = 0; r < 16; ++r) S[m][r] *= gl;
#pragma unroll
      for (int j2 = 0; j2 < 2; ++j2)
#pragma unroll
        for (int s = 0; s < 2; ++s) S[m] = MFMA32(KF[((m * 2 + j2) * 2 + s) * 64], Vb[j2][s], S[m]);
    }
    const size_t t0 = (size_t)b * S_ + c * 64;
#pragma unroll
    for (int i2 = 0; i2 < 2; ++i2)
#pragma unroll
      for (int r = 0; r < 16; ++r) proj[(t0 + 32 * i2 + crow(r, hi)) * PP + 1536 + h * 128 + 32 * wv + r32] = f2bf(o[i2][r]);
  }
}
DI void phase_gdnscan(const Params& p, int bid, int nb) {
  for (int s = bid; s < 16; s += nb) gdn_scan_seq(p, s);
}
DI void phase_gdnout(const Params& p, int bid, int nb) {
  const int lane = threadIdx.x & 63, gw = bid * 4 + (threadIdx.x >> 6), nw = nb * 4;
  bf16_t* proj = (bf16_t*)(p.ws + WS_P);
  const f32x4 w0 = *(const f32x4*)(p.gdn_norm_w + (lane & 15) * 8), w1 = *(const f32x4*)(p.gdn_norm_w + (lane & 15) * 8 + 4);
  for (int row = gw; row < T_; row += nw) {
    bf16_t* op = proj + (size_t)row * PP + 1536 + lane * 8;
    const u32x4 ov = *(const u32x4*)op, zv = *(const u32x4*)(proj + (size_t)row * PP + 3072 + lane * 8);
    float o[8], z[8];
#pragma unroll
    for (int e = 0; e < 4; ++e) { o[2 * e] = bflo(ov[e]); o[2 * e + 1] = bfhi(ov[e]); z[2 * e] = bflo(zv[e]); z[2 * e + 1] = bfhi(zv[e]); }
    float ss = 0.f;
#pragma unroll
    for (int e = 0; e < 8; ++e) ss += o[e] * o[e];
    ss += __shfl_xor(ss, 1); ss += __shfl_xor(ss, 2); ss += __shfl_xor(ss, 4); ss += __shfl_xor(ss, 8);
    const float rstd = rsqrtf(ss * (1.f / 128.f) + 1e-6f);
    float y[8];
#pragma unroll
    for (int e = 0; e < 8; ++e) { const float w = e < 4 ? w0[e] : w1[e - 4]; y[e] = o[e] * rstd * w * (z[e] * sigmoidf_(z[e])); }
    u32x4 r = {pk2(y[0], y[1]), pk2(y[2], y[3]), pk2(y[4], y[5]), pk2(y[6], y[7])};
    *(u32x4*)op = r;
  }
}

struct EpiMergeA {
  const bf16_t* proj; bf16_t* mp;
  DI void operator()(int row, int col, f32x4 v) const {
    const u32x2 g = *(const u32x2*)(proj + (size_t)row * PP + 3584 + col);
    u32x2 o = {pk2(v[0] * bflo(g[0]), v[1] * bfhi(g[0])), pk2(v[2] * bflo(g[1]), v[3] * bfhi(g[1]))};
    *(u32x2*)(mp + (size_t)row * 1024 + col) = o;
  }
};
struct EpiMergeB {
  const bf16_t* proj; bf16_t* mp;
  DI void operator()(int row, int col, f32x4 v) const {
    const u32x2 g = *(const u32x2*)(proj + (size_t)row * PP + 4608 + col);
    const u32x2 q = *(const u32x2*)(mp + (size_t)row * 1024 + col);
    u32x2 o = {pk2(bflo(q[0]) + v[0] * bflo(g[0]), bfhi(q[0]) + v[1] * bfhi(g[0])), pk2(bflo(q[1]) + v[2] * bflo(g[1]), bfhi(q[1]) + v[3] * bfhi(g[1]))};
    *(u32x2*)(mp + (size_t)row * 1024 + col) = o;
  }
};
struct EpiF32 { float* out; int ld; DI void operator()(int row, int col, f32x4 v) const { *(f32x4*)(out + (size_t)row * ld + col) = v; } };
struct EpiBf16 { bf16_t* out; int ld; DI void operator()(int row, int col, f32x4 v) const { u32x2 o = {pk2(v[0], v[1]), pk2(v[2], v[3])}; *(u32x2*)(out + (size_t)row * ld + col) = o; } };
DI void phase_merge(const Params& p, int bid, int nb, char* lds) {
  const bf16_t* proj = (const bf16_t*)(p.ws + WS_P);
  GemmArgs ga = {proj, PP, (const bf16_t*)(p.ws + WS_WFO), 512, 512};
  GemmArgs gb = {proj + 1536, PP, (const bf16_t*)(p.ws + WS_WGO), 512, 512};
  EpiMergeA ea = {proj, (bf16_t*)(p.ws + WS_H)};
  EpiMergeB eb = {proj, (bf16_t*)(p.ws + WS_H)};
  for (int t = bid; t < 256 * 8; t += nb) { gemm_tile(ga, (t >> 3) * 128, (t & 7) * 128, lds, ea); gemm_tile(gb, (t >> 3) * 128, (t & 7) * 128, lds, eb); }
}
DI void phase_wout(const Params& p, int bid, int nb, char* lds) {
  GemmArgs g = {(const bf16_t*)(p.ws + WS_H), 1024, (const bf16_t*)(p.ws + WS_WOUT), 1024, 1024};
  EpiF32 e = {p.out, 1024};
  for (int t = bid; t < 256 * 8; t += nb) gemm_tile(g, (t >> 3) * 128, (t & 7) * 128, lds, e);
}
DI void phase_rows1(const Params& p, int bid, int nb) {
  const int lane = threadIdx.x & 63, gw = bid * 4 + (threadIdx.x >> 6), nw = nb * 4;
  const float* mod = (const float*)(p.ws + WS_MOD);
  bf16_t* h2 = (bf16_t*)(p.ws + WS_H);
  for (int row = gw; row < T_; row += nw) {
    const int b = row >> 13;
    f32x4* mr = (f32x4*)(p.out + (size_t)row * 1024);
    const f32x4* xr = (const f32x4*)(p.x + (size_t)row * 1024);
    f32x4 v[4]; float ss = 0.f;
#pragma unroll
    for (int i = 0; i < 4; ++i) { v[i] = mr[lane + 64 * i]; ss += v[i][0] * v[i][0] + v[i][1] * v[i][1] + v[i][2] * v[i][2] + v[i][3] * v[i][3]; }
    ss = wave_sum(ss);
    const float rstd = rsqrtf(ss * (1.f / 1024.f) + 1e-6f);
    float s2 = 0.f;
#pragma unroll
    for (int i = 0; i < 4; ++i) {
      const int col = 4 * lane + 256 * i;
      const f32x4 g4 = *(const f32x4*)(p.g_post_mix + col), gt = *(const f32x4*)(mod + b * 6144 + 2048 + col);
      v[i] = xr[lane + 64 * i] + gt * (v[i] * rstd * g4);
      mr[lane + 64 * i] = v[i];
      s2 += v[i][0] * v[i][0] + v[i][1] * v[i][1] + v[i][2] * v[i][2] + v[i][3] * v[i][3];
    }
    s2 = wave_sum(s2);
    const float rstd2 = rsqrtf(s2 * (1.f / 1024.f) + 1e-6f);
#pragma unroll
    for (int i = 0; i < 4; ++i) {
      const int col = 4 * lane + 256 * i;
      const f32x4 g4 = *(const f32x4*)(p.g_pre_ffn + col), sh = *(const f32x4*)(mod + b * 6144 + 3072 + col), sc = *(const f32x4*)(mod + b * 6144 + 4096 + col);
      const f32x4 y = (v[i] * rstd2 * g4) * (1.f + sc) + sh;
      u32x2 o = {pk2(y[0], y[1]), pk2(y[2], y[3])};
      *(u32x2*)(h2 + (size_t)row * 1024 + col) = o;
    }
  }
}

DI void phase_peerq(const Params& p, int bid, int nb, char* lds) {
  GemmArgs g = {(const bf16_t*)(p.ws + WS_H), 1024, (const bf16_t*)(p.ws + WS_WQ), 1024, 1024};
  EpiBf16 e = {(bf16_t*)(p.ws + WS_QY), 2048};
  for (int t = bid; t < 256 * 16; t += nb) gemm_tile(g, (t >> 4) * 128, (t & 15) * 128, lds, e);
}
DI unsigned ordkey(float f) { const unsigned u = __float_as_uint(f); return (u & 0x80000000u) ? ~u : (u | 0x80000000u); }
DI void peer_select_unit(const Params& p, int unit, char* lds) {
  const int tid = threadIdx.x, lane = tid & 63, wid = tid >> 6, fr = lane & 15, fq = lane >> 4;
  const int h = unit & 7, t0 = (unit >> 3) * 32;
  float* sc = (float*)lds;
  float* topv = (float*)(lds + 2 * 32 * 132 * 4);
  int* topi = (int*)(topv + 2 * 32 * 16);
  const bf16_t* qy = (const bf16_t*)(p.ws + WS_QY);
  const bf16_t* keys = (const bf16_t*)(p.ws + WS_KEYS);
  __syncthreads();
  {
    const int set = wid >> 1, ts = wid & 1;
    bf16x8 qa[4];
#pragma unroll
    for (int kk = 0; kk < 4; ++kk) qa[kk] = *(const bf16x8*)(qy + (size_t)(t0 + 16 * ts + fr) * 2048 + h * 256 + set * 128 + kk * 32 + fq * 8);
#pragma unroll
    for (int nj = 0; nj < 8; ++nj) {
      f32x4 d = {0.f, 0.f, 0.f, 0.f};
#pragma unroll
      for (int kk = 0; kk < 4; ++kk) { const bf16x8 kb = *(const bf16x8*)(keys + set * 16384 + (16 * nj + fr) * 128 + kk * 32 + fq * 8); d = MFMA16(qa[kk], kb, d); }
#pragma unroll
      for (int r = 0; r < 4; ++r) sc[(set * 32 + 16 * ts + 4 * fq + r) * 132 + 16 * nj + fr] = d[r];
    }
  }
  __syncthreads();
  for (int it = 0; it < 16; ++it) {
    const int rr = 16 * wid + it;
    const float* srow = sc + rr * 132;
    unsigned k0 = (ordkey(srow[lane]) & ~127u) | (unsigned)(127 - lane), k1 = (ordkey(srow[lane + 64]) & ~127u) | (unsigned)(63 - lane);
    int myidx = 0;
    for (int rd = 0; rd < 16; ++rd) {
      const unsigned km = wave_max_u(k0 > k1 ? k0 : k1);
      const int idx = 127 - (int)(km & 127u);
      if (lane == (idx & 63)) { if (idx < 64) k0 = 0u; else k1 = 0u; }
      if (lane == rd) myidx = idx;
    }
    if (lane < 16) { topv[rr * 16 + lane] = srow[myidx]; topi[rr * 16 + lane] = myidx; }
  }
  __syncthreads();
  for (int it = 0; it < 8; ++it) {
    const int tok = 8 * wid + it;
    const float* v1 = topv + tok * 16; const float* v2 = topv + (32 + tok) * 16;
    const int a = lane >> 2, b0 = 4 * (lane & 3);
    unsigned kc[4];
#pragma unroll
    for (int e = 0; e < 4; ++e) kc[e] = (ordkey(v1[a] + v2[b0 + e]) & ~255u) | (unsigned)(255 - (a * 16 + b0 + e));
    int mypos = 0;
    for (int rd = 0; rd < 16; ++rd) {
      unsigned mloc = kc[0] > kc[1] ? kc[0] : kc[1]; const unsigned m2 = kc[2] > kc[3] ? kc[2] : kc[3]; mloc = mloc > m2 ? mloc : m2;
      const unsigned km = wave_max_u(mloc);
      const int pos = 255 - (int)(km & 255u);
      if (lane == (pos >> 2)) {
#pragma unroll
        for (int e = 0; e < 4; ++e) if ((pos & 3) == e) kc[e] = 0u;
      }
      if (lane == rd) mypos = pos;
    }
    const float val = v1[mypos >> 4] + v2[mypos & 15];
    const int ei = topi[tok * 16 + (mypos >> 4)] * 128 + topi[(32 + tok) * 16 + (mypos & 15)];
    const float mx = __shfl(val, 0);
    const float ex = __expf(val - mx);
    float sm = ex; sm += __shfl_xor(sm, 1); sm += __shfl_xor(sm, 2); sm += __shfl_xor(sm, 4); sm += __shfl_xor(sm, 8);
    if (lane < 16) {
      const size_t o = ((size_t)(t0 + tok) * 8 + h) * 16 + lane;
      ((int*)(p.ws + WS_EIDX))[o] = ei; ((float*)(p.ws + WS_GATE))[o] = ex / sm;
    }
  }
}
DI void phase_peersel(const Params& p, int bid, int nb, char* lds) {
  for (int u = bid; u < 8192; u += nb) peer_select_unit(p, u, lds);
}
DI void phase_peergather(const Params& p, int bid, int nb) {
  const int lane = threadIdx.x & 63, gw = bid * 4 + (threadIdx.x >> 6), nw = nb * 4;
  const float* mod = (const float*)(p.ws + WS_MOD);
  const bf16_t* h2 = (const bf16_t*)(p.ws + WS_H);
  const bf16_t* pu = (const bf16_t*)(p.ws + WS_PU); const bf16_t* pv = (const bf16_t*)(p.ws + WS_PV);
  const int* eidx = (const int*)(p.ws + WS_EIDX); const float* gate = (const float*)(p.ws + WS_GATE);
  for (int t = gw; t < T_; t += nw) {
    const int b = t >> 13;
    float hx[16];
    { const u32x4 a = *(const u32x4*)(h2 + (size_t)t * 1024 + 8 * lane), c = *(const u32x4*)(h2 + (size_t)t * 1024 + 512 + 8 * lane);
#pragma unroll
      for (int e = 0; e < 4; ++e) { hx[2 * e] = bflo(a[e]); hx[2 * e + 1] = bfhi(a[e]); hx[8 + 2 * e] = bflo(c[e]); hx[8 + 2 * e + 1] = bfhi(c[e]); } }
    const int e0 = eidx[(size_t)t * 128 + lane], e1 = eidx[(size_t)t * 128 + 64 + lane];
    const float g0 = gate[(size_t)t * 128 + lane], g1 = gate[(size_t)t * 128 + 64 + lane];
    float y[16];
#pragma unroll
    for (int e = 0; e < 16; ++e) y[e] = 0.f;
    for (int sl = 0; sl < 128; sl += 4) {
      int ex[4]; float gx[4]; u32x4 ua[4], ub[4];
#pragma unroll
      for (int q = 0; q < 4; ++q) {
        const int s = sl + q;
        ex[q] = __builtin_amdgcn_readlane(s < 64 ? e0 : e1, s & 63);
        gx[q] = __uint_as_float(__builtin_amdgcn_readlane(__float_as_uint(s < 64 ? g0 : g1), s & 63));
        ua[q] = *(const u32x4*)(pu + (size_t)ex[q] * 1024 + 8 * lane); ub[q] = *(const u32x4*)(pu + (size_t)ex[q] * 1024 + 512 + 8 * lane);
      }
      float coef[4];
#pragma unroll
      for (int q = 0; q < 4; ++q) {
        float d = 0.f;
#pragma unroll
        for (int e = 0; e < 4; ++e) { d += hx[2 * e] * bflo(ua[q][e]) + hx[2 * e + 1] * bfhi(ua[q][e]); d += hx[8 + 2 * e] * bflo(ub[q][e]) + hx[8 + 2 * e + 1] * bfhi(ub[q][e]); }
        d = wave_sum(d);
        coef[q] = gx[q] * 0.5f * d * (1.f + erff(d * 0.70710678118654752f));
      }
#pragma unroll
      for (int q = 0; q < 4; ++q) {
        const u32x4 va = *(const u32x4*)(pv + (size_t)ex[q] * 1024 + 8 * lane), vb = *(const u32x4*)(pv + (size_t)ex[q] * 1024 + 512 + 8 * lane);
#pragma unroll
        for (int e = 0; e < 4; ++e) { y[2 * e] += coef[q] * bflo(va[e]); y[2 * e + 1] += coef[q] * bfhi(va[e]); y[8 + 2 * e] += coef[q] * bflo(vb[e]); y[8 + 2 * e + 1] += coef[q] * bfhi(vb[e]); }
      }
    }
    float ss = 0.f;
#pragma unroll
    for (int e = 0; e < 16; ++e) ss += y[e] * y[e];
    ss = wave_sum(ss);
    const float rstd = rsqrtf(ss * (1.f / 1024.f) + 1e-6f);
    float* orow = p.out + (size_t)t * 1024;
#pragma unroll
    for (int hf = 0; hf < 2; ++hf)
#pragma unroll
      for (int q = 0; q < 2; ++q) {
        const int col = 512 * hf + 8 * lane + 4 * q;
        const f32x4 g4 = *(const f32x4*)(p.g_post_ffn + col), gt = *(const f32x4*)(mod + b * 6144 + 5120 + col);
        f32x4 x1 = *(const f32x4*)(orow + col);
        const f32x4 yy = {y[8 * hf + 4 * q], y[8 * hf + 4 * q + 1], y[8 * hf + 4 * q + 2], y[8 * hf + 4 * q + 3]};
        x1 = x1 + gt * (yy * rstd * g4);
        *(f32x4*)(orow + col) = x1;
      }
  }
}

namespace cg = cooperative_groups;
constexpr int LDS_BYTES = 72704;
constexpr size_t WS_CTL = 0;
DI void phase_mixer(const Params& p, int bid, int nb, char* lds) {
  if (bid < 16) gdn_scan_seq(p, bid);
  unsigned* ctr = (unsigned*)(p.ws + WS_CTL);
  int* slot = (int*)(lds + LDS_BYTES - 16);
  for (;;) {
    __syncthreads();
    if (threadIdx.x == 0) *slot = (int)atomicAdd(ctr, 1u);
    __syncthreads();
    const int u = *slot;
    if (u >= 2048) break;
    attn_unit(p, u & 31, 63 - (u >> 5), lds);
  }
}
__global__ void __launch_bounds__(NT, 2) fwd(Params p) {
  extern __shared__ __attribute__((aligned(16))) char lds[];
  cg::grid_group grid = cg::this_grid();
  const int bid = blockIdx.x, nb = gridDim.x;
  if (bid == 0 && threadIdx.x < 64) ((unsigned*)(p.ws + WS_CTL))[threadIdx.x] = 0u;
  phase_mod(p, bid, nb, lds); phase_wconv(p, bid, nb, lds);
  grid.sync();
  phase_xnorm(p, bid, nb);
  grid.sync();
  phase_inproj(p, bid, nb, lds);
  grid.sync();
  if (bid < 32) phase_foxcum(p, bid, 32, lds);
  phase_gdnprep(p, bid, nb, lds);
  grid.sync();
  phase_mixer(p, bid, nb, lds);
  grid.sync();
  phase_gdnout(p, bid, nb);
  grid.sync();
  phase_merge(p, bid, nb, lds);
  grid.sync();
  phase_wout(p, bid, nb, lds); phase_tabconv(p, bid, nb);
  grid.sync();
  phase_rows1(p, bid, nb);
  grid.sync();
  phase_peerq(p, bid, nb, lds);
  grid.sync();
  phase_peersel(p, bid, nb, lds);
  grid.sync();
  phase_peergather(p, bid, nb);
}

extern "C" void kernel_launch(void* const* d_in, const int* in_sizes, int n_in, void* d_out, int out_size, void* d_ws, size_t ws_size, hipStream_t stream) {
  static int grid_blocks = 0;
  if (!grid_blocks) {
    int dev = 0, cus = 0, per_cu = 0;
    hipGetDevice(&dev);
    hipDeviceGetAttribute(&cus, hipDeviceAttributeMultiprocessorCount, dev);
    (void)hipFuncSetAttribute((const void*)fwd, hipFuncAttributeMaxDynamicSharedMemorySize, LDS_BYTES);
    hipOccupancyMaxActiveBlocksPerMultiprocessor(&per_cu, (const void*)fwd, NT, LDS_BYTES);
    if (per_cu < 1) per_cu = 1;
    if (per_cu > 2) per_cu = 2;
    grid_blocks = cus * per_cu;
  }
  Params p{};
  const float** f = (const float**)&p;
  for (int i = 0; i < 23; ++i) f[i] = (const float*)d_in[i];
  p.out = (float*)d_out; p.ws = (char*)d_ws;
  void* args[] = {&p};
  hipError_t e = hipLaunchCooperativeKernel((const void*)fwd, dim3(grid_blocks), dim3(NT), args, LDS_BYTES, stream);
  if (e != hipSuccess) fprintf(stderr, "cooperative launch failed: %s (grid %d)\n", hipGetErrorString(e), grid_blocks);
}
```

```cpp
#include <hip/hip_runtime.h>
#include <hip/hip_cooperative_groups.h>
#include <stdint.h>
#include <math.h>
#include <cstdio>

#define DI __device__ __forceinline__
#define LAS __attribute__((address_space(3)))
typedef unsigned short bf16_t;
typedef short bf16x8 __attribute__((ext_vector_type(8)));
typedef short s16x4 __attribute__((ext_vector_type(4)));
typedef float f32x4 __attribute__((ext_vector_type(4)));
typedef float f32x16 __attribute__((ext_vector_type(16)));
typedef float f32x2 __attribute__((ext_vector_type(2)));
typedef unsigned u32x4 __attribute__((ext_vector_type(4)));
typedef unsigned u32x2 __attribute__((ext_vector_type(2)));
typedef __bf16 bf16x2_t __attribute__((ext_vector_type(2)));

constexpr int NT = 256;
constexpr int T_ = 32768, S_ = 8192;
constexpr int PP = 5632;
constexpr int NPAD = 5760;
constexpr float LOG2E = 1.4426950408889634f;
constexpr size_t MiB = 1u << 20;

constexpr size_t WS_MOD = 1 * MiB;
constexpr size_t WS_WIN = 2 * MiB;
constexpr size_t WS_WFO = 14 * MiB;
constexpr size_t WS_WGO = 15 * MiB;
constexpr size_t WS_WOUT = 16 * MiB;
constexpr size_t WS_WQ = 18 * MiB;
constexpr size_t WS_KEYS = 22 * MiB;
constexpr size_t WS_SMALL = 23 * MiB;
constexpr size_t WS_FNEG = 25 * MiB;
constexpr size_t WS_GL = 26 * MiB;
constexpr size_t WS_H = 32 * MiB;
constexpr size_t WS_P = 96 * MiB;
constexpr size_t WS_UF = 448 * MiB;
constexpr size_t WS_WF = 480 * MiB;
constexpr size_t WS_QY = 96 * MiB;
constexpr size_t WS_PU = 224 * MiB;
constexpr size_t WS_PV = 240 * MiB;
constexpr size_t WS_UINV = 256 * MiB;
constexpr size_t WS_VINV = 256 * MiB + 65536;
constexpr size_t WS_EIDX = 288 * MiB;
constexpr size_t WS_GATE = 304 * MiB;
constexpr size_t WS_PD = 320 * MiB;
constexpr size_t WS_Y2 = 96 * MiB;
constexpr size_t WS_COEF = 32 * MiB;
constexpr size_t WS_SSQ = 48 * MiB;

DI unsigned pk2(float lo, float hi) { f32x2 v = {lo, hi}; bf16x2_t b = __builtin_convertvector(v, bf16x2_t); return __builtin_bit_cast(unsigned, b); }
DI bf16_t f2bf(float x) { return (bf16_t)(pk2(x, 0.f) & 0xffffu); }
DI float bf2f(bf16_t v) { return __uint_as_float(((unsigned)v) << 16); }
DI float bflo(unsigned u) { return __uint_as_float(u << 16); }
DI float bfhi(unsigned u) { return __uint_as_float(u & 0xffff0000u); }
DI float wave_sum(float v) {
#pragma unroll
  for (int d = 32; d >= 1; d >>= 1) v += __shfl_xor(v, d);
  return v;
}
DI unsigned wave_max_u(unsigned v) {
#pragma unroll
  for (int d = 32; d >= 1; d >>= 1) { unsigned o = (unsigned)__shfl_xor((int)v, d); v = o > v ? o : v; }
  return v;
}
DI float sigmoidf_(float x) { return 1.f / (1.f + __expf(-x)); }
DI float softplusf_(float x) { return fmaxf(x, 0.f) + log1pf(__expf(-fabsf(x))); }
DI int crow(int r, int hi) { return (r & 3) + 8 * (r >> 2) + 4 * hi; }
#define MFMA16(a, b, c) __builtin_amdgcn_mfma_f32_16x16x32_bf16((a), (b), (c), 0, 0, 0)
#define MFMA32(a, b, c) __builtin_amdgcn_mfma_f32_32x32x16_bf16((a), (b), (c), 0, 0, 0)
DI s16x4 tr16(const LAS char* p) { typedef short v4i16_t __attribute__((ext_vector_type(4))); return __builtin_bit_cast(s16x4, __builtin_amdgcn_ds_read_tr16_b64_v4i16((LAS v4i16_t*)p)); }
DI bf16x8 cat8(s16x4 lo, s16x4 hi) { return __builtin_shufflevector(lo, hi, 0, 1, 2, 3, 4, 5, 6, 7); }
DI bf16x8 pack8(float a0, float a1, float a2, float a3, float a4, float a5, float a6, float a7) {
  u32x4 p = {pk2(a0, a1), pk2(a2, a3), pk2(a4, a5), pk2(a6, a7)}; return __builtin_bit_cast(bf16x8, p);
}

struct Params {
  const float *x, *c, *w_ada, *b_ada, *g_pre_mix, *g_post_mix, *w_in, *b_fgate, *fox_w_o, *conv_w, *a_log, *dt_bias, *gdn_norm_w, *gdn_w_o,
      *b_branch_gate, *w_out, *g_pre_ffn, *g_post_ffn, *peer_w_query, *peer_keys1, *peer_keys2, *peer_u, *peer_v;
  float* out; char* ws;
};

DI void phase_mod(const Params& p, int bid, int nb, char* lds) {
  float* sc = (float*)lds;
  float* part = sc + 4096;
  const int tid = threadIdx.x;
  for (int i = tid; i < 4096; i += NT) { float v = p.c[i]; sc[i] = v / (1.f + __expf(-v)); }
  __syncthreads();
  float* mod = (float*)(p.ws + WS_MOD);
  for (int g = bid; g < 96; g += nb) {
    const int cc = tid & 63, kg = tid >> 6, col = g * 64 + cc;
    float a0 = 0.f, a1 = 0.f, a2 = 0.f, a3 = 0.f;
#pragma unroll 8
    for (int k = kg; k < 1024; k += 4) { const float w = p.w_ada[(size_t)k * 6144 + col]; a0 += sc[k] * w; a1 += sc[1024 + k] * w; a2 += sc[2048 + k] * w; a3 += sc[3072 + k] * w; }
    part[(kg * 4 + 0) * 64 + cc] = a0; part[(kg * 4 + 1) * 64 + cc] = a1; part[(kg * 4 + 2) * 64 + cc] = a2; part[(kg * 4 + 3) * 64 + cc] = a3;
    __syncthreads();
    { const int b = tid >> 6; float s = part[(0 * 4 + b) * 64 + cc] + part[(1 * 4 + b) * 64 + cc] + part[(2 * 4 + b) * 64 + cc] + part[(3 * 4 + b) * 64 + cc];
      mod[b * 6144 + col] = s + p.b_ada[col]; }
    __syncthreads();
  }
}

DI int inproj_colmap(int n) {
  if (n < 1536) return n;
  if (n < 3584) return 1544 + (n - 1536);
  if (n < 5632) return 3600 + (n - 3584);
  if (n < 5640) return 1536 + (n - 5632);
  if (n < 5648) return 3592 + (n - 5640);
  return -1;
}
DI void transpose_tile(const float* src, int ldsrc, bf16_t* dst, int K, int n0, int k0, bool permute, float* tile) {
  const int tid = threadIdx.x, tx = tid & 63, ty = tid >> 6;
  const int n = n0 + tx; const int oc = permute ? inproj_colmap(n) : n;
#pragma unroll 4
  for (int i = 0; i < 16; ++i) { const int ky = ty + 4 * i; tile[ky * 65 + tx] = (oc >= 0) ? src[(size_t)(k0 + ky) * ldsrc + oc] : 0.f; }
  __syncthreads();
#pragma unroll 4
  for (int i = 0; i < 16; ++i) { const int ny = ty + 4 * i; dst[(size_t)(n0 + ny) * K + k0 + tx] = f2bf(tile[tx * 65 + ny]); }
  __syncthreads();
}
DI void phase_wconv(const Params& p, int bid, int nb, char* lds) {
  float* tile = (float*)lds;
  for (int t = bid; t < 2464; t += nb) {
    if (t < 1440) transpose_tile(p.w_in, 5648, (bf16_t*)(p.ws + WS_WIN), 1024, (t / 16) * 64, (t % 16) * 64, true, tile);
    else if (t < 1568) { const int u = t - 1440; transpose_tile(p.fox_w_o, 1024, (bf16_t*)(p.ws + WS_WFO), 512, (u / 8) * 64, (u % 8) * 64, false, tile); }
    else if (t < 1696) { const int u = t - 1568; transpose_tile(p.gdn_w_o, 1024, (bf16_t*)(p.ws + WS_WGO), 512, (u / 8) * 64, (u % 8) * 64, false, tile); }
    else if (t < 1952) { const int u = t - 1696; transpose_tile(p.w_out, 1024, (bf16_t*)(p.ws + WS_WOUT), 1024, (u / 16) * 64, (u % 16) * 64, false, tile); }
    else { const int u = t - 1952; transpose_tile(p.peer_w_query, 2048, (bf16_t*)(p.ws + WS_WQ), 1024, (u / 16) * 64, (u % 16) * 64, false, tile); }
  }
  bf16_t* kd = (bf16_t*)(p.ws + WS_KEYS);
  for (int i = bid * NT + threadIdx.x; i < 32768; i += nb * NT) kd[i] = f2bf(i < 16384 ? p.peer_keys1[i] : p.peer_keys2[i - 16384]);
}
DI unsigned pk4_fp8(float a, float b, float c, float d) { int w = 0; w = __builtin_amdgcn_cvt_pk_fp8_f32(a, b, w, false); w = __builtin_amdgcn_cvt_pk_fp8_f32(c, d, w, true); return (unsigned)w; }
DI void phase_tabconv(const Params& p, int bid, int nb) {
  const int lane = threadIdx.x & 63, gw = bid * 4 + (threadIdx.x >> 6), nw = nb * 4;
  for (int r = gw; r < 32768; r += nw) {
    const bool second = r >= 16384; const int e = r & 16383;
    const float* src = (second ? p.peer_v : p.peer_u) + (size_t)e * 1024 + 16 * lane;
    f32x4 v[4]; float am = 0.f;
#pragma unroll
    for (int i = 0; i < 4; ++i) { v[i] = *(const f32x4*)(src + 4 * i); am = fmaxf(am, fmaxf(fmaxf(fabsf(v[i][0]), fabsf(v[i][1])), fmaxf(fabsf(v[i][2]), fabsf(v[i][3])))); }
#pragma unroll
    for (int d = 32; d >= 1; d >>= 1) am = fmaxf(am, __shfl_xor(am, d));
    float sc = 1.f, inv = 1.f;
    if (am > 1e-30f) { const int ex = (int)floorf(log2f(448.f / am)); sc = exp2f((float)ex); inv = exp2f((float)-ex); }
    u32x4 o;
#pragma unroll
    for (int i = 0; i < 4; ++i) o[i] = pk4_fp8(v[i][0] * sc, v[i][1] * sc, v[i][2] * sc, v[i][3] * sc);
    *(u32x4*)(p.ws + (second ? WS_PV : WS_PU) + ((size_t)(lane >> 3) * 16384 + e) * 128 + 16 * (lane & 7)) = o;
    if (lane == 0) ((float*)(p.ws + (second ? WS_VINV : WS_UINV)))[e] = inv;
  }
}

DI void phase_xnorm(const Params& p, int bid, int nb) {
  const int lane = threadIdx.x & 63, gw = bid * 4 + (threadIdx.x >> 6), nw = nb * 4;
  const float* mod = (const float*)(p.ws + WS_MOD);
  bf16_t* h = (bf16_t*)(p.ws + WS_H);
  for (int row = gw; row < T_; row += nw) {
    const int b = row >> 13;
    const f32x4* xr = (const f32x4*)(p.x + (size_t)row * 1024);
    f32x4 v[4]; float ss = 0.f;
#pragma unroll
    for (int i = 0; i < 4; ++i) { v[i] = xr[lane + 64 * i]; ss += v[i][0] * v[i][0] + v[i][1] * v[i][1] + v[i][2] * v[i][2] + v[i][3] * v[i][3]; }
    ss = wave_sum(ss);
    const float rstd = rsqrtf(ss * (1.f / 1024.f) + 1e-6f);
#pragma unroll
    for (int i = 0; i < 4; ++i) {
      const int col = 4 * lane + 256 * i;
      const f32x4 g4 = *(const f32x4*)(p.g_pre_mix + col), sh = *(const f32x4*)(mod + b * 6144 + col), sc = *(const f32x4*)(mod + b * 6144 + 1024 + col);
      const f32x4 y = (v[i] * rstd * g4) * (1.f + sc) + sh;
      u32x2 o = {pk2(y[0], y[1]), pk2(y[2], y[3])};
      *(u32x2*)(h + (size_t)row * 1024 + col) = o;
    }
  }
}

struct GemmArgs { const bf16_t* A; int lda; const bf16_t* Bt; int ldb; int K; };
DI int swz(int row, int c) { return row * 128 + ((c ^ ((row >> 1) & 7)) << 4); }
template <class Epi>
DI void gemm_tile(const GemmArgs& g, int m0, int n0, char* lds, const Epi& epi) {
  const int tid = threadIdx.x, lane = tid & 63, wid = tid >> 6, wr = wid >> 1, wc = wid & 1, fr = lane & 15, fq = lane >> 4;
  char* As = lds; char* Bs = lds + 16384;
  f32x4 acc[4][4];
#pragma unroll
  for (int i = 0; i < 4; ++i)
#pragma unroll
    for (int j = 0; j < 4; ++j) acc[i][j] = (f32x4){0.f, 0.f, 0.f, 0.f};
  const int srow = tid >> 3, sc = tid & 7;
  const bf16_t* ag = g.A + (size_t)(m0 + srow) * g.lda + sc * 8;
  const bf16_t* bg = g.Bt + (size_t)(n0 + srow) * g.ldb + sc * 8;
  u32x4 ra[4], rb[4];
#pragma unroll
  for (int i = 0; i < 4; ++i) { ra[i] = *(const u32x4*)(ag + (size_t)(32 * i) * g.lda); rb[i] = *(const u32x4*)(bg + (size_t)(32 * i) * g.ldb); }
  const int nk = g.K / 64;
  for (int kt = 0; kt < nk; ++kt) {
    __syncthreads();
#pragma unroll
    for (int i = 0; i < 4; ++i) { const int off = swz(srow + 32 * i, sc); *(u32x4*)(As + off) = ra[i]; *(u32x4*)(Bs + off) = rb[i]; }
    __syncthreads();
    if (kt + 1 < nk) {
#pragma unroll
      for (int i = 0; i < 4; ++i) { ra[i] = *(const u32x4*)(ag + (size_t)(32 * i) * g.lda + (kt + 1) * 64); rb[i] = *(const u32x4*)(bg + (size_t)(32 * i) * g.ldb + (kt + 1) * 64); }
    }
#pragma unroll
    for (int kk = 0; kk < 2; ++kk) {
      bf16x8 af[4], bfm[4];
#pragma unroll
      for (int i = 0; i < 4; ++i) { af[i] = *(const bf16x8*)(As + swz(wr * 64 + i * 16 + fr, kk * 4 + fq)); bfm[i] = *(const bf16x8*)(Bs + swz(wc * 64 + i * 16 + fr, kk * 4 + fq)); }
#pragma unroll
      for (int i = 0; i < 4; ++i)
#pragma unroll
        for (int j = 0; j < 4; ++j) acc[i][j] = MFMA16(bfm[j], af[i], acc[i][j]);
    }
  }
#pragma unroll
  for (int i = 0; i < 4; ++i)
#pragma unroll
    for (int j = 0; j < 4; ++j) epi(m0 + wr * 64 + i * 16 + fr, n0 + wc * 64 + j * 16 + 4 * fq, acc[i][j]);
}

struct EpiInproj {
  bf16_t* proj; float* small; const float *bbg, *b_fgate, *a_log, *dt_bias;
  DI void operator()(int row, int col, f32x4 v) const {
    if (col < 3584) { u32x2 o = {pk2(v[0], v[1]), pk2(v[2], v[3])}; *(u32x2*)(proj + (size_t)row * PP + col) = o; }
    else if (col < 5632) {
      const f32x4 b = *(const f32x4*)(bbg + (col - 3584));
      u32x2 o = {pk2(sigmoidf_(v[0] + b[0]), sigmoidf_(v[1] + b[1])), pk2(sigmoidf_(v[2] + b[2]), sigmoidf_(v[3] + b[3]))};
      *(u32x2*)(proj + (size_t)row * PP + col) = o;
    } else if (col < 5648) {
      const int j0 = col - 5632;
#pragma unroll
      for (int e = 0; e < 4; ++e) { const int j = j0 + e; float r;
        if (j < 8) r = -softplusf_(-(v[e] + b_fgate[j]));
        else if (j < 12) r = sigmoidf_(v[e]);
        else r = -__expf(a_log[j - 12]) * softplusf_(v[e] + dt_bias[j - 12]);
        small[(size_t)row * 16 + j] = r; }
    }
  }
};
DI void phase_inproj(const Params& p, int bid, int nb, char* lds) {
  GemmArgs g = {(const bf16_t*)(p.ws + WS_H), 1024, (const bf16_t*)(p.ws + WS_WIN), 1024, 1024};
  EpiInproj e = {(bf16_t*)(p.ws + WS_P), (float*)(p.ws + WS_SMALL), p.b_branch_gate, p.b_fgate, p.a_log, p.dt_bias};
  for (int t = bid; t < 256 * 45; t += nb) gemm_tile(g, (t / 45) * 128, (t % 45) * 128, lds, e);
}

DI void phase_foxcum(const Params& p, int bid, int nb, char* lds) {
  float* tot = (float*)lds;
  const float* small = (const float*)(p.ws + WS_SMALL);
  float* fneg = (float*)(p.ws + WS_FNEG);
  const int tid = threadIdx.x;
  for (int bh = bid; bh < 32; bh += nb) {
    const int b = bh >> 3, h = bh & 7;
    float v[32]; float run = 0.f;
#pragma unroll
    for (int i = 0; i < 32; ++i) { run += small[((size_t)b * S_ + tid * 32 + i) * 16 + h]; v[i] = run; }
    tot[tid] = run; __syncthreads();
    float off = 0.f; for (int j = 0; j < tid; ++j) off += tot[j];
#pragma unroll
    for (int i = 0; i < 32; ++i) fneg[(size_t)bh * S_ + tid * 32 + i] = -(v[i] + off) * LOG2E;
    __syncthreads();
  }
}

DI int swzv(int row, int c) { return row * 128 + ((c ^ (((row >> 1) & 7) ^ ((row & 2) << 1))) << 4); }
DI void attn_unit(const Params& p, int bh, int qb, char* lds) {
  const int tid = threadIdx.x, lane = tid & 63, wid = tid >> 6, r32 = lane & 31, hi = lane >> 5;
  const int b = bh >> 3, h = bh & 7;
  bf16_t* proj = (bf16_t*)(p.ws + WS_P);
  const float* fneg = (const float*)(p.ws + WS_FNEG) + (size_t)bh * S_;
  const size_t rowbase = (size_t)b * S_;
  char* Ks = lds; char* Vs = lds + 8192; float* Fs = (float*)(lds + 16384);
  const LAS char* Vs3 = (const LAS char*)Vs;
  const int qrow = qb * 128 + wid * 32 + r32;
  bf16_t* qptr = proj + (rowbase + qrow) * PP + h * 64;
  bf16x8 qr[4];
  {
    const float c2 = 0.125f * LOG2E;
#pragma unroll
    for (int ks = 0; ks < 4; ++ks) { const u32x4 w = *(const u32x4*)(qptr + ks * 16 + hi * 8);
      qr[ks] = pack8(bflo(w[0]) * c2, bfhi(w[0]) * c2, bflo(w[1]) * c2, bfhi(w[1]) * c2, bflo(w[2]) * c2, bfhi(w[2]) * c2, bflo(w[3]) * c2, bfhi(w[3]) * c2); }
  }
  f32x16 o0, o1;
#pragma unroll
  for (int r = 0; r < 16; ++r) { o0[r] = 0.f; o1[r] = 0.f; }
  float m = -1e30f, l = 0.f;
  const int ntiles = 2 * qb + 2;
  const int srow = tid >> 3, sc = tid & 7;
  const bf16_t* kg = proj + (rowbase + srow) * PP + 512 + h * 64 + sc * 8;
  const bf16_t* vg = proj + (rowbase + srow) * PP + 1024 + h * 64 + sc * 8;
  u32x4 rk[2], rv[2]; f32x4 rf = {0.f, 0.f, 0.f, 0.f};
#pragma unroll
  for (int i = 0; i < 2; ++i) { rk[i] = *(const u32x4*)(kg + (size_t)(32 * i) * PP); rv[i] = *(const u32x4*)(vg + (size_t)(32 * i) * PP); }
  if (tid < 16) rf = *(const f32x4*)(fneg + tid * 4);
  const int wave_maxrow = qb * 128 + wid * 32 + 31;
  for (int j = 0; j < ntiles; ++j) {
    __syncthreads();
#pragma unroll
    for (int i = 0; i < 2; ++i) { *(u32x4*)(Ks + swz(srow + 32 * i, sc)) = rk[i]; *(u32x4*)(Vs + swzv(srow + 32 * i, sc)) = rv[i]; }
    if (tid < 16) *(f32x4*)(Fs + tid * 4) = rf;
    __syncthreads();
    if (j + 1 < ntiles) {
#pragma unroll
      for (int i = 0; i < 2; ++i) { rk[i] = *(const u32x4*)(kg + (size_t)((j + 1) * 64 + 32 * i) * PP); rv[i] = *(const u32x4*)(vg + (size_t)((j + 1) * 64 + 32 * i) * PP); }
      if (tid < 16) rf = *(const f32x4*)(fneg + (j + 1) * 64 + tid * 4);
    }
    if (j * 64 > wave_maxrow) continue;
    f32x16 p0, p1;
#pragma unroll
    for (int g = 0; g < 4; ++g) { const f32x4 a = *(const f32x4*)(Fs + 8 * g + 4 * hi), c = *(const f32x4*)(Fs + 32 + 8 * g + 4 * hi);
#pragma unroll
      for (int e = 0; e < 4; ++e) { p0[4 * g + e] = a[e]; p1[4 * g + e] = c[e]; } }
#pragma unroll
    for (int ks = 0; ks < 4; ++ks) {
      const bf16x8 k0 = *(const bf16x8*)(Ks + swz(r32, 2 * ks + hi)), k1 = *(const bf16x8*)(Ks + swz(32 + r32, 2 * ks + hi));
      p0 = MFMA32(k0, qr[ks], p0); p1 = MFMA32(k1, qr[ks], p1);
    }
    if (j >= 2 * qb) {
      const int kb = j * 64;
#pragma unroll
      for (int r = 0; r < 16; ++r) { const int kv = kb + crow(r, hi); if (kv > qrow) p0[r] = -INFINITY; if (kv + 32 > qrow) p1[r] = -INFINITY; }
    }
    float mx = fmaxf(p0[0], p1[0]);
#pragma unroll
    for (int r = 1; r < 16; ++r) mx = fmaxf(mx, fmaxf(p0[r], p1[r]));
    mx = fmaxf(mx, __shfl_xor(mx, 32));
    const float mn = fmaxf(m, mx), alpha = exp2f(m - mn); m = mn;
    float ps = 0.f;
#pragma unroll
    for (int r = 0; r < 16; ++r) { p0[r] = exp2f(p0[r] - mn); p1[r] = exp2f(p1[r] - mn); ps += p0[r] + p1[r]; }
    l = l * alpha + ps;
#pragma unroll
    for (int r = 0; r < 16; ++r) { o0[r] *= alpha; o1[r] *= alpha; }
    bf16x8 pf[2][2];
    pf[0][0] = pack8(p0[0], p0[1], p0[2], p0[3], p0[4], p0[5], p0[6], p0[7]);
    pf[0][1] = pack8(p0[8], p0[9], p0[10], p0[11], p0[12], p0[13], p0[14], p0[15]);
    pf[1][0] = pack8(p1[0], p1[1], p1[2], p1[3], p1[4], p1[5], p1[6], p1[7]);
    pf[1][1] = pack8(p1[8], p1[9], p1[10], p1[11], p1[12], p1[13], p1[14], p1[15]);
#pragma unroll
    for (int pb = 0; pb < 2; ++pb)
#pragma unroll
      for (int s = 0; s < 2; ++s) {
        const int rowa = 32 * pb + 16 * s + 4 * hi + ((lane & 15) >> 2);
#pragma unroll
        for (int d0 = 0; d0 < 2; ++d0) {
          const int cl = 4 * d0 + 2 * ((lane >> 4) & 1) + ((lane & 3) >> 1), sub = 8 * (lane & 1);
          const s16x4 lo = tr16(Vs3 + swzv(rowa, cl) + sub), hi4 = tr16(Vs3 + swzv(rowa + 8, cl) + sub);
          const bf16x8 vf = cat8(lo, hi4);
          if (d0 == 0) o0 = MFMA32(vf, pf[pb][s], o0); else o1 = MFMA32(vf, pf[pb][s], o1);
        }
      }
  }
  l += __shfl_xor(l, 32);
  const float inv = 1.f / l;
#pragma unroll
  for (int g = 0; g < 4; ++g) {
    u32x2 a = {pk2(o0[4 * g] * inv, o0[4 * g + 1] * inv), pk2(o0[4 * g + 2] * inv, o0[4 * g + 3] * inv)};
    u32x2 c = {pk2(o1[4 * g] * inv, o1[4 * g + 1] * inv), pk2(o1[4 * g + 2] * inv, o1[4 * g + 3] * inv)};
    *(u32x2*)(qptr + 8 * g + 4 * hi) = a; *(u32x2*)(qptr + 32 + 8 * g + 4 * hi) = c;
  }
}
DI void phase_attn(const Params& p, int bid, int nb, char* lds) {
  for (int u = bid; u < 2048; u += nb) attn_unit(p, u & 31, 63 - (u >> 5), lds);
}

constexpr int QP = 136;
DI void gdn_prep_unit(const Params& p, int U, char* lds) {
  const int tid = threadIdx.x, lane = tid & 63, wid = tid >> 6, fr = lane & 15, fq = lane >> 4;
  const int b = U >> 9, h = (U >> 7) & 3, c = U & 127;
  const size_t t0 = (size_t)b * S_ + c * 64;
  const int s0 = c * 64;
  const bf16_t* proj = (const bf16_t*)(p.ws + WS_P);
  const float* small = (const float*)(p.ws + WS_SMALL);
  bf16_t* q_s = (bf16_t*)lds; bf16_t* k_s = q_s + 64 * QP; bf16_t* v_s = k_s + 64 * QP;
  float* Lm = (float*)(lds + 3 * 17408);
  bf16_t* T1 = (bf16_t*)Lm; bf16_t* T2 = T1 + 64 * 72;
  float* gcs = (float*)(lds + 3 * 17408 + 18432);
  bf16_t* QF = (bf16_t*)((char*)p.out) + (size_t)U * 8192;
  bf16_t* KF = (bf16_t*)((char*)p.out + 32 * MiB) + (size_t)U * 8192;
  bf16_t* AF = (bf16_t*)((char*)p.out + 64 * MiB) + (size_t)U * 4096;
  bf16_t* UF = (bf16_t*)(p.ws + WS_UF) + (size_t)U * 8192;
  bf16_t* WF = (bf16_t*)(p.ws + WS_WF) + (size_t)U * 8192;
  __syncthreads();
  if (wid == 0) {
    const float g = small[(t0 + lane) * 16 + 12 + h], bt = small[(t0 + lane) * 16 + 8 + h];
    float cs = g;
#pragma unroll
    for (int d = 1; d < 64; d <<= 1) { const float n = __shfl_up(cs, d); if (lane >= d) cs += n; }
    const float gl = __shfl(cs, 63);
    gcs[lane] = cs; gcs[64 + lane] = bt; gcs[128 + lane] = __expf(cs); gcs[192 + lane] = __expf(gl - cs);
    if (lane == 0) { gcs[256] = __expf(gl); ((float*)(p.ws + WS_GL))[U] = __expf(gl); }
  }
  __syncthreads();
  {
#pragma unroll
    for (int X = 0; X < 3; ++X) {
      const int col = 1536 + 512 * X + h * 128 + 2 * lane, cb = 512 * X + h * 128 + 2 * lane;
      float w0[4], w1[4];
#pragma unroll
      for (int j = 0; j < 4; ++j) { w0[j] = p.conv_w[j * 1536 + cb]; w1[j] = p.conv_w[j * 1536 + cb + 1]; }
      bf16_t* dst = X == 0 ? q_s : (X == 1 ? k_s : v_s);
      float xa[4], xb[4];
      const int i0 = 16 * wid;
#pragma unroll
      for (int j = 0; j < 3; ++j) { const int rr = i0 - 3 + j; unsigned u = 0u; if (s0 + rr >= 0) u = *(const unsigned*)(proj + (size_t)((long)t0 + rr) * PP + col); xa[j + 1] = bflo(u); xb[j + 1] = bfhi(u); }
      for (int i = i0; i < i0 + 16; ++i) {
        xa[0] = xa[1]; xa[1] = xa[2]; xa[2] = xa[3]; xb[0] = xb[1]; xb[1] = xb[2]; xb[2] = xb[3];
        const unsigned u = *(const unsigned*)(proj + (t0 + i) * PP + col); xa[3] = bflo(u); xb[3] = bfhi(u);
        float y0 = w0[0] * xa[0] + w0[1] * xa[1] + w0[2] * xa[2] + w0[3] * xa[3];
        float y1 = w1[0] * xb[0] + w1[1] * xb[1] + w1[2] * xb[2] + w1[3] * xb[3];
        y0 = y0 * sigmoidf_(y0); y1 = y1 * sigmoidf_(y1);
        if (X < 2) { const float ss = wave_sum(y0 * y0 + y1 * y1); const float rn = rsqrtf(ss + 1e-6f); y0 *= rn; y1 *= rn; }
        *(unsigned*)(dst + i * QP + 2 * lane) = pk2(y0, y1);
        if (X == 0) {
          const float f = 0.08838834764831845f * gcs[128 + i];
          const int d = 2 * lane, mm = d >> 5, ss2 = (d >> 4) & 1, aa = (d >> 3) & 1, hh = (d >> 2) & 1, bb = d & 3;
          const int lp = (i & 31) + 32 * hh;
          *(unsigned*)(QF + (size_t)(((((i >> 5) * 4 + mm) * 2 + ss2) * 64 + lp) * 8 + 4 * aa + bb)) = pk2(y0 * f, y1 * f);
        }
      }
    }
  }
  __syncthreads();
  {
    bf16x8 ka[4];
#pragma unroll
    for (int kk = 0; kk < 4; ++kk) ka[kk] = *(const bf16x8*)(k_s + (16 * wid + fr) * QP + kk * 32 + fq * 8);
#pragma unroll
    for (int ni = 0; ni < 4; ++ni) {
      f32x4 dkk = {0.f, 0.f, 0.f, 0.f}, dqk = {0.f, 0.f, 0.f, 0.f};
      const int i = 16 * ni + fr, jj0 = 16 * wid + 4 * fq;
      if (ni >= wid) {
#pragma unroll
        for (int kk = 0; kk < 4; ++kk) {
          const bf16x8 bk = *(const bf16x8*)(k_s + (16 * ni + fr) * QP + kk * 32 + fq * 8), bq = *(const bf16x8*)(q_s + (16 * ni + fr) * QP + kk * 32 + fq * 8);
          dkk = MFMA16(ka[kk], bk, dkk); dqk = MFMA16(ka[kk], bq, dqk);
        }
      }
      const float gi = gcs[i], bi = gcs[64 + i];
      f32x4 lv, av;
#pragma unroll
      for (int r = 0; r < 4; ++r) { const int jj = jj0 + r; const float dec = __expf(fminf(gi - gcs[jj], 0.f));
        lv[r] = (jj < i) ? bi * dkk[r] * dec : 0.f; av[r] = (jj <= i) ? dqk[r] * 0.08838834764831845f * dec : 0.f; }
      *(f32x4*)(Lm + i * 68 + jj0) = lv;
      const int lp = (i & 31) + 32 * (fq & 1);
      u32x2 o = {pk2(av[0], av[1]), pk2(av[2], av[3])};
      *(u32x2*)(AF + (size_t)((((((i >> 5) * 2 + (wid >> 1)) * 2 + (wid & 1)) * 64 + lp) * 8) + 4 * (fq >> 1))) = o;
    }
    for (int it = tid; it < 2048; it += NT) {
      const int d = it & 127, jg = it >> 7;
      float v4[4];
#pragma unroll
      for (int e = 0; e < 4; ++e) { const int jj = 4 * jg + e; v4[e] = bf2f(k_s[jj * QP + d]) * gcs[192 + jj]; }
      const int lp = (d & 31) + 32 * (jg & 1);
      u32x2 o = {pk2(v4[0], v4[1]), pk2(v4[2], v4[3])};
      *(u32x2*)(KF + (size_t)((((((d >> 5) * 2 + (jg >> 3)) * 2 + ((jg >> 2) & 1)) * 64 + lp) * 8) + 4 * ((jg >> 1) & 1))) = o;
    }
  }
  __syncthreads();
  if (wid == 0) {
    float* Ts = (float*)q_s;
    for (int i = 0; i < 64; ++i) {
      float a0 = (lane == i) ? 1.f : 0.f, a1 = 0.f, a2 = 0.f, a3 = 0.f;
      const float* Li = Lm + i * 68;
      int j = 0;
#pragma unroll 4
      for (; j + 4 <= i; j += 4) {
        const f32x4 Lv = *(const f32x4*)(Li + j);
        a0 -= Lv[0] * Ts[j * 64 + lane]; a1 -= Lv[1] * Ts[(j + 1) * 64 + lane]; a2 -= Lv[2] * Ts[(j + 2) * 64 + lane]; a3 -= Lv[3] * Ts[(j + 3) * 64 + lane];
      }
      for (; j < i; ++j) a0 -= Li[j] * Ts[j * 64 + lane];
      Ts[i * 64 + lane] = (a0 + a1) + (a2 + a3);
    }
    const float f1 = gcs[64 + lane], f2 = f1 * gcs[128 + lane];
    asm volatile("" ::: "memory");
    for (int i = 0; i < 64; ++i) { const float t = Ts[i * 64 + lane]; T1[i * 72 + lane] = f2bf(t * f1); T2[i * 72 + lane] = f2bf(t * f2); }
  }
  __syncthreads();
  {
    const LAS char* v3 = (const LAS char*)v_s; const LAS char* k3 = (const LAS char*)k_s;
    bf16x8 ta[2], tb[2];
#pragma unroll
    for (int kk = 0; kk < 2; ++kk) { ta[kk] = *(const bf16x8*)(T1 + (16 * wid + fr) * 72 + kk * 32 + fq * 8); tb[kk] = *(const bf16x8*)(T2 + (16 * wid + fr) * 72 + kk * 32 + fq * 8); }
#pragma unroll
    for (int nj = 0; nj < 8; ++nj) {
      f32x4 du = {0.f, 0.f, 0.f, 0.f}, dw = {0.f, 0.f, 0.f, 0.f};
#pragma unroll
      for (int kk = 0; kk < 2; ++kk) {
        const int jr = 32 * kk + 8 * fq + ((lane & 15) >> 2), cc = 16 * nj + 4 * (lane & 3);
        const bf16x8 vb = cat8(tr16(v3 + (jr * QP + cc) * 2), tr16(v3 + ((jr + 4) * QP + cc) * 2));
        const bf16x8 kb = cat8(tr16(k3 + (jr * QP + cc) * 2), tr16(k3 + ((jr + 4) * QP + cc) * 2));
        du = MFMA16(ta[kk], vb, du);
        dw = MFMA16(kb, tb[kk], dw);
      }
      {
        const int lp = 16 * (nj & 1) + fr + 32 * (fq & 1);
        u32x2 o = {pk2(du[0], du[1]), pk2(du[2], du[3])};
        *(u32x2*)(UF + (size_t)(((((wid >> 1) * 4 + (nj >> 1)) * 64 + lp) * 16) + 4 * (2 * (wid & 1) + (fq >> 1)))) = o;
      }
      {
        const int lp = 16 * (wid & 1) + fr + 32 * (fq & 1);
        u32x2 o = {pk2(-dw[0], -dw[1]), pk2(-dw[2], -dw[3])};
        *(u32x2*)(WF + (size_t)((((((wid >> 1) * 4 + (nj >> 1)) * 2 + (nj & 1)) * 64 + lp) * 8) + 4 * (fq >> 1))) = o;
      }
    }
  }
}
DI void phase_gdnprep(const Params& p, int bid, int nb, char* lds) {
  for (int U = bid; U < 2048; U += nb) gdn_prep_unit(p, U, lds);
}

DI bf16x8 packS(const f32x16& x, int s) { return pack8(x[8 * s], x[8 * s + 1], x[8 * s + 2], x[8 * s + 3], x[8 * s + 4], x[8 * s + 5], x[8 * s + 6], x[8 * s + 7]); }
DI void gdn_scan_seq(const Params& p, int bh16, char* lds) {
  const int tid = threadIdx.x, lane = tid & 63, wv = tid >> 6, r32 = lane & 31, hi = lane >> 5;
  const int b = bh16 >> 2, h = bh16 & 3;
  bf16_t* proj = (bf16_t*)(p.ws + WS_P);
  const float* glp = (const float*)(p.ws + WS_GL) + bh16 * 128;
  const char* wf = (const char*)(p.ws + WS_WF) + (size_t)bh16 * 128 * 16384 + tid * 16;
  const char* qf = (const char*)p.out + (size_t)bh16 * 128 * 16384 + tid * 16;
  const char* kf = (const char*)p.out + 32 * MiB + (size_t)bh16 * 128 * 16384 + tid * 16;
  const char* af = (const char*)p.out + 64 * MiB + (size_t)bh16 * 128 * 8192 + tid * 16;
  const char* uf = (const char*)(p.ws + WS_UF) + (size_t)bh16 * 128 * 16384 + (size_t)(wv * 64 + lane) * 32;
  const char* lw = lds + lane * 16; const char* lq = lds + 16384 + lane * 16; const char* la = lds + 32768 + lane * 16; const char* lk = lds + 40960 + lane * 16;
  bf16_t* ol = (bf16_t*)(lds + 57344);
  float* gnw = (float*)(lds + 57344 + 17408);
  if (tid < 128) gnw[tid] = p.gdn_norm_w[tid];
#define SCAN_DMA(gsrc, ldsoff) __builtin_amdgcn_global_load_lds((const unsigned*)(gsrc), (LAS unsigned*)(lds + (ldsoff) + wv * 1024), 16, 0, 0)
#define SCAN_WQ(c) do { _Pragma("unroll") for (int i = 0; i < 4; ++i) { SCAN_DMA(wf + (size_t)(c) * 16384 + i * 4096, i * 4096); SCAN_DMA(qf + (size_t)(c) * 16384 + i * 4096, 16384 + i * 4096); } } while (0)
#define SCAN_AK(c) do { _Pragma("unroll") for (int i = 0; i < 2; ++i) SCAN_DMA(af + (size_t)(c) * 8192 + i * 4096, 32768 + i * 4096); \
    _Pragma("unroll") for (int i = 0; i < 4; ++i) SCAN_DMA(kf + (size_t)(c) * 16384 + i * 4096, 40960 + i * 4096); } while (0)
#define SCAN_U(c) do { _Pragma("unroll") for (int i2 = 0; i2 < 2; ++i2) { un[2 * i2] = *(const u32x4*)(uf + (size_t)(c) * 16384 + i2 * 8192); un[2 * i2 + 1] = *(const u32x4*)(uf + (size_t)(c) * 16384 + i2 * 8192 + 16); } gln = glp[c]; } while (0)
  f32x16 S[4];
#pragma unroll
  for (int m = 0; m < 4; ++m)
#pragma unroll
    for (int r = 0; r < 16; ++r) S[m][r] = 0.f;
  u32x4 un[4]; float gln;
  __syncthreads();
  SCAN_WQ(0); SCAN_U(0);
  for (int c = 0; c < 128; ++c) {
    __syncthreads();
    SCAN_AK(c);
    f32x16 vn[2];
#pragma unroll
    for (int i2 = 0; i2 < 2; ++i2) {
#pragma unroll
      for (int e = 0; e < 4; ++e) { vn[i2][2 * e] = bflo(un[2 * i2][e]); vn[i2][2 * e + 1] = bfhi(un[2 * i2][e]); vn[i2][8 + 2 * e] = bflo(un[2 * i2 + 1][e]); vn[i2][8 + 2 * e + 1] = bfhi(un[2 * i2 + 1][e]); }
    }
    const float gl = gln;
#pragma unroll
    for (int m = 0; m < 4; ++m) {
      const bf16x8 sb0 = packS(S[m], 0), sb1 = packS(S[m], 1);
#pragma unroll
      for (int i2 = 0; i2 < 2; ++i2) {
        vn[i2] = MFMA32(*(const bf16x8*)(lw + ((i2 * 4 + m) * 2 + 0) * 1024), sb0, vn[i2]);
        vn[i2] = MFMA32(*(const bf16x8*)(lw + ((i2 * 4 + m) * 2 + 1) * 1024), sb1, vn[i2]);
      }
    }
    bf16x8 Vb[2][2];
#pragma unroll
    for (int j2 = 0; j2 < 2; ++j2) { Vb[j2][0] = packS(vn[j2], 0); Vb[j2][1] = packS(vn[j2], 1); }
    f32x16 o[2];
#pragma unroll
    for (int i2 = 0; i2 < 2; ++i2)
#pragma unroll
      for (int r = 0; r < 16; ++r) o[i2][r] = 0.f;
#pragma unroll
    for (int m = 0; m < 4; ++m) {
      const bf16x8 sb0 = packS(S[m], 0), sb1 = packS(S[m], 1);
#pragma unroll
      for (int i2 = 0; i2 < 2; ++i2) {
        o[i2] = MFMA32(*(const bf16x8*)(lq + ((i2 * 4 + m) * 2 + 0) * 1024), sb0, o[i2]);
        o[i2] = MFMA32(*(const bf16x8*)(lq + ((i2 * 4 + m) * 2 + 1) * 1024), sb1, o[i2]);
      }
    }
    __syncthreads();
    if (c + 1 < 128) { SCAN_WQ(c + 1); SCAN_U(c + 1); }
#pragma unroll
    for (int i2 = 0; i2 < 2; ++i2)
#pragma unroll
      for (int j2 = 0; j2 <= i2; ++j2)
#pragma unroll
        for (int s = 0; s < 2; ++s) o[i2] = MFMA32(*(const bf16x8*)(la + ((i2 * 2 + j2) * 2 + s) * 1024), Vb[j2][s], o[i2]);
#pragma unroll
    for (int i2 = 0; i2 < 2; ++i2)
#pragma unroll
      for (int r = 0; r < 16; ++r) ol[(32 * i2 + crow(r, hi)) * 136 + 32 * wv + r32] = f2bf(o[i2][r]);
#pragma unroll
    for (int m = 0; m < 4; ++m) {
#pragma unroll
      for (int r = 0; r < 16; ++r) S[m][r] *= gl;
#pragma unroll
      for (int j2 = 0; j2 < 2; ++j2)
#pragma unroll
        for (int s = 0; s < 2; ++s) S[m] = MFMA32(*(const bf16x8*)(lk + ((m * 2 + j2) * 2 + s) * 1024), Vb[j2][s], S[m]);
    }
    __syncthreads();
    {
      const size_t t0 = (size_t)b * S_ + c * 64;
      const int row = tid >> 2, q4 = tid & 3;
      const bf16_t* gzp = proj + (t0 + row) * PP + 3072 + h * 128 + 32 * q4;
      bf16_t* op = proj + (t0 + row) * PP + 1536 + h * 128 + 32 * q4;
      float ss = 0.f;
#pragma unroll
      for (int q = 0; q < 4; ++q) { const u32x4 w = *(const u32x4*)(ol + row * 136 + 32 * q4 + 8 * q);
#pragma unroll
        for (int e = 0; e < 4; ++e) { const float a0 = bflo(w[e]), a1 = bfhi(w[e]); ss += a0 * a0 + a1 * a1; } }
      ss += __uint_as_float((unsigned)__builtin_amdgcn_update_dpp(0, (int)__float_as_uint(ss), 0xB1, 0xF, 0xF, true));
      ss += __uint_as_float((unsigned)__builtin_amdgcn_update_dpp(0, (int)__float_as_uint(ss), 0x4E, 0xF, 0xF, true));
      const float rstd = rsqrtf(ss * (1.f / 128.f) + 1e-6f);
#pragma unroll
      for (int q = 0; q < 4; ++q) {
        const u32x4 w = *(const u32x4*)(ol + row * 136 + 32 * q4 + 8 * q), gz = *(const u32x4*)(gzp + 8 * q);
        float y[8];
#pragma unroll
        for (int e = 0; e < 4; ++e) { const float z0 = bflo(gz[e]), z1 = bfhi(gz[e]);
          y[2 * e] = bflo(w[e]) * rstd * gnw[32 * q4 + 8 * q + 2 * e] * (z0 * sigmoidf_(z0));
          y[2 * e + 1] = bfhi(w[e]) * rstd * gnw[32 * q4 + 8 * q + 2 * e + 1] * (z1 * sigmoidf_(z1)); }
        u32x4 wv4 = {pk2(y[0], y[1]), pk2(y[2], y[3]), pk2(y[4], y[5]), pk2(y[6], y[7])};
        *(u32x4*)(op + 8 * q) = wv4;
      }
    }
  }
#undef SCAN_DMA
#undef SCAN_WQ
#undef SCAN_AK
#undef SCAN_U
  __syncthreads();
}
DI void phase_gdnout(const Params& p, int bid, int nb) {
  const int lane = threadIdx.x & 63, gw = bid * 4 + (threadIdx.x >> 6), nw = nb * 4;
  bf16_t* proj = (bf16_t*)(p.ws + WS_P);
  const f32x4 w0 = *(const f32x4*)(p.gdn_norm_w + (lane & 15) * 8), w1 = *(const f32x4*)(p.gdn_norm_w + (lane & 15) * 8 + 4);
  for (int row = gw; row < T_; row += nw) {
    bf16_t* op = proj + (size_t)row * PP + 1536 + lane * 8;
    const u32x4 ov = *(const u32x4*)op, zv = *(const u32x4*)(proj + (size_t)row * PP + 3072 + lane * 8);
    float o[8], z[8];
#pragma unroll
    for (int e = 0; e < 4; ++e) { o[2 * e] = bflo(ov[e]); o[2 * e + 1] = bfhi(ov[e]); z[2 * e] = bflo(zv[e]); z[2 * e + 1] = bfhi(zv[e]); }
    float ss = 0.f;
#pragma unroll
    for (int e = 0; e < 8; ++e) ss += o[e] * o[e];
    ss += __shfl_xor(ss, 1); ss += __shfl_xor(ss, 2); ss += __shfl_xor(ss, 4); ss += __shfl_xor(ss, 8);
    const float rstd = rsqrtf(ss * (1.f / 128.f) + 1e-6f);
    float y[8];
#pragma unroll
    for (int e = 0; e < 8; ++e) { const float w = e < 4 ? w0[e] : w1[e - 4]; y[e] = o[e] * rstd * w * (z[e] * sigmoidf_(z[e])); }
    u32x4 r = {pk2(y[0], y[1]), pk2(y[2], y[3]), pk2(y[4], y[5]), pk2(y[6], y[7])};
    *(u32x4*)op = r;
  }
}

struct EpiMergeA {
  const bf16_t* proj; bf16_t* mp;
  DI void operator()(int row, int col, f32x4 v) const {
    const u32x2 g = *(const u32x2*)(proj + (size_t)row * PP + 3584 + col);
    u32x2 o = {pk2(v[0] * bflo(g[0]), v[1] * bfhi(g[0])), pk2(v[2] * bflo(g[1]), v[3] * bfhi(g[1]))};
    *(u32x2*)(mp + (size_t)row * 1024 + col) = o;
  }
};
struct EpiMergeB {
  const bf16_t* proj; bf16_t* mp;
  DI void operator()(int row, int col, f32x4 v) const {
    const u32x2 g = *(const u32x2*)(proj + (size_t)row * PP + 4608 + col);
    const u32x2 q = *(const u32x2*)(mp + (size_t)row * 1024 + col);
    u32x2 o = {pk2(bflo(q[0]) + v[0] * bflo(g[0]), bfhi(q[0]) + v[1] * bfhi(g[0])), pk2(bflo(q[1]) + v[2] * bflo(g[1]), bfhi(q[1]) + v[3] * bfhi(g[1]))};
    *(u32x2*)(mp + (size_t)row * 1024 + col) = o;
  }
};
struct EpiF32 { float* out; int ld; DI void operator()(int row, int col, f32x4 v) const { *(f32x4*)(out + (size_t)row * ld + col) = v; } };
struct EpiBf16 { bf16_t* out; int ld; DI void operator()(int row, int col, f32x4 v) const { u32x2 o = {pk2(v[0], v[1]), pk2(v[2], v[3])}; *(u32x2*)(out + (size_t)row * ld + col) = o; } };
DI void phase_merge(const Params& p, int bid, int nb, char* lds) {
  const bf16_t* proj = (const bf16_t*)(p.ws + WS_P);
  GemmArgs ga = {proj, PP, (const bf16_t*)(p.ws + WS_WFO), 512, 512};
  GemmArgs gb = {proj + 1536, PP, (const bf16_t*)(p.ws + WS_WGO), 512, 512};
  EpiMergeA ea = {proj, (bf16_t*)(p.ws + WS_H)};
  EpiMergeB eb = {proj, (bf16_t*)(p.ws + WS_H)};
  for (int t = bid; t < 256 * 8; t += nb) { gemm_tile(ga, (t >> 3) * 128, (t & 7) * 128, lds, ea); gemm_tile(gb, (t >> 3) * 128, (t & 7) * 128, lds, eb); }
}
DI void phase_wout(const Params& p, int bid, int nb, char* lds) {
  GemmArgs g = {(const bf16_t*)(p.ws + WS_H), 1024, (const bf16_t*)(p.ws + WS_WOUT), 1024, 1024};
  EpiF32 e = {p.out, 1024};
  for (int t = bid; t < 256 * 8; t += nb) gemm_tile(g, (t >> 3) * 128, (t & 7) * 128, lds, e);
}
DI void phase_rows1(const Params& p, int bid, int nb) {
  const int lane = threadIdx.x & 63, gw = bid * 4 + (threadIdx.x >> 6), nw = nb * 4;
  const float* mod = (const float*)(p.ws + WS_MOD);
  bf16_t* h2 = (bf16_t*)(p.ws + WS_H);
  for (int row = gw; row < T_; row += nw) {
    const int b = row >> 13;
    f32x4* mr = (f32x4*)(p.out + (size_t)row * 1024);
    const f32x4* xr = (const f32x4*)(p.x + (size_t)row * 1024);
    f32x4 v[4]; float ss = 0.f;
#pragma unroll
    for (int i = 0; i < 4; ++i) { v[i] = mr[lane + 64 * i]; ss += v[i][0] * v[i][0] + v[i][1] * v[i][1] + v[i][2] * v[i][2] + v[i][3] * v[i][3]; }
    ss = wave_sum(ss);
    const float rstd = rsqrtf(ss * (1.f / 1024.f) + 1e-6f);
    float s2 = 0.f;
#pragma unroll
    for (int i = 0; i < 4; ++i) {
      const int col = 4 * lane + 256 * i;
      const f32x4 g4 = *(const f32x4*)(p.g_post_mix + col), gt = *(const f32x4*)(mod + b * 6144 + 2048 + col);
      v[i] = xr[lane + 64 * i] + gt * (v[i] * rstd * g4);
      mr[lane + 64 * i] = v[i];
      s2 += v[i][0] * v[i][0] + v[i][1] * v[i][1] + v[i][2] * v[i][2] + v[i][3] * v[i][3];
    }
    s2 = wave_sum(s2);
    const float rstd2 = rsqrtf(s2 * (1.f / 1024.f) + 1e-6f);
#pragma unroll
    for (int i = 0; i < 4; ++i) {
      const int col = 4 * lane + 256 * i;
      const f32x4 g4 = *(const f32x4*)(p.g_pre_ffn + col), sh = *(const f32x4*)(mod + b * 6144 + 3072 + col), sc = *(const f32x4*)(mod + b * 6144 + 4096 + col);
      const f32x4 y = (v[i] * rstd2 * g4) * (1.f + sc) + sh;
      u32x2 o = {pk2(y[0], y[1]), pk2(y[2], y[3])};
      *(u32x2*)(h2 + (size_t)row * 1024 + col) = o;
    }
  }
}

DI void phase_peerq(const Params& p, int bid, int nb, char* lds) {
  GemmArgs g = {(const bf16_t*)(p.ws + WS_H), 1024, (const bf16_t*)(p.ws + WS_WQ), 1024, 1024};
  EpiBf16 e = {(bf16_t*)(p.ws + WS_QY), 2048};
  for (int t = bid; t < 256 * 16; t += nb) gemm_tile(g, (t >> 4) * 128, (t & 15) * 128, lds, e);
}
DI unsigned ordkey(float f) { const unsigned u = __float_as_uint(f); return (u & 0x80000000u) ? ~u : (u | 0x80000000u); }
DI void ins16(unsigned (&a)[16], unsigned x) {
#pragma unroll
  for (int s = 0; s < 16; ++s) { const unsigned t = a[s] > x ? a[s] : x; x = a[s] > x ? x : a[s]; a[s] = t; }
}
DI void peer_select_unit(const Params& p, int unit, char* lds) {
  const int tid = threadIdx.x, lane = tid & 63, wid = tid >> 6, fr = lane & 15, fq = lane >> 4;
  const int h = unit & 7, t0 = (unit >> 3) * 32;
  float* sc = (float*)lds;
  float* topv = (float*)(lds + 64 * 132 * 4);
  int* topi = (int*)(lds + 64 * 132 * 4 + 64 * 16 * 4);
  const bf16_t* qy = (const bf16_t*)(p.ws + WS_QY);
  const bf16_t* keys = (const bf16_t*)(p.ws + WS_KEYS);
  __syncthreads();
  {
    const int set = wid >> 1, ts = wid & 1;
    bf16x8 qa[4];
#pragma unroll
    for (int kk = 0; kk < 4; ++kk) qa[kk] = *(const bf16x8*)(qy + (size_t)(t0 + 16 * ts + fr) * 2048 + h * 256 + set * 128 + kk * 32 + fq * 8);
#pragma unroll
    for (int nj = 0; nj < 8; ++nj) {
      f32x4 d = {0.f, 0.f, 0.f, 0.f};
#pragma unroll
      for (int kk = 0; kk < 4; ++kk) { const bf16x8 kb = *(const bf16x8*)(keys + set * 16384 + (16 * nj + fr) * 128 + kk * 32 + fq * 8); d = MFMA16(qa[kk], kb, d); }
#pragma unroll
      for (int r = 0; r < 4; ++r) sc[(set * 32 + 16 * ts + 4 * fq + r) * 132 + 16 * nj + fr] = d[r];
    }
  }
  __syncthreads();
  {
    const int rr = tid >> 2, qt = tid & 3;
    unsigned a[16];
#pragma unroll
    for (int s = 0; s < 16; ++s) a[s] = 0u;
    const float* srow = sc + rr * 132 + 32 * qt;
#pragma unroll 2
    for (int j = 0; j < 8; ++j) {
      const f32x4 v = *(const f32x4*)(srow + 4 * j);
#pragma unroll
      for (int e = 0; e < 4; ++e) ins16(a, (ordkey(v[e]) & ~127u) | (unsigned)(127 - (32 * qt + 4 * j + e)));
    }
    unsigned bq[16];
#pragma unroll
    for (int s = 0; s < 16; ++s) bq[s] = (unsigned)__builtin_amdgcn_update_dpp(0, (int)a[s], 0xB1, 0xF, 0xF, true);
#pragma unroll
    for (int s = 0; s < 16; ++s) ins16(a, bq[s]);
#pragma unroll
    for (int s = 0; s < 16; ++s) bq[s] = (unsigned)__builtin_amdgcn_update_dpp(0, (int)a[s], 0x4E, 0xF, 0xF, true);
#pragma unroll
    for (int s = 0; s < 16; ++s) ins16(a, bq[s]);
#pragma unroll
    for (int s = 0; s < 4; ++s) {
      const unsigned k = qt == 0 ? a[s] : (qt == 1 ? a[4 + s] : (qt == 2 ? a[8 + s] : a[12 + s]));
      const int idx = 127 - (int)(k & 127u);
      topv[rr * 16 + 4 * qt + s] = sc[rr * 132 + idx]; topi[rr * 16 + 4 * qt + s] = idx;
    }
  }
  __syncthreads();
  if (tid < 32) {
    const int tok = tid;
    unsigned c[16];
#pragma unroll
    for (int s = 0; s < 16; ++s) c[s] = 0u;
    for (int a = 0; a < 16; ++a) {
      const float va = topv[tok * 16 + a]; const int nbb = 16 / (a + 1);
      for (int b = 0; b < nbb; ++b) ins16(c, (ordkey(va + topv[(32 + tok) * 16 + b]) & ~255u) | (unsigned)(255 - (16 * a + b)));
    }
    float val[16]; int ei[16];
    float tot = 0.f, mx = 0.f;
#pragma unroll
    for (int s = 0; s < 16; ++s) { const int pos = 255 - (int)(c[s] & 255u); const int a = pos >> 4, b = pos & 15;
      const float v = topv[tok * 16 + a] + topv[(32 + tok) * 16 + b]; ei[s] = topi[tok * 16 + a] * 128 + topi[(32 + tok) * 16 + b];
      if (s == 0) mx = v;
      val[s] = __expf(v - mx); tot += val[s]; }
    const float rt = 1.f / tot;
    int* eo = (int*)(p.ws + WS_EIDX) + ((size_t)(t0 + tok) * 8 + h) * 16; float* go = (float*)(p.ws + WS_GATE) + ((size_t)(t0 + tok) * 8 + h) * 16;
#pragma unroll
    for (int q = 0; q < 4; ++q) {
      *(f32x4*)(go + 4 * q) = (f32x4){val[4 * q] * rt, val[4 * q + 1] * rt, val[4 * q + 2] * rt, val[4 * q + 3] * rt};
      typedef int i32x4 __attribute__((ext_vector_type(4)));
      *(i32x4*)(eo + 4 * q) = (i32x4){ei[4 * q], ei[4 * q + 1], ei[4 * q + 2], ei[4 * q + 3]};
    }
  }
}
DI void phase_peersel(const Params& p, int bid, int nb, char* lds) {
  for (int u = bid; u < 8192; u += nb) peer_select_unit(p, u, lds);
}
DI float dpp_sum8(float d) {
  d += __uint_as_float((unsigned)__builtin_amdgcn_update_dpp(0, (int)__float_as_uint(d), 0xB1, 0xF, 0xF, true));
  d += __uint_as_float((unsigned)__builtin_amdgcn_update_dpp(0, (int)__float_as_uint(d), 0x4E, 0xF, 0xF, true));
  d += __uint_as_float((unsigned)__builtin_amdgcn_update_dpp(0, (int)__float_as_uint(d), 0x141, 0xF, 0xF, true));
  return d;
}
DI void unpack16_fp8(const u32x4 w, float (&f)[16]) {
#pragma unroll
  for (int i = 0; i < 4; ++i) { const f32x2 lo = __builtin_amdgcn_cvt_pk_f32_fp8((int)w[i], false), hi = __builtin_amdgcn_cvt_pk_f32_fp8((int)w[i], true); f[4 * i] = lo[0]; f[4 * i + 1] = lo[1]; f[4 * i + 2] = hi[0]; f[4 * i + 3] = hi[1]; }
}
DI void phase_peerdown(const Params& p, int bid, int nb) {
  const int lane = threadIdx.x & 63, wid = threadIdx.x >> 6, e8 = lane >> 3, c = lane & 7;
  const int x = bid & 7, gw = (bid >> 3) * 4 + wid, nw = (nb >> 3) * 4;
  const bf16_t* h2 = (const bf16_t*)(p.ws + WS_H);
  const char* tab = p.ws + WS_PU + (size_t)x * 16384 * 128 + 16 * c;
  const int* eidx = (const int*)(p.ws + WS_EIDX);
  float* pd = (float*)(p.ws + WS_PD) + (size_t)x * T_ * 128;
  for (int t = gw; t < T_; t += nw) {
    float hx[16];
    { const u32x4 a = *(const u32x4*)(h2 + (size_t)t * 1024 + 128 * x + 16 * c), b = *(const u32x4*)(h2 + (size_t)t * 1024 + 128 * x + 16 * c + 8);
#pragma unroll
      for (int e = 0; e < 4; ++e) { hx[2 * e] = bflo(a[e]); hx[2 * e + 1] = bfhi(a[e]); hx[8 + 2 * e] = bflo(b[e]); hx[8 + 2 * e + 1] = bfhi(b[e]); } }
    typedef int i32x4 __attribute__((ext_vector_type(4)));
    int ee[16];
#pragma unroll
    for (int q = 0; q < 4; ++q) { const i32x4 v = *(const i32x4*)(eidx + (size_t)t * 128 + 16 * e8 + 4 * q); ee[4 * q] = v[0]; ee[4 * q + 1] = v[1]; ee[4 * q + 2] = v[2]; ee[4 * q + 3] = v[3]; }
    float k0 = 0.f, k1 = 0.f;
#pragma unroll
    for (int g0 = 0; g0 < 16; g0 += 8) {
      u32x4 w[8];
#pragma unroll
      for (int q = 0; q < 8; ++q) w[q] = *(const u32x4*)(tab + (size_t)ee[g0 + q] * 128);
#pragma unroll
      for (int q = 0; q < 8; ++q) {
        float f[16]; unpack16_fp8(w[q], f);
        float d = 0.f;
#pragma unroll
        for (int i = 0; i < 16; ++i) d += f[i] * hx[i];
        d = dpp_sum8(d);
        if (c == q) { if (g0 == 0) k0 = d; else k1 = d; }
      }
    }
    pd[(size_t)t * 128 + 16 * e8 + c] = k0; pd[(size_t)t * 128 + 16 * e8 + 8 + c] = k1;
  }
}
DI void phase_peercoef(const Params& p, int bid, int nb) {
  const float* pd = (const float*)(p.ws + WS_PD);
  const int* eidx = (const int*)(p.ws + WS_EIDX); const float* gate = (const float*)(p.ws + WS_GATE);
  const float* uinv = (const float*)(p.ws + WS_UINV); const float* vinv = (const float*)(p.ws + WS_VINV);
  float* coef = (float*)(p.ws + WS_COEF);
  for (size_t i = (size_t)bid * NT + threadIdx.x; i < (size_t)T_ * 128; i += (size_t)nb * NT) {
    float d = 0.f;
#pragma unroll
    for (int x = 0; x < 8; ++x) d += pd[(size_t)x * T_ * 128 + i];
    const int e = eidx[i];
    d *= uinv[e];
    coef[i] = gate[i] * 0.5f * d * (1.f + erff(d * 0.70710678118654752f)) * vinv[e];
  }
}
DI void phase_peerup(const Params& p, int bid, int nb) {
  const int lane = threadIdx.x & 63, wid = threadIdx.x >> 6, e8 = lane >> 3, c = lane & 7;
  const int x = bid & 7, gw = (bid >> 3) * 4 + wid, nw = (nb >> 3) * 4;
  const char* tab = p.ws + WS_PV + (size_t)x * 16384 * 128 + 16 * c;
  const int* eidx = (const int*)(p.ws + WS_EIDX); const float* coef = (const float*)(p.ws + WS_COEF);
  float* y2 = (float*)(p.ws + WS_Y2); float* ssq = (float*)(p.ws + WS_SSQ) + (size_t)x * T_;
  for (int t = gw; t < T_; t += nw) {
    typedef int i32x4 __attribute__((ext_vector_type(4)));
    int ee[16]; float cf[16];
#pragma unroll
    for (int q = 0; q < 4; ++q) { const i32x4 v = *(const i32x4*)(eidx + (size_t)t * 128 + 16 * e8 + 4 * q); const f32x4 g = *(const f32x4*)(coef + (size_t)t * 128 + 16 * e8 + 4 * q);
#pragma unroll
      for (int e = 0; e < 4; ++e) { ee[4 * q + e] = v[e]; cf[4 * q + e] = g[e]; } }
    float y[16];
#pragma unroll
    for (int i = 0; i < 16; ++i) y[i] = 0.f;
#pragma unroll
    for (int g0 = 0; g0 < 16; g0 += 8) {
      u32x4 w[8];
#pragma unroll
      for (int q = 0; q < 8; ++q) w[q] = *(const u32x4*)(tab + (size_t)ee[g0 + q] * 128);
#pragma unroll
      for (int q = 0; q < 8; ++q) {
        float f[16]; unpack16_fp8(w[q], f);
#pragma unroll
        for (int i = 0; i < 16; ++i) y[i] += cf[g0 + q] * f[i];
      }
    }
    float ss = 0.f;
#pragma unroll
    for (int i = 0; i < 16; ++i) { y[i] += __shfl_xor(y[i], 8); y[i] += __shfl_xor(y[i], 16); y[i] += __shfl_xor(y[i], 32); ss += y[i] * y[i]; }
    ss = dpp_sum8(ss);
    if (e8 == 0) {
      float* yo = y2 + (size_t)t * 1024 + 128 * x + 16 * c;
#pragma unroll
      for (int q = 0; q < 4; ++q) *(f32x4*)(yo + 4 * q) = (f32x4){y[4 * q], y[4 * q + 1], y[4 * q + 2], y[4 * q + 3]};
      if (c == 0) ssq[t] = ss;
    }
  }
}
DI void phase_final(const Params& p, int bid, int nb) {
  const int lane = threadIdx.x & 63, gw = bid * 4 + (threadIdx.x >> 6), nw = nb * 4;
  const float* mod = (const float*)(p.ws + WS_MOD);
  const float* y2 = (const float*)(p.ws + WS_Y2); const float* ssq = (const float*)(p.ws + WS_SSQ);
  for (int row = gw; row < T_; row += nw) {
    const int b = row >> 13;
    float ss = 0.f;
#pragma unroll
    for (int x = 0; x < 8; ++x) ss += ssq[(size_t)x * T_ + row];
    const float rstd = rsqrtf(ss * (1.f / 1024.f) + 1e-6f);
    f32x4* orow = (f32x4*)(p.out + (size_t)row * 1024); const f32x4* yr = (const f32x4*)(y2 + (size_t)row * 1024);
#pragma unroll
    for (int i = 0; i < 4; ++i) {
      const int col = 4 * lane + 256 * i;
      const f32x4 g4 = *(const f32x4*)(p.g_post_ffn + col), gt = *(const f32x4*)(mod + b * 6144 + 5120 + col);
      orow[lane + 64 * i] = orow[lane + 64 * i] + gt * (yr[lane + 64 * i] * rstd * g4);
    }
  }
}

namespace cg = cooperative_groups;
constexpr int LDS_BYTES = 75776;
constexpr size_t WS_CTL = 0;
DI void phase_mixer(const Params& p, int bid, int nb, char* lds) {
  if (bid < 16) gdn_scan_seq(p, bid, lds);
  unsigned* ctr = (unsigned*)(p.ws + WS_CTL);
  int* slot = (int*)(lds + LDS_BYTES - 16);
  for (;;) {
    __syncthreads();
    if (threadIdx.x == 0) *slot = (int)atomicAdd(ctr, 1u);
    __syncthreads();
    const int u = *slot;
    if (u >= 2048) break;
    attn_unit(p, u & 31, 63 - (u >> 5), lds);
  }
}
#ifndef PROBE_PHASE
#define PROBE_PHASE -1
#endif
__global__ void __launch_bounds__(NT, 2) fwd(Params p) {
  extern __shared__ __attribute__((aligned(16))) char lds[];
  cg::grid_group grid = cg::this_grid();
  const int bid = blockIdx.x, nb = gridDim.x;
  unsigned long long tprev = 0, tprobe = 0; int nph = 0;
#define SEAM() do { asm volatile("s_waitcnt vmcnt(0)" ::: "memory");   grid.sync(); if (PROBE_PHASE >= 0) { const unsigned long long tn = __builtin_amdgcn_s_memrealtime(); if (nph == PROBE_PHASE) tprobe = tn - tprev; tprev = tn; ++nph; } } while (0)
  if (bid == 0 && threadIdx.x < 64) ((unsigned*)(p.ws + WS_CTL))[threadIdx.x] = 0u;
  if (PROBE_PHASE >= 0) tprev = __builtin_amdgcn_s_memrealtime();
  phase_mod(p, bid, nb, lds); phase_wconv(p, bid, nb, lds);
  SEAM();
  phase_xnorm(p, bid, nb);
  SEAM();
  phase_inproj(p, bid, nb, lds);
  SEAM();
  if (bid < 32) phase_foxcum(p, bid, 32, lds);
  phase_gdnprep(p, bid, nb, lds);
  SEAM();
  phase_mixer(p, bid, nb, lds);
  SEAM();
  phase_merge(p, bid, nb, lds);
  SEAM();
  phase_wout(p, bid, nb, lds); phase_tabconv(p, bid, nb);
  SEAM();
  phase_rows1(p, bid, nb);
  SEAM();
  phase_peerq(p, bid, nb, lds);
  SEAM();
  phase_peersel(p, bid, nb, lds);
  SEAM();
  phase_peerdown(p, bid, nb);
  SEAM();
  phase_peercoef(p, bid, nb);
  SEAM();
  phase_peerup(p, bid, nb);
  SEAM();
  phase_final(p, bid, nb);
  if (PROBE_PHASE >= 0) {
    if (PROBE_PHASE == nph) { asm volatile("s_waitcnt vmcnt(0)" ::: "memory"); grid.sync(); tprobe = __builtin_amdgcn_s_memrealtime() - tprev; }
    if (bid == 0 && threadIdx.x == 0) { const unsigned long long t0 = __builtin_amdgcn_s_memrealtime(); while (__builtin_amdgcn_s_memrealtime() - t0 < tprobe) __builtin_amdgcn_s_sleep(8); }
  }
}

extern "C" void kernel_launch(void* const* d_in, const int* in_sizes, int n_in, void* d_out, int out_size, void* d_ws, size_t ws_size, hipStream_t stream) {
  static int grid_blocks = 0;
  if (!grid_blocks) {
    int dev = 0, cus = 0, per_cu = 0;
    hipGetDevice(&dev);
    hipDeviceGetAttribute(&cus, hipDeviceAttributeMultiprocessorCount, dev);
    (void)hipFuncSetAttribute((const void*)fwd, hipFuncAttributeMaxDynamicSharedMemorySize, LDS_BYTES);
    hipOccupancyMaxActiveBlocksPerMultiprocessor(&per_cu, (const void*)fwd, NT, LDS_BYTES);
    if (per_cu < 1) per_cu = 1;
    if (per_cu > 2) per_cu = 2;
    grid_blocks = cus * per_cu;
  }
  Params p{};
  const float** f = (const float**)&p;
  for (int i = 0; i < 23; ++i) f[i] = (const float*)d_in[i];
  p.out = (float*)d_out; p.ws = (char*)d_ws;
  void* args[] = {&p};
  hipError_t e = hipLaunchCooperativeKernel((const void*)fwd, dim3(grid_blocks), dim3(NT), args, LDS_BYTES, stream);
  if (e != hipSuccess) fprintf(stderr, "cooperative launch failed: %s (grid %d)\n", hipGetErrorString(e), grid_blocks);
}
```

```cpp
#include <hip/hip_runtime.h>
#include <hip/hip_cooperative_groups.h>
#include <stdint.h>
#include <math.h>
#include <cstdio>

#define DI __device__ __forceinline__
#define LAS __attribute__((address_space(3)))
typedef unsigned short bf16_t;
typedef short bf16x8 __attribute__((ext_vector_type(8)));
typedef short s16x4 __attribute__((ext_vector_type(4)));
typedef float f32x4 __attribute__((ext_vector_type(4)));
typedef float f32x16 __attribute__((ext_vector_type(16)));
typedef float f32x2 __attribute__((ext_vector_type(2)));
typedef unsigned u32x4 __attribute__((ext_vector_type(4)));
typedef unsigned u32x2 __attribute__((ext_vector_type(2)));
typedef __bf16 bf16x2_t __attribute__((ext_vector_type(2)));

constexpr int NT = 256;
constexpr int T_ = 32768, S_ = 8192;
constexpr int PP = 5632;
constexpr int NPAD = 5760;
constexpr float LOG2E = 1.4426950408889634f;
constexpr size_t MiB = 1u << 20;

constexpr size_t WS_CTL = 0;
constexpr size_t WS_MOD = 1 * MiB;
constexpr size_t WS_WIN = 2 * MiB;
constexpr size_t WS_WFO = 14 * MiB;
constexpr size_t WS_WGO = 15 * MiB;
constexpr size_t WS_WOUT = 16 * MiB;
constexpr size_t WS_WQ = 18 * MiB;
constexpr size_t WS_KEYS = 22 * MiB;
constexpr size_t WS_SMALL = 23 * MiB;
constexpr size_t WS_FNEG = 25 * MiB;
constexpr size_t WS_KNPM = 26 * MiB + 65536;
constexpr size_t WS_GL = 26 * MiB;
constexpr size_t WS_SC = 32 * MiB;
constexpr size_t WS_H = 32 * MiB;
constexpr size_t WS_P = 96 * MiB;
constexpr size_t WS_UF = 448 * MiB;
constexpr size_t WS_WF = 480 * MiB;
constexpr size_t WS_QY = 96 * MiB;
constexpr size_t WS_PU = 224 * MiB;
constexpr size_t WS_PV = 240 * MiB;
constexpr size_t WS_UINV = 256 * MiB;
constexpr size_t WS_VINV = 256 * MiB + 65536;
constexpr size_t WS_EIDX = 288 * MiB;
constexpr size_t WS_GATE = 304 * MiB;
constexpr size_t WS_PD = 320 * MiB;
constexpr size_t WS_Y2 = 96 * MiB;
constexpr size_t WS_COEF = 32 * MiB;
constexpr size_t WS_SSQ = 48 * MiB;

DI int tidx() { int t = threadIdx.x; asm volatile("" : "+v"(t)); return t; }
DI unsigned pk2(float lo, float hi) { f32x2 v = {lo, hi}; bf16x2_t b = __builtin_convertvector(v, bf16x2_t); return __builtin_bit_cast(unsigned, b); }
DI bf16_t f2bf(float x) { return (bf16_t)(pk2(x, 0.f) & 0xffffu); }
DI float bf2f(bf16_t v) { return __uint_as_float(((unsigned)v) << 16); }
DI float bflo(unsigned u) { return __uint_as_float(u << 16); }
DI float bfhi(unsigned u) { return __uint_as_float(u & 0xffff0000u); }
DI float wave_sum(float v) {
#pragma unroll
  for (int d = 32; d >= 1; d >>= 1) v += __shfl_xor(v, d);
  return v;
}
DI unsigned wave_max_u(unsigned v) {
#pragma unroll
  for (int d = 32; d >= 1; d >>= 1) { unsigned o = (unsigned)__shfl_xor((int)v, d); v = o > v ? o : v; }
  return v;
}
DI float sigmoidf_(float x) { return 1.f / (1.f + __expf(-x)); }
DI float softplusf_(float x) { return fmaxf(x, 0.f) + log1pf(__expf(-fabsf(x))); }
DI int crow(int r, int hi) { return (r & 3) + 8 * (r >> 2) + 4 * hi; }
#define MFMA16(a, b, c) __builtin_amdgcn_mfma_f32_16x16x32_bf16((a), (b), (c), 0, 0, 0)
#define MFMA32(a, b, c) __builtin_amdgcn_mfma_f32_32x32x16_bf16((a), (b), (c), 0, 0, 0)
DI s16x4 tr16(const LAS char* p) { typedef short v4i16_t __attribute__((ext_vector_type(4))); return __builtin_bit_cast(s16x4, __builtin_amdgcn_ds_read_tr16_b64_v4i16((LAS v4i16_t*)p)); }
DI bf16x8 cat8(s16x4 lo, s16x4 hi) { return __builtin_shufflevector(lo, hi, 0, 1, 2, 3, 4, 5, 6, 7); }
DI bf16x8 pack8(float a0, float a1, float a2, float a3, float a4, float a5, float a6, float a7) {
  u32x4 p = {pk2(a0, a1), pk2(a2, a3), pk2(a4, a5), pk2(a6, a7)}; return __builtin_bit_cast(bf16x8, p);
}

struct Params {
  const float *x, *c, *w_ada, *b_ada, *g_pre_mix, *g_post_mix, *w_in, *b_fgate, *fox_w_o, *conv_w, *a_log, *dt_bias, *gdn_norm_w, *gdn_w_o,
      *b_branch_gate, *w_out, *g_pre_ffn, *g_post_ffn, *peer_w_query, *peer_keys1, *peer_keys2, *peer_u, *peer_v;
  float* out; char* ws;
};

DI void phase_mod(const Params& p, int bid, int nb, char* lds) {
  float* sc = (float*)lds;
  float* part = sc + 4096;
  const int tid = tidx();
  for (int i = tid; i < 4096; i += NT) { float v = p.c[i]; sc[i] = v / (1.f + __expf(-v)); }
  __syncthreads();
  float* mod = (float*)(p.ws + WS_MOD);
  for (int g = bid; g < 96; g += nb) {
    const int cc = tid & 63, kg = tid >> 6, col = g * 64 + cc;
    float a0 = 0.f, a1 = 0.f, a2 = 0.f, a3 = 0.f;
#pragma unroll 8
    for (int k = kg; k < 1024; k += 4) { const float w = p.w_ada[(size_t)k * 6144 + col]; a0 += sc[k] * w; a1 += sc[1024 + k] * w; a2 += sc[2048 + k] * w; a3 += sc[3072 + k] * w; }
    part[(kg * 4 + 0) * 64 + cc] = a0; part[(kg * 4 + 1) * 64 + cc] = a1; part[(kg * 4 + 2) * 64 + cc] = a2; part[(kg * 4 + 3) * 64 + cc] = a3;
    __syncthreads();
    { const int b = tid >> 6; float s = part[(0 * 4 + b) * 64 + cc] + part[(1 * 4 + b) * 64 + cc] + part[(2 * 4 + b) * 64 + cc] + part[(3 * 4 + b) * 64 + cc];
      mod[b * 6144 + col] = s + p.b_ada[col]; }
    __syncthreads();
  }
}

DI int inproj_colmap(int n) {
  if (n < 1536) return n;
  if (n < 3584) return 1544 + (n - 1536);
  if (n < 5632) return 3600 + (n - 3584);
  if (n < 5640) return 1536 + (n - 5632);
  if (n < 5648) return 3592 + (n - 5640);
  return -1;
}
DI void transpose_tile(const float* src, int ldsrc, bf16_t* dst, int K, int n0, int k0, bool permute, float* tile) {
  const int tid = tidx(), tx = tid & 63, ty = tid >> 6;
  const int n = n0 + tx; const int oc = permute ? inproj_colmap(n) : n;
#pragma unroll 4
  for (int i = 0; i < 16; ++i) { const int ky = ty + 4 * i; tile[ky * 65 + tx] = (oc >= 0) ? src[(size_t)(k0 + ky) * ldsrc + oc] : 0.f; }
  __syncthreads();
#pragma unroll 4
  for (int i = 0; i < 16; ++i) { const int ny = ty + 4 * i; dst[(size_t)(n0 + ny) * K + k0 + tx] = f2bf(tile[tx * 65 + ny]); }
  __syncthreads();
}
DI void phase_wconv(const Params& p, int bid, int nb, char* lds) {
  float* tile = (float*)lds;
  for (int t = bid; t < 2464; t += nb) {
    if (t < 1440) transpose_tile(p.w_in, 5648, (bf16_t*)(p.ws + WS_WIN), 1024, (t / 16) * 64, (t % 16) * 64, true, tile);
    else if (t < 1568) { const int u = t - 1440; transpose_tile(p.fox_w_o, 1024, (bf16_t*)(p.ws + WS_WFO), 512, (u / 8) * 64, (u % 8) * 64, false, tile); }
    else if (t < 1696) { const int u = t - 1568; transpose_tile(p.gdn_w_o, 1024, (bf16_t*)(p.ws + WS_WGO), 512, (u / 8) * 64, (u % 8) * 64, false, tile); }
    else if (t < 1952) { const int u = t - 1696; transpose_tile(p.w_out, 1024, (bf16_t*)(p.ws + WS_WOUT), 1024, (u / 16) * 64, (u % 16) * 64, false, tile); }
    else { const int u = t - 1952; transpose_tile(p.peer_w_query, 2048, (bf16_t*)(p.ws + WS_WQ), 1024, (u / 16) * 64, (u % 16) * 64, false, tile); }
  }
  bf16_t* kd = (bf16_t*)(p.ws + WS_KEYS);
  for (int i = bid * NT + tidx(); i < 32768; i += nb * NT) kd[i] = f2bf(i < 16384 ? p.peer_keys1[i] : p.peer_keys2[i - 16384]);
}
DI unsigned pk4_fp8(float a, float b, float c, float d) { int w = 0; w = __builtin_amdgcn_cvt_pk_fp8_f32(a, b, w, false); w = __builtin_amdgcn_cvt_pk_fp8_f32(c, d, w, true); return (unsigned)w; }
DI void phase_tabconv(const Params& p, int bid, int nb) {
  const int lane = tidx() & 63, gw = bid * 4 + (tidx() >> 6), nw = nb * 4;
  for (int r = gw; r < 32768; r += nw) {
    const bool second = r >= 16384; const int e = r & 16383;
    const float* src = (second ? p.peer_v : p.peer_u) + (size_t)e * 1024 + 16 * lane;
    f32x4 v[4]; float am = 0.f;
#pragma unroll
    for (int i = 0; i < 4; ++i) { v[i] = *(const f32x4*)(src + 4 * i); am = fmaxf(am, fmaxf(fmaxf(fabsf(v[i][0]), fabsf(v[i][1])), fmaxf(fabsf(v[i][2]), fabsf(v[i][3])))); }
#pragma unroll
    for (int d = 32; d >= 1; d >>= 1) am = fmaxf(am, __shfl_xor(am, d));
    float sc = 1.f, inv = 1.f;
    if (am > 1e-30f) { const int ex = (int)floorf(log2f(448.f / am)); sc = exp2f((float)ex); inv = exp2f((float)-ex); }
    u32x4 o;
#pragma unroll
    for (int i = 0; i < 4; ++i) o[i] = pk4_fp8(v[i][0] * sc, v[i][1] * sc, v[i][2] * sc, v[i][3] * sc);
    *(u32x4*)(p.ws + (second ? WS_PV : WS_PU) + ((size_t)(lane >> 3) * 16384 + e) * 128 + 16 * (lane & 7)) = o;
    if (lane == 0) ((float*)(p.ws + (second ? WS_VINV : WS_UINV)))[e] = inv;
  }
}

DI void phase_xnorm(const Params& p, int bid, int nb) {
  const int lane = tidx() & 63, gw = bid * 4 + (tidx() >> 6), nw = nb * 4;
  const float* mod = (const float*)(p.ws + WS_MOD);
  bf16_t* h = (bf16_t*)(p.ws + WS_H);
  for (int row = gw; row < T_; row += nw) {
    const int b = row >> 13;
    const f32x4* xr = (const f32x4*)(p.x + (size_t)row * 1024);
    f32x4 v[4]; float ss = 0.f;
#pragma unroll
    for (int i = 0; i < 4; ++i) { v[i] = xr[lane + 64 * i]; ss += v[i][0] * v[i][0] + v[i][1] * v[i][1] + v[i][2] * v[i][2] + v[i][3] * v[i][3]; }
    ss = wave_sum(ss);
    const float rstd = rsqrtf(ss * (1.f / 1024.f) + 1e-6f);
#pragma unroll
    for (int i = 0; i < 4; ++i) {
      const int col = 4 * lane + 256 * i;
      const f32x4 g4 = *(const f32x4*)(p.g_pre_mix + col), sh = *(const f32x4*)(mod + b * 6144 + col), sc = *(const f32x4*)(mod + b * 6144 + 1024 + col);
      const f32x4 y = (v[i] * rstd * g4) * (1.f + sc) + sh;
      u32x2 o = {pk2(y[0], y[1]), pk2(y[2], y[3])};
      *(u32x2*)(h + (size_t)row * 1024 + col) = o;
    }
  }
}

struct GemmArgs { const bf16_t* A; int lda; const bf16_t* Bt; int ldb; int K; };
DI int swz(int row, int c) { return row * 128 + ((c ^ ((row >> 1) & 7)) << 4); }
template <class Epi>
DI void gemm_tile(const GemmArgs& g, int m0, int n0, char* lds, const Epi& epi) {
  const int tid = tidx(), lane = tid & 63, wid = tid >> 6, wr = wid >> 1, wc = wid & 1, fr = lane & 15, fq = lane >> 4;
  f32x4 acc[4][4];
#pragma unroll
  for (int i = 0; i < 4; ++i)
#pragma unroll
    for (int j = 0; j < 4; ++j) acc[i][j] = (f32x4){0.f, 0.f, 0.f, 0.f};
  const int srow = 32 * wid + (lane >> 3);
  const bf16_t* ag[4]; const bf16_t* bg[4];
#pragma unroll
  for (int i = 0; i < 4; ++i) { const int r = srow + 8 * i, c = (lane & 7) ^ ((r >> 1) & 7);
    ag[i] = g.A + (size_t)(m0 + r) * g.lda + 8 * c; bg[i] = g.Bt + (size_t)(n0 + r) * g.ldb + 8 * c; }
#define GT_ISSUE(kt, buf) do { _Pragma("unroll") for (int i = 0; i < 4; ++i) { \
    __builtin_amdgcn_global_load_lds((const unsigned*)(ag[i] + (kt) * 64), (LAS unsigned*)(lds + (buf) * 32768 + (4 * wid + i) * 1024), 16, 0, 0); \
    __builtin_amdgcn_global_load_lds((const unsigned*)(bg[i] + (kt) * 64), (LAS unsigned*)(lds + (buf) * 32768 + 16384 + (4 * wid + i) * 1024), 16, 0, 0); } } while (0)
  const int nk = g.K / 64;
  __syncthreads();
  GT_ISSUE(0, 0);
#pragma unroll 1
  for (int kt = 0; kt < nk; ++kt) {
    __syncthreads();
    if (kt + 1 < nk) GT_ISSUE(kt + 1, (kt + 1) & 1);
    const char* As = lds + (kt & 1) * 32768; const char* Bs = As + 16384;
#pragma unroll
    for (int kk = 0; kk < 2; ++kk) {
      bf16x8 af[4], bfm[4];
#pragma unroll
      for (int i = 0; i < 4; ++i) { af[i] = *(const bf16x8*)(As + swz(wr * 64 + i * 16 + fr, kk * 4 + fq)); bfm[i] = *(const bf16x8*)(Bs + swz(wc * 64 + i * 16 + fr, kk * 4 + fq)); }
#pragma unroll
      for (int i = 0; i < 4; ++i)
#pragma unroll
        for (int j = 0; j < 4; ++j) acc[i][j] = MFMA16(bfm[j], af[i], acc[i][j]);
    }
  }
#undef GT_ISSUE
#pragma unroll
  for (int i = 0; i < 4; ++i)
#pragma unroll
    for (int j = 0; j < 4; ++j) epi(m0 + wr * 64 + i * 16 + fr, n0 + wc * 64 + j * 16 + 4 * fq, acc[i][j]);
}

struct TileMap {
  int x, r, R, Nt, ngroups, L;
  DI void init(int bid, int nb, int Nt_) { x = bid & 7; r = bid >> 3; R = nb >> 3; Nt = Nt_; ngroups = (Nt_ + 7) >> 3; L = r; }
  DI bool next(int& m, int& n) {
    for (;;) {
      if (L >= 256 * ngroups) return false;
      const int ng = L >> 8, rem = L & 255, mg = rem >> 6, ni = (rem & 63) >> 3, mi = rem & 7;
      L += R;
      m = 32 * x + 8 * mg + mi; n = 8 * ng + ni;
      if (n < Nt) return true;
    }
  }
};
struct EpiInproj {
  bf16_t* proj; float* small; const float *bbg, *b_fgate, *a_log, *dt_bias;
  DI void operator()(int row, int col, f32x4 v) const {
    if (col < 3584) { u32x2 o = {pk2(v[0], v[1]), pk2(v[2], v[3])}; *(u32x2*)(proj + (size_t)row * PP + col) = o; }
    else if (col < 5632) {
      const f32x4 b = *(const f32x4*)(bbg + (col - 3584));
      u32x2 o = {pk2(sigmoidf_(v[0] + b[0]), sigmoidf_(v[1] + b[1])), pk2(sigmoidf_(v[2] + b[2]), sigmoidf_(v[3] + b[3]))};
      *(u32x2*)(proj + (size_t)row * PP + col) = o;
    } else if (col < 5648) {
      const int j0 = col - 5632;
#pragma unroll
      for (int e = 0; e < 4; ++e) { const int j = j0 + e; float r;
        if (j < 8) r = -softplusf_(-(v[e] + b_fgate[j]));
        else if (j < 12) r = sigmoidf_(v[e]);
        else r = -__expf(a_log[j - 12]) * softplusf_(v[e] + dt_bias[j - 12]);
        small[(size_t)row * 16 + j] = r; }
    }
  }
};
DI void phase_inproj(const Params& p, int bid, int nb, char* lds) {
  GemmArgs g = {(const bf16_t*)(p.ws + WS_H), 1024, (const bf16_t*)(p.ws + WS_WIN), 1024, 1024};
  EpiInproj e = {(bf16_t*)(p.ws + WS_P), (float*)(p.ws + WS_SMALL), p.b_branch_gate, p.b_fgate, p.a_log, p.dt_bias};
  TileMap tm; tm.init(bid, nb, 45); int m, n; while (tm.next(m, n)) gemm_tile(g, m * 128, n * 128, lds, e);
}

DI void phase_foxcum(const Params& p, int bid, int nb, char* lds) {
  float* tot = (float*)lds;
  const float* small = (const float*)(p.ws + WS_SMALL);
  float* fneg = (float*)(p.ws + WS_FNEG);
  const int tid = tidx();
  for (int bh = bid; bh < 32; bh += nb) {
    const int b = bh >> 3, h = bh & 7;
    float v[32]; float run = 0.f;
#pragma unroll
    for (int i = 0; i < 32; ++i) { run += small[((size_t)b * S_ + tid * 32 + i) * 16 + h]; v[i] = run; }
    tot[tid] = run; __syncthreads();
    float off = 0.f; for (int j = 0; j < tid; ++j) off += tot[j];
#pragma unroll
    for (int i = 0; i < 32; ++i) fneg[(size_t)bh * S_ + tid * 32 + i] = -(v[i] + off) * LOG2E;
    __syncthreads();
  }
}
DI void phase_qknorm(const Params& p, int bid, int nb) {
  const int lane = tidx() & 63, gw = bid * 4 + (tidx() >> 6), nw = nb * 4;
  const bf16_t* proj = (const bf16_t*)(p.ws + WS_P);
  unsigned* qk = (unsigned*)(p.ws + WS_CTL) + 64;
  for (int it = gw; it < 4096; it += nw) {
    const int bh = it >> 7, j = it & 127, b = bh >> 3, h = bh & 7;
    const bf16_t* rp = proj + ((size_t)b * S_ + j * 64 + lane) * PP + h * 64;
    float sq = 0.f, sk = 0.f;
#pragma unroll
    for (int q = 0; q < 8; ++q) { const u32x4 wq = *(const u32x4*)(rp + 8 * q), wk = *(const u32x4*)(rp + 512 + 8 * q);
#pragma unroll
      for (int e = 0; e < 4; ++e) { const float a0 = bflo(wq[e]), a1 = bfhi(wq[e]), c0 = bflo(wk[e]), c1 = bfhi(wk[e]); sq += a0 * a0 + a1 * a1; sk += c0 * c0 + c1 * c1; } }
#pragma unroll
    for (int d = 32; d >= 1; d >>= 1) { sq = fmaxf(sq, __shfl_xor(sq, d)); sk = fmaxf(sk, __shfl_xor(sk, d)); }
    if (lane == 0) { atomicMax(qk + 2 * bh, __float_as_uint(sq)); atomicMax(qk + 2 * bh + 1, __float_as_uint(sk)); }
  }
}

DI int swzv(int row, int c) { return row * 128 + ((c ^ (((row >> 1) & 7) ^ ((row & 2) << 1))) << 4); }
DI void attn_unit(const Params& p, int bh, int qb, char* lds) {
  const int tid = tidx(), lane = tid & 63, wid = tid >> 6, r32 = lane & 31, hi = lane >> 5;
  const int b = bh >> 3, h = bh & 7;
  bf16_t* proj = (bf16_t*)(p.ws + WS_P);
  const float* fneg = (const float*)(p.ws + WS_FNEG) + (size_t)bh * S_;
  const size_t rowbase = (size_t)b * S_;
  char* Ks = lds; char* Vs = lds + 8192; float* Fs = (float*)(lds + 16384);
  const LAS char* Vs3 = (const LAS char*)Vs;
  const int qrow = qb * 128 + wid * 32 + r32;
  bf16_t* qptr = proj + (rowbase + qrow) * PP + h * 64;
  bf16x8 qr[4];
  {
    const float c2 = 0.125f * LOG2E;
#pragma unroll
    for (int ks = 0; ks < 4; ++ks) { const u32x4 w = *(const u32x4*)(qptr + ks * 16 + hi * 8);
      qr[ks] = pack8(bflo(w[0]) * c2, bfhi(w[0]) * c2, bflo(w[1]) * c2, bfhi(w[1]) * c2, bflo(w[2]) * c2, bfhi(w[2]) * c2, bflo(w[3]) * c2, bfhi(w[3]) * c2); }
  }
  f32x16 o0, o1;
#pragma unroll
  for (int r = 0; r < 16; ++r) { o0[r] = 0.f; o1[r] = 0.f; }
  float m = -1e30f, l = 0.f;
  const float qkmax = sqrtf(__uint_as_float(((const unsigned*)(p.ws + WS_CTL))[64 + 2 * bh])) * sqrtf(__uint_as_float(((const unsigned*)(p.ws + WS_CTL))[64 + 2 * bh + 1])) * (0.125f * LOG2E * 1.02f);
  int* flags = (int*)(lds + 16384 + 256);
  const int ntiles = 2 * qb + 2;
  const int srow = tid >> 3, sc = tid & 7;
  const bf16_t* kg = proj + (rowbase + srow) * PP + 512 + h * 64 + sc * 8;
  const bf16_t* vg = proj + (rowbase + srow) * PP + 1024 + h * 64 + sc * 8;
  u32x4 rk[2], rv[2]; f32x4 rf = {0.f, 0.f, 0.f, 0.f};
  {
    const int j0 = ntiles - 1;
#pragma unroll
    for (int i = 0; i < 2; ++i) { rk[i] = *(const u32x4*)(kg + (size_t)(j0 * 64 + 32 * i) * PP); rv[i] = *(const u32x4*)(vg + (size_t)(j0 * 64 + 32 * i) * PP); }
    if (tid < 16) rf = *(const f32x4*)(fneg + j0 * 64 + tid * 4);
  }
  if (tid < 8) flags[tid] = 0;
  const int wave_maxrow = qb * 128 + wid * 32 + 31;
  for (int j = ntiles - 1; j >= 0; --j) {
    __syncthreads();
#pragma unroll
    for (int i = 0; i < 2; ++i) { *(u32x4*)(Ks + swz(srow + 32 * i, sc)) = rk[i]; *(u32x4*)(Vs + swzv(srow + 32 * i, sc)) = rv[i]; }
    if (tid < 16) *(f32x4*)(Fs + tid * 4) = rf;
    __syncthreads();
    { const int* fl = flags + 4 * ((j + 1) & 1); if ((fl[0] & fl[1] & fl[2] & fl[3]) != 0) break; }
    float ubf = 0.f;
    if (j > 0) { ubf = fneg[j * 64 - 1]; }
    if (j > 0) {
#pragma unroll
      for (int i = 0; i < 2; ++i) { rk[i] = *(const u32x4*)(kg + (size_t)((j - 1) * 64 + 32 * i) * PP); rv[i] = *(const u32x4*)(vg + (size_t)((j - 1) * 64 + 32 * i) * PP); }
      if (tid < 16) rf = *(const f32x4*)(fneg + (j - 1) * 64 + tid * 4);
    }
    if (j * 64 <= wave_maxrow) {
    f32x16 p0, p1;
#pragma unroll
    for (int g = 0; g < 4; ++g) { const f32x4 a = *(const f32x4*)(Fs + 8 * g + 4 * hi), c = *(const f32x4*)(Fs + 32 + 8 * g + 4 * hi);
#pragma unroll
      for (int e = 0; e < 4; ++e) { p0[4 * g + e] = a[e]; p1[4 * g + e] = c[e]; } }
#pragma unroll
    for (int ks = 0; ks < 4; ++ks) {
      const bf16x8 k0 = *(const bf16x8*)(Ks + swz(r32, 2 * ks + hi)), k1 = *(const bf16x8*)(Ks + swz(32 + r32, 2 * ks + hi));
      p0 = MFMA32(k0, qr[ks], p0); p1 = MFMA32(k1, qr[ks], p1);
    }
    if (j >= 2 * qb) {
      const int kb = j * 64;
#pragma unroll
      for (int r = 0; r < 16; ++r) { const int kv = kb + crow(r, hi); if (kv > qrow) p0[r] = -INFINITY; if (kv + 32 > qrow) p1[r] = -INFINITY; }
    }
    float mx = fmaxf(p0[0], p1[0]);
#pragma unroll
    for (int r = 1; r < 16; ++r) mx = fmaxf(mx, fmaxf(p0[r], p1[r]));
    mx = fmaxf(mx, __shfl_xor(mx, 32));
    const float mn = fmaxf(m, mx), alpha = exp2f(m - mn); m = mn;
    float ps = 0.f;
#pragma unroll
    for (int r = 0; r < 16; ++r) { p0[r] = exp2f(p0[r] - mn); p1[r] = exp2f(p1[r] - mn); ps += p0[r] + p1[r]; }
    l = l * alpha + ps;
#pragma unroll
    for (int r = 0; r < 16; ++r) { o0[r] *= alpha; o1[r] *= alpha; }
    bf16x8 pf[2][2];
    pf[0][0] = pack8(p0[0], p0[1], p0[2], p0[3], p0[4], p0[5], p0[6], p0[7]);
    pf[0][1] = pack8(p0[8], p0[9], p0[10], p0[11], p0[12], p0[13], p0[14], p0[15]);
    pf[1][0] = pack8(p1[0], p1[1], p1[2], p1[3], p1[4], p1[5], p1[6], p1[7]);
    pf[1][1] = pack8(p1[8], p1[9], p1[10], p1[11], p1[12], p1[13], p1[14], p1[15]);
#pragma unroll
    for (int pb = 0; pb < 2; ++pb)
#pragma unroll
      for (int s = 0; s < 2; ++s) {
        const int rowa = 32 * pb + 16 * s + 4 * hi + ((lane & 15) >> 2);
#pragma unroll
        for (int d0 = 0; d0 < 2; ++d0) {
          const int cl = 4 * d0 + 2 * ((lane >> 4) & 1) + ((lane & 3) >> 1), sub = 8 * (lane & 1);
          const s16x4 lo = tr16(Vs3 + swzv(rowa, cl) + sub), hi4 = tr16(Vs3 + swzv(rowa + 8, cl) + sub);
          const bf16x8 vf = cat8(lo, hi4);
          if (d0 == 0) o0 = MFMA32(vf, pf[pb][s], o0); else o1 = MFMA32(vf, pf[pb][s], o1);
        }
      }
    }
    if (j > 0) {
      const float ub = qkmax + ubf + log2f((float)(j * 64));
      const int ok = __all((ub - m) <= -30.f);
      if (lane == 0) flags[4 * (j & 1) + wid] = ok;
    }
  }
  l += __shfl_xor(l, 32);
  const float inv = 1.f / l;
#pragma unroll
  for (int g = 0; g < 4; ++g) {
    u32x2 a = {pk2(o0[4 * g] * inv, o0[4 * g + 1] * inv), pk2(o0[4 * g + 2] * inv, o0[4 * g + 3] * inv)};
    u32x2 c = {pk2(o1[4 * g] * inv, o1[4 * g + 1] * inv), pk2(o1[4 * g + 2] * inv, o1[4 * g + 3] * inv)};
    *(u32x2*)(qptr + 8 * g + 4 * hi) = a; *(u32x2*)(qptr + 32 + 8 * g + 4 * hi) = c;
  }
}
DI void phase_attn(const Params& p, int bid, int nb, char* lds) {
  for (int u = bid; u < 2048; u += nb) attn_unit(p, u & 31, 63 - (u >> 5), lds);
}

constexpr int QP = 136;
DI void gdn_prep_unit(const Params& p, int U, char* lds) {
  const int tid = tidx(), lane = tid & 63, wid = tid >> 6, fr = lane & 15, fq = lane >> 4;
  const int b = U >> 9, h = (U >> 7) & 3, c = U & 127;
  const size_t t0 = (size_t)b * S_ + c * 64;
  const int s0 = c * 64;
  const bf16_t* proj = (const bf16_t*)(p.ws + WS_P);
  const float* small = (const float*)(p.ws + WS_SMALL);
  bf16_t* q_s = (bf16_t*)lds; bf16_t* k_s = q_s + 64 * QP; bf16_t* v_s = k_s + 64 * QP;
  float* Lm = (float*)(lds + 3 * 17408);
  bf16_t* T1 = (bf16_t*)Lm; bf16_t* T2 = T1 + 64 * 72;
  float* gcs = (float*)(lds + 3 * 17408 + 18432);
  bf16_t* QF = (bf16_t*)((char*)p.out) + (size_t)U * 8192;
  bf16_t* KF = (bf16_t*)((char*)p.out + 32 * MiB) + (size_t)U * 8192;
  bf16_t* AF = (bf16_t*)((char*)p.out + 64 * MiB) + (size_t)U * 4096;
  bf16_t* UF = (bf16_t*)(p.ws + WS_UF) + (size_t)U * 8192;
  bf16_t* WF = (bf16_t*)(p.ws + WS_WF) + (size_t)U * 8192;
  __syncthreads();
  if (wid == 0) {
    const float g = small[(t0 + lane) * 16 + 12 + h], bt = small[(t0 + lane) * 16 + 8 + h];
    float cs = g;
#pragma unroll
    for (int d = 1; d < 64; d <<= 1) { const float n = __shfl_up(cs, d); if (lane >= d) cs += n; }
    const float gl = __shfl(cs, 63);
    gcs[lane] = cs; gcs[64 + lane] = bt; gcs[128 + lane] = __expf(cs); gcs[192 + lane] = __expf(gl - cs);
    if (lane == 0) { gcs[256] = __expf(gl); ((float*)(p.ws + WS_GL))[U] = __expf(gl); }
  }
  __syncthreads();
  {
#pragma unroll
    for (int X = 0; X < 3; ++X) {
      const int col = 1536 + 512 * X + h * 128 + 2 * lane, cb = 512 * X + h * 128 + 2 * lane;
      float w0[4], w1[4];
#pragma unroll
      for (int j = 0; j < 4; ++j) { w0[j] = p.conv_w[j * 1536 + cb]; w1[j] = p.conv_w[j * 1536 + cb + 1]; }
      bf16_t* dst = X == 0 ? q_s : (X == 1 ? k_s : v_s);
      float xa[4], xb[4];
      const int i0 = 16 * wid;
#pragma unroll
      for (int j = 0; j < 3; ++j) { const int rr = i0 - 3 + j; unsigned u = 0u; if (s0 + rr >= 0) u = *(const unsigned*)(proj + (size_t)((long)t0 + rr) * PP + col); xa[j + 1] = bflo(u); xb[j + 1] = bfhi(u); }
      for (int i = i0; i < i0 + 16; ++i) {
        xa[0] = xa[1]; xa[1] = xa[2]; xa[2] = xa[3]; xb[0] = xb[1]; xb[1] = xb[2]; xb[2] = xb[3];
        const unsigned u = *(const unsigned*)(proj + (t0 + i) * PP + col); xa[3] = bflo(u); xb[3] = bfhi(u);
        float y0 = w0[0] * xa[0] + w0[1] * xa[1] + w0[2] * xa[2] + w0[3] * xa[3];
        float y1 = w1[0] * xb[0] + w1[1] * xb[1] + w1[2] * xb[2] + w1[3] * xb[3];
        y0 = y0 * sigmoidf_(y0); y1 = y1 * sigmoidf_(y1);
        if (X < 2) { const float ss = wave_sum(y0 * y0 + y1 * y1); const float rn = rsqrtf(ss + 1e-6f); y0 *= rn; y1 *= rn; }
        *(unsigned*)(dst + i * QP + 2 * lane) = pk2(y0, y1);
        if (X == 0) {
          const float f = 0.08838834764831845f * gcs[128 + i];
          const int d = 2 * lane, mm = d >> 5, ss2 = (d >> 4) & 1, aa = (d >> 3) & 1, hh = (d >> 2) & 1, bb = d & 3;
          const int lp = (i & 31) + 32 * hh;
          *(unsigned*)(QF + (size_t)(((((i >> 5) * 4 + mm) * 2 + ss2) * 64 + lp) * 8 + 4 * aa + bb)) = pk2(y0 * f, y1 * f);
        }
      }
    }
  }
  __syncthreads();
  {
    bf16x8 ka[4];
#pragma unroll
    for (int kk = 0; kk < 4; ++kk) ka[kk] = *(const bf16x8*)(k_s + (16 * wid + fr) * QP + kk * 32 + fq * 8);
#pragma unroll
    for (int ni = 0; ni < 4; ++ni) {
      f32x4 dkk = {0.f, 0.f, 0.f, 0.f}, dqk = {0.f, 0.f, 0.f, 0.f};
      const int i = 16 * ni + fr, jj0 = 16 * wid + 4 * fq;
      if (ni >= wid) {
#pragma unroll
        for (int kk = 0; kk < 4; ++kk) {
          const bf16x8 bk = *(const bf16x8*)(k_s + (16 * ni + fr) * QP + kk * 32 + fq * 8), bq = *(const bf16x8*)(q_s + (16 * ni + fr) * QP + kk * 32 + fq * 8);
          dkk = MFMA16(ka[kk], bk, dkk); dqk = MFMA16(ka[kk], bq, dqk);
        }
      }
      const float gi = gcs[i], bi = gcs[64 + i];
      f32x4 lv, av;
#pragma unroll
      for (int r = 0; r < 4; ++r) { const int jj = jj0 + r; const float dec = __expf(fminf(gi - gcs[jj], 0.f));
        lv[r] = (jj < i) ? bi * dkk[r] * dec : 0.f; av[r] = (jj <= i) ? dqk[r] * 0.08838834764831845f * dec : 0.f; }
      *(f32x4*)(Lm + i * 68 + jj0) = lv;
      const int lp = (i & 31) + 32 * (fq & 1);
      u32x2 o = {pk2(av[0], av[1]), pk2(av[2], av[3])};
      *(u32x2*)(AF + (size_t)((((((i >> 5) * 2 + (wid >> 1)) * 2 + (wid & 1)) * 64 + lp) * 8) + 4 * (fq >> 1))) = o;
    }
    for (int it = tid; it < 2048; it += NT) {
      const int d = it & 127, jg = it >> 7;
      float v4[4];
#pragma unroll
      for (int e = 0; e < 4; ++e) { const int jj = 4 * jg + e; v4[e] = bf2f(k_s[jj * QP + d]) * gcs[192 + jj]; }
      const int lp = (d & 31) + 32 * (jg & 1);
      u32x2 o = {pk2(v4[0], v4[1]), pk2(v4[2], v4[3])};
      *(u32x2*)(KF + (size_t)((((((d >> 5) * 2 + (jg >> 3)) * 2 + ((jg >> 2) & 1)) * 64 + lp) * 8) + 4 * ((jg >> 1) & 1))) = o;
    }
  }
  __syncthreads();
  if (wid == 0) {
    float* Ts = (float*)q_s;
    for (int i = 0; i < 64; ++i) {
      float a0 = (lane == i) ? 1.f : 0.f, a1 = 0.f, a2 = 0.f, a3 = 0.f;
      const float* Li = Lm + i * 68;
      int j = 0;
#pragma unroll 4
      for (; j + 4 <= i; j += 4) {
        const f32x4 Lv = *(const f32x4*)(Li + j);
        a0 -= Lv[0] * Ts[j * 64 + lane]; a1 -= Lv[1] * Ts[(j + 1) * 64 + lane]; a2 -= Lv[2] * Ts[(j + 2) * 64 + lane]; a3 -= Lv[3] * Ts[(j + 3) * 64 + lane];
      }
      for (; j < i; ++j) a0 -= Li[j] * Ts[j * 64 + lane];
      Ts[i * 64 + lane] = (a0 + a1) + (a2 + a3);
    }
    const float f1 = gcs[64 + lane], f2 = f1 * gcs[128 + lane];
    asm volatile("" ::: "memory");
    for (int i = 0; i < 64; ++i) { const float t = Ts[i * 64 + lane]; T1[i * 72 + lane] = f2bf(t * f1); T2[i * 72 + lane] = f2bf(t * f2); }
  }
  __syncthreads();
  {
    const LAS char* v3 = (const LAS char*)v_s; const LAS char* k3 = (const LAS char*)k_s;
    bf16x8 ta[2], tb[2];
#pragma unroll
    for (int kk = 0; kk < 2; ++kk) { ta[kk] = *(const bf16x8*)(T1 + (16 * wid + fr) * 72 + kk * 32 + fq * 8); tb[kk] = *(const bf16x8*)(T2 + (16 * wid + fr) * 72 + kk * 32 + fq * 8); }
#pragma unroll
    for (int nj = 0; nj < 8; ++nj) {
      f32x4 du = {0.f, 0.f, 0.f, 0.f}, dw = {0.f, 0.f, 0.f, 0.f};
#pragma unroll
      for (int kk = 0; kk < 2; ++kk) {
        const int jr = 32 * kk + 8 * fq + ((lane & 15) >> 2), cc = 16 * nj + 4 * (lane & 3);
        const bf16x8 vb = cat8(tr16(v3 + (jr * QP + cc) * 2), tr16(v3 + ((jr + 4) * QP + cc) * 2));
        const bf16x8 kb = cat8(tr16(k3 + (jr * QP + cc) * 2), tr16(k3 + ((jr + 4) * QP + cc) * 2));
        du = MFMA16(ta[kk], vb, du);
        dw = MFMA16(kb, tb[kk], dw);
      }
      {
        const int lp = 16 * (nj & 1) + fr + 32 * (fq & 1);
        u32x2 o = {pk2(du[0], du[1]), pk2(du[2], du[3])};
        *(u32x2*)(UF + (size_t)(((((wid >> 1) * 4 + (nj >> 1)) * 64 + lp) * 16) + 4 * (2 * (wid & 1) + (fq >> 1)))) = o;
      }
      {
        const int lp = 16 * (wid & 1) + fr + 32 * (fq & 1);
        u32x2 o = {pk2(-dw[0], -dw[1]), pk2(-dw[2], -dw[3])};
        *(u32x2*)(WF + (size_t)((((((wid >> 1) * 4 + (nj >> 1)) * 2 + (nj & 1)) * 64 + lp) * 8) + 4 * (fq >> 1))) = o;
      }
    }
  }
}
DI void phase_gdnprep(const Params& p, int bid, int nb, char* lds) {
  for (int U = bid; U < 2048; U += nb) gdn_prep_unit(p, U, lds);
}

DI bf16x8 packS(const f32x16& x, int s) { return pack8(x[8 * s], x[8 * s + 1], x[8 * s + 2], x[8 * s + 3], x[8 * s + 4], x[8 * s + 5], x[8 * s + 6], x[8 * s + 7]); }
DI void gdn_scan_seq(const Params& p, int bh16, char* lds) {
  const int tid = tidx(), lane = tid & 63, wv = tid >> 6;
  const float* glp = (const float*)(p.ws + WS_GL) + bh16 * 128;
  const char* wf = (const char*)(p.ws + WS_WF) + (size_t)bh16 * 128 * 16384 + tid * 16;
  const char* kf = (const char*)p.out + 32 * MiB + (size_t)bh16 * 128 * 16384 + tid * 16;
  const char* uf = (const char*)(p.ws + WS_UF) + (size_t)bh16 * 128 * 16384 + (size_t)(wv * 64 + lane) * 32;
  char* scp = p.ws + WS_SC + (size_t)bh16 * 128 * 32768 + (size_t)wv * 8192 + lane * 16;
#define SCAN_DMA(gsrc, ldsoff) __builtin_amdgcn_global_load_lds((const unsigned*)(gsrc), (LAS unsigned*)(lds + (ldsoff) + wv * 1024), 16, 0, 0)
#define SCAN_WK(c, slot) do { _Pragma("unroll") for (int i = 0; i < 4; ++i) { SCAN_DMA(wf + (size_t)(c) * 16384 + i * 4096, (slot) * 32768 + i * 4096); SCAN_DMA(kf + (size_t)(c) * 16384 + i * 4096, (slot) * 32768 + 16384 + i * 4096); } } while (0)
#define SCAN_U(c) do { _Pragma("unroll") for (int i2 = 0; i2 < 2; ++i2) { un[2 * i2] = *(const u32x4*)(uf + (size_t)(c) * 16384 + i2 * 8192); un[2 * i2 + 1] = *(const u32x4*)(uf + (size_t)(c) * 16384 + i2 * 8192 + 16); } gln = glp[c]; } while (0)
  f32x16 S[4];
#pragma unroll
  for (int m = 0; m < 4; ++m)
#pragma unroll
    for (int r = 0; r < 16; ++r) S[m][r] = 0.f;
  u32x4 un[4]; float gln;
  __syncthreads();
  SCAN_WK(0, 0); SCAN_U(0);
#pragma unroll 1
  for (int c = 0; c < 128; ++c) {
    __syncthreads();
    f32x16 vn[2];
#pragma unroll
    for (int i2 = 0; i2 < 2; ++i2) {
#pragma unroll
      for (int e = 0; e < 4; ++e) { vn[i2][2 * e] = bflo(un[2 * i2][e]); vn[i2][2 * e + 1] = bfhi(un[2 * i2][e]); vn[i2][8 + 2 * e] = bflo(un[2 * i2 + 1][e]); vn[i2][8 + 2 * e + 1] = bfhi(un[2 * i2 + 1][e]); }
    }
    const float gl = gln;
    asm volatile("" : "+v"(vn[0]), "+v"(vn[1]));
    __builtin_amdgcn_sched_barrier(0);
    if (c + 1 < 128) { SCAN_WK(c + 1, (c + 1) & 1); SCAN_U(c + 1); }
    const char* lw = lds + (c & 1) * 32768 + lane * 16; const char* lk = lw + 16384;
    char* sco = scp + (size_t)c * 32768;
#pragma unroll
    for (int m = 0; m < 4; ++m) {
      const bf16x8 sb0 = packS(S[m], 0), sb1 = packS(S[m], 1);
      *(bf16x8*)(sco + (m * 2 + 0) * 1024) = sb0; *(bf16x8*)(sco + (m * 2 + 1) * 1024) = sb1;
#pragma unroll
      for (int i2 = 0; i2 < 2; ++i2) {
        vn[i2] = MFMA32(*(const bf16x8*)(lw + ((i2 * 4 + m) * 2 + 0) * 1024), sb0, vn[i2]);
        vn[i2] = MFMA32(*(const bf16x8*)(lw + ((i2 * 4 + m) * 2 + 1) * 1024), sb1, vn[i2]);
      }
    }
    bf16x8 Vb[2][2];
#pragma unroll
    for (int j2 = 0; j2 < 2; ++j2) { Vb[j2][0] = packS(vn[j2], 0); Vb[j2][1] = packS(vn[j2], 1); }
#pragma unroll
    for (int m = 0; m < 4; ++m) {
#pragma unroll
      for (int r = 0; r < 16; ++r) S[m][r] *= gl;
#pragma unroll
      for (int j2 = 0; j2 < 2; ++j2)
#pragma unroll
        for (int s = 0; s < 2; ++s) S[m] = MFMA32(*(const bf16x8*)(lk + ((m * 2 + j2) * 2 + s) * 1024), Vb[j2][s], S[m]);
    }
  }
#undef SCAN_DMA
#undef SCAN_WK
#undef SCAN_U
  __syncthreads();
}
DI void gdn_out_unit(const Params& p, int U, char* lds) {
  const int tid = tidx(), lane = tid & 63, wv = tid >> 6, r32 = lane & 31, hi = lane >> 5;
  const int b = U >> 9, h = (U >> 7) & 3, c = U & 127;
  bf16_t* proj = (bf16_t*)(p.ws + WS_P);
  const bf16x8* WF = (const bf16x8*)((const bf16_t*)(p.ws + WS_WF) + (size_t)U * 8192) + lane;
  const bf16x8* QF = (const bf16x8*)((const bf16_t*)((char*)p.out) + (size_t)U * 8192) + lane;
  const bf16x8* AF = (const bf16x8*)((const bf16_t*)((char*)p.out + 64 * MiB) + (size_t)U * 4096) + lane;
  const bf16_t* UF = (const bf16_t*)(p.ws + WS_UF) + (size_t)U * 8192;
  const bf16x8* SC = (const bf16x8*)(p.ws + WS_SC + (size_t)U * 32768 + (size_t)wv * 8192) + lane;
  bf16_t* ol = (bf16_t*)lds;
  bf16x8 Sb[4][2];
#pragma unroll
  for (int m = 0; m < 4; ++m) { Sb[m][0] = SC[(m * 2 + 0) * 64]; Sb[m][1] = SC[(m * 2 + 1) * 64]; }
  f32x16 vn[2], o[2];
#pragma unroll
  for (int i2 = 0; i2 < 2; ++i2) {
    const u32x4 ua = *(const u32x4*)(UF + (size_t)((i2 * 4 + wv) * 64 + lane) * 16), ub = *(const u32x4*)(UF + (size_t)((i2 * 4 + wv) * 64 + lane) * 16 + 8);
#pragma unroll
    for (int e = 0; e < 4; ++e) { vn[i2][2 * e] = bflo(ua[e]); vn[i2][2 * e + 1] = bfhi(ua[e]); vn[i2][8 + 2 * e] = bflo(ub[e]); vn[i2][8 + 2 * e + 1] = bfhi(ub[e]); }
#pragma unroll
    for (int r = 0; r < 16; ++r) o[i2][r] = 0.f;
#pragma unroll
    for (int m = 0; m < 4; ++m)
#pragma unroll
      for (int s = 0; s < 2; ++s) {
        vn[i2] = MFMA32(WF[((i2 * 4 + m) * 2 + s) * 64], Sb[m][s], vn[i2]);
        o[i2] = MFMA32(QF[((i2 * 4 + m) * 2 + s) * 64], Sb[m][s], o[i2]);
      }
  }
  bf16x8 Vb[2][2];
#pragma unroll
  for (int j2 = 0; j2 < 2; ++j2) { Vb[j2][0] = packS(vn[j2], 0); Vb[j2][1] = packS(vn[j2], 1); }
#pragma unroll
  for (int i2 = 0; i2 < 2; ++i2)
#pragma unroll
    for (int j2 = 0; j2 <= i2; ++j2)
#pragma unroll
      for (int s = 0; s < 2; ++s) o[i2] = MFMA32(AF[((i2 * 2 + j2) * 2 + s) * 64], Vb[j2][s], o[i2]);
  __syncthreads();
#pragma unroll
  for (int i2 = 0; i2 < 2; ++i2)
#pragma unroll
    for (int r = 0; r < 16; ++r) ol[(32 * i2 + crow(r, hi)) * 136 + 32 * wv + r32] = f2bf(o[i2][r]);
  __syncthreads();
  {
    const size_t t0 = (size_t)b * S_ + c * 64;
    const int row = tid >> 2, q4 = tid & 3;
    const bf16_t* gzp = proj + (t0 + row) * PP + 3072 + h * 128 + 32 * q4;
    bf16_t* op = proj + (t0 + row) * PP + 1536 + h * 128 + 32 * q4;
    float ss = 0.f;
#pragma unroll
    for (int q = 0; q < 4; ++q) { const u32x4 w = *(const u32x4*)(ol + row * 136 + 32 * q4 + 8 * q);
#pragma unroll
      for (int e = 0; e < 4; ++e) { const float a0 = bflo(w[e]), a1 = bfhi(w[e]); ss += a0 * a0 + a1 * a1; } }
    ss += __uint_as_float((unsigned)__builtin_amdgcn_update_dpp(0, (int)__float_as_uint(ss), 0xB1, 0xF, 0xF, true));
    ss += __uint_as_float((unsigned)__builtin_amdgcn_update_dpp(0, (int)__float_as_uint(ss), 0x4E, 0xF, 0xF, true));
    const float rstd = rsqrtf(ss * (1.f / 128.f) + 1e-6f);
#pragma unroll
    for (int q = 0; q < 4; ++q) {
      const u32x4 w = *(const u32x4*)(ol + row * 136 + 32 * q4 + 8 * q), gz = *(const u32x4*)(gzp + 8 * q);
      const f32x4 n0 = *(const f32x4*)(p.gdn_norm_w + 32 * q4 + 8 * q), n1 = *(const f32x4*)(p.gdn_norm_w + 32 * q4 + 8 * q + 4);
      float y[8];
#pragma unroll
      for (int e = 0; e < 4; ++e) { const float z0 = bflo(gz[e]), z1 = bfhi(gz[e]);
        const float g0 = (2 * e < 4) ? n0[(2 * e) & 3] : n1[(2 * e) & 3], g1 = (2 * e + 1 < 4) ? n0[(2 * e + 1) & 3] : n1[(2 * e + 1) & 3];
        y[2 * e] = bflo(w[e]) * rstd * g0 * (z0 * sigmoidf_(z0));
        y[2 * e + 1] = bfhi(w[e]) * rstd * g1 * (z1 * sigmoidf_(z1)); }
      u32x4 wv4 = {pk2(y[0], y[1]), pk2(y[2], y[3]), pk2(y[4], y[5]), pk2(y[6], y[7])};
      *(u32x4*)(op + 8 * q) = wv4;
    }
  }
}
DI void phase_gdnout2(const Params& p, int bid, int nb, char* lds) {
  for (int U = bid; U < 2048; U += nb) gdn_out_unit(p, U, lds);
}
DI void phase_gdnout(const Params& p, int bid, int nb) {
  const int lane = tidx() & 63, gw = bid * 4 + (tidx() >> 6), nw = nb * 4;
  bf16_t* proj = (bf16_t*)(p.ws + WS_P);
  const f32x4 w0 = *(const f32x4*)(p.gdn_norm_w + (lane & 15) * 8), w1 = *(const f32x4*)(p.gdn_norm_w + (lane & 15) * 8 + 4);
  for (int row = gw; row < T_; row += nw) {
    bf16_t* op = proj + (size_t)row * PP + 1536 + lane * 8;
    const u32x4 ov = *(const u32x4*)op, zv = *(const u32x4*)(proj + (size_t)row * PP + 3072 + lane * 8);
    float o[8], z[8];
#pragma unroll
    for (int e = 0; e < 4; ++e) { o[2 * e] = bflo(ov[e]); o[2 * e + 1] = bfhi(ov[e]); z[2 * e] = bflo(zv[e]); z[2 * e + 1] = bfhi(zv[e]); }
    float ss = 0.f;
#pragma unroll
    for (int e = 0; e < 8; ++e) ss += o[e] * o[e];
    ss += __shfl_xor(ss, 1); ss += __shfl_xor(ss, 2); ss += __shfl_xor(ss, 4); ss += __shfl_xor(ss, 8);
    const float rstd = rsqrtf(ss * (1.f / 128.f) + 1e-6f);
    float y[8];
#pragma unroll
    for (int e = 0; e < 8; ++e) { const float w = e < 4 ? w0[e] : w1[e - 4]; y[e] = o[e] * rstd * w * (z[e] * sigmoidf_(z[e])); }
    u32x4 r = {pk2(y[0], y[1]), pk2(y[2], y[3]), pk2(y[4], y[5]), pk2(y[6], y[7])};
    *(u32x4*)op = r;
  }
}

struct EpiMergeA {
  const bf16_t* proj; bf16_t* mp;
  DI void operator()(int row, int col, f32x4 v) const {
    const u32x2 g = *(const u32x2*)(proj + (size_t)row * PP + 3584 + col);
    u32x2 o = {pk2(v[0] * bflo(g[0]), v[1] * bfhi(g[0])), pk2(v[2] * bflo(g[1]), v[3] * bfhi(g[1]))};
    *(u32x2*)(mp + (size_t)row * 1024 + col) = o;
  }
};
struct EpiMergeB {
  const bf16_t* proj; bf16_t* mp;
  DI void operator()(int row, int col, f32x4 v) const {
    const u32x2 g = *(const u32x2*)(proj + (size_t)row * PP + 4608 + col);
    const u32x2 q = *(const u32x2*)(mp + (size_t)row * 1024 + col);
    u32x2 o = {pk2(bflo(q[0]) + v[0] * bflo(g[0]), bfhi(q[0]) + v[1] * bfhi(g[0])), pk2(bflo(q[1]) + v[2] * bflo(g[1]), bfhi(q[1]) + v[3] * bfhi(g[1]))};
    *(u32x2*)(mp + (size_t)row * 1024 + col) = o;
  }
};
struct EpiF32 { float* out; int ld; DI void operator()(int row, int col, f32x4 v) const { *(f32x4*)(out + (size_t)row * ld + col) = v; } };
struct EpiBf16 { bf16_t* out; int ld; DI void operator()(int row, int col, f32x4 v) const { u32x2 o = {pk2(v[0], v[1]), pk2(v[2], v[3])}; *(u32x2*)(out + (size_t)row * ld + col) = o; } };
DI void phase_merge(const Params& p, int bid, int nb, char* lds) {
  const bf16_t* proj = (const bf16_t*)(p.ws + WS_P);
  GemmArgs ga = {proj, PP, (const bf16_t*)(p.ws + WS_WFO), 512, 512};
  GemmArgs gb = {proj + 1536, PP, (const bf16_t*)(p.ws + WS_WGO), 512, 512};
  EpiMergeA ea = {proj, (bf16_t*)(p.ws + WS_H)};
  EpiMergeB eb = {proj, (bf16_t*)(p.ws + WS_H)};
  TileMap tm; tm.init(bid, nb, 8); int m, n; while (tm.next(m, n)) { gemm_tile(ga, m * 128, n * 128, lds, ea); gemm_tile(gb, m * 128, n * 128, lds, eb); }
}
DI void phase_wout(const Params& p, int bid, int nb, char* lds) {
  GemmArgs g = {(const bf16_t*)(p.ws + WS_H), 1024, (const bf16_t*)(p.ws + WS_WOUT), 1024, 1024};
  EpiF32 e = {p.out, 1024};
  TileMap tm; tm.init(bid, nb, 8); int m, n; while (tm.next(m, n)) gemm_tile(g, m * 128, n * 128, lds, e);
}
DI void phase_rows1(const Params& p, int bid, int nb) {
  const int lane = tidx() & 63, gw = bid * 4 + (tidx() >> 6), nw = nb * 4;
  const float* mod = (const float*)(p.ws + WS_MOD);
  bf16_t* h2 = (bf16_t*)(p.ws + WS_H);
  for (int row = gw; row < T_; row += nw) {
    const int b = row >> 13;
    f32x4* mr = (f32x4*)(p.out + (size_t)row * 1024);
    const f32x4* xr = (const f32x4*)(p.x + (size_t)row * 1024);
    f32x4 v[4]; float ss = 0.f;
#pragma unroll
    for (int i = 0; i < 4; ++i) { v[i] = mr[lane + 64 * i]; ss += v[i][0] * v[i][0] + v[i][1] * v[i][1] + v[i][2] * v[i][2] + v[i][3] * v[i][3]; }
    ss = wave_sum(ss);
    const float rstd = rsqrtf(ss * (1.f / 1024.f) + 1e-6f);
    float s2 = 0.f;
#pragma unroll
    for (int i = 0; i < 4; ++i) {
      const int col = 4 * lane + 256 * i;
      const f32x4 g4 = *(const f32x4*)(p.g_post_mix + col), gt = *(const f32x4*)(mod + b * 6144 + 2048 + col);
      v[i] = xr[lane + 64 * i] + gt * (v[i] * rstd * g4);
      mr[lane + 64 * i] = v[i];
      s2 += v[i][0] * v[i][0] + v[i][1] * v[i][1] + v[i][2] * v[i][2] + v[i][3] * v[i][3];
    }
    s2 = wave_sum(s2);
    const float rstd2 = rsqrtf(s2 * (1.f / 1024.f) + 1e-6f);
#pragma unroll
    for (int i = 0; i < 4; ++i) {
      const int col = 4 * lane + 256 * i;
      const f32x4 g4 = *(const f32x4*)(p.g_pre_ffn + col), sh = *(const f32x4*)(mod + b * 6144 + 3072 + col), sc = *(const f32x4*)(mod + b * 6144 + 4096 + col);
      const f32x4 y = (v[i] * rstd2 * g4) * (1.f + sc) + sh;
      u32x2 o = {pk2(y[0], y[1]), pk2(y[2], y[3])};
      *(u32x2*)(h2 + (size_t)row * 1024 + col) = o;
    }
  }
}

DI void phase_peerq(const Params& p, int bid, int nb, char* lds) {
  GemmArgs g = {(const bf16_t*)(p.ws + WS_H), 1024, (const bf16_t*)(p.ws + WS_WQ), 1024, 1024};
  EpiBf16 e = {(bf16_t*)(p.ws + WS_QY), 2048};
  TileMap tm; tm.init(bid, nb, 16); int m, n; while (tm.next(m, n)) gemm_tile(g, m * 128, n * 128, lds, e);
}
DI unsigned ordkey(float f) { const unsigned u = __float_as_uint(f); return (u & 0x80000000u) ? ~u : (u | 0x80000000u); }
#define CE_DESC(x, y) do { const unsigned mx_ = (x) > (y) ? (x) : (y); const unsigned mn_ = (x) > (y) ? (y) : (x); (x) = mx_; (y) = mn_; } while (0)
DI void sort16_desc(unsigned (&a)[16]) {
#pragma unroll
  for (int k = 2; k <= 16; k <<= 1)
#pragma unroll
    for (int j = k >> 1; j > 0; j >>= 1)
#pragma unroll
      for (int i = 0; i < 16; ++i) {
        const int l = i ^ j;
        if (l > i) { if ((i & k) == 0) CE_DESC(a[i], a[l]); else CE_DESC(a[l], a[i]); }
      }
}
DI void merge16_desc(unsigned (&a)[16], const unsigned (&b)[16]) {
#pragma unroll
  for (int i = 0; i < 16; ++i) a[i] = a[i] > b[15 - i] ? a[i] : b[15 - i];
#pragma unroll
  for (int j = 8; j > 0; j >>= 1)
#pragma unroll
    for (int i = 0; i < 16; ++i) if ((i & j) == 0) CE_DESC(a[i], a[i + j]);
}
template <int CTRL> DI void dpp16(unsigned (&b)[16], const unsigned (&a)[16]) {
#pragma unroll
  for (int s = 0; s < 16; ++s) b[s] = (unsigned)__builtin_amdgcn_update_dpp(0, (int)a[s], CTRL, 0xF, 0xF, true);
}
__device__ const unsigned char PEER_CAND[64] = {
  0x00, 0x01, 0x02, 0x03, 0x04, 0x05, 0x06, 0x07, 0x08, 0x09, 0x0A, 0x0B, 0x0C, 0x0D, 0x0E, 0x0F,
  0x10, 0x11, 0x12, 0x13, 0x14, 0x15, 0x16, 0x17, 0x20, 0x21, 0x22, 0x23, 0x24, 0x80, 0x90, 0xA0,
  0x30, 0x31, 0x32, 0x33, 0x40, 0x41, 0x42, 0x50, 0x51, 0x60, 0x61, 0x70, 0x71, 0xB0, 0xC0, 0xD0,
  0xE0, 0xF0, 0xFF, 0xFF, 0xFF, 0xFF, 0xFF, 0xFF, 0xFF, 0xFF, 0xFF, 0xFF, 0xFF, 0xFF, 0xFF, 0xFF};
DI void peer_select_unit(const Params& p, int unit, char* lds) {
  const int tid = tidx(), lane = tid & 63, wid = tid >> 6, fr = lane & 15, fq = lane >> 4;
  const int h = unit & 7, t0 = (unit >> 3) * 32;
  float* sc = (float*)lds;
  float* topv = (float*)(lds + 64 * 132 * 4);
  int* topi = (int*)(lds + 64 * 132 * 4 + 64 * 16 * 4);
  const bf16_t* qy = (const bf16_t*)(p.ws + WS_QY);
  const bf16_t* keys = (const bf16_t*)(p.ws + WS_KEYS);
  __syncthreads();
  {
    const int set = wid >> 1, ts = wid & 1;
    bf16x8 qa[4];
#pragma unroll
    for (int kk = 0; kk < 4; ++kk) qa[kk] = *(const bf16x8*)(qy + (size_t)(t0 + 16 * ts + fr) * 2048 + h * 256 + set * 128 + kk * 32 + fq * 8);
#pragma unroll
    for (int nj = 0; nj < 8; ++nj) {
      f32x4 d = {0.f, 0.f, 0.f, 0.f};
#pragma unroll
      for (int kk = 0; kk < 4; ++kk) { const bf16x8 kb = *(const bf16x8*)(keys + set * 16384 + (16 * nj + fr) * 128 + kk * 32 + fq * 8); d = MFMA16(qa[kk], kb, d); }
#pragma unroll
      for (int r = 0; r < 4; ++r) sc[(set * 32 + 16 * ts + 4 * fq + r) * 132 + 16 * nj + fr] = d[r];
    }
  }
  __syncthreads();
#pragma unroll 1
  for (int pass = 0; pass < 2; ++pass) {
    const int rr = pass * 32 + (tid >> 3), part = tid & 7;
    unsigned a[16], bq[16];
    const float* srow = sc + rr * 132 + 16 * part;
#pragma unroll
    for (int j = 0; j < 4; ++j) {
      const f32x4 v = *(const f32x4*)(srow + 4 * j);
#pragma unroll
      for (int e = 0; e < 4; ++e) a[4 * j + e] = (ordkey(v[e]) & ~127u) | (unsigned)(127 - (16 * part + 4 * j + e));
    }
    sort16_desc(a);
    dpp16<0xB1>(bq, a); merge16_desc(a, bq);
    dpp16<0x4E>(bq, a); merge16_desc(a, bq);
    dpp16<0x141>(bq, a); merge16_desc(a, bq);
#pragma unroll
    for (int s = 0; s < 2; ++s) {
      unsigned k = 0u;
#pragma unroll
      for (int q = 0; q < 8; ++q) k = part == q ? a[2 * q + s] : k;
      const int idx = 127 - (int)(k & 127u);
      topv[rr * 16 + 2 * part + s] = sc[rr * 132 + idx]; topi[rr * 16 + 2 * part + s] = idx;
    }
  }
  __syncthreads();
  if (tid < 128) {
    const int tok = tid >> 2, q4 = tid & 3;
    unsigned c[16], bq[16];
#pragma unroll
    for (int i = 0; i < 16; ++i) {
      const unsigned code = PEER_CAND[16 * q4 + i];
      const float v = topv[tok * 16 + ((code >> 4) & 15)] + topv[(32 + tok) * 16 + (code & 15)];
      c[i] = code == 0xFFu ? 0u : ((ordkey(v) & ~255u) | (255u - code));
    }
    sort16_desc(c);
    dpp16<0xB1>(bq, c); merge16_desc(c, bq);
    dpp16<0x4E>(bq, c); merge16_desc(c, bq);
    float mx; { const int pos = 255 - (int)(c[0] & 255u); mx = topv[tok * 16 + (pos >> 4)] + topv[(32 + tok) * 16 + (pos & 15)]; }
    float val[4]; int ei[4]; float part = 0.f;
#pragma unroll
    for (int s = 0; s < 4; ++s) {
      unsigned k = 0u;
#pragma unroll
      for (int q = 0; q < 4; ++q) k = q4 == q ? c[4 * q + s] : k;
      const int pos = 255 - (int)(k & 255u); const int a = pos >> 4, b = pos & 15;
      const float v = topv[tok * 16 + a] + topv[(32 + tok) * 16 + b]; ei[s] = topi[tok * 16 + a] * 128 + topi[(32 + tok) * 16 + b];
      val[s] = __expf(v - mx); part += val[s];
    }
    part += __uint_as_float((unsigned)__builtin_amdgcn_update_dpp(0, (int)__float_as_uint(part), 0xB1, 0xF, 0xF, true));
    part += __uint_as_float((unsigned)__builtin_amdgcn_update_dpp(0, (int)__float_as_uint(part), 0x4E, 0xF, 0xF, true));
    const float rt = 1.f / part;
    int* eo = (int*)(p.ws + WS_EIDX) + ((size_t)(t0 + tok) * 8 + h) * 16 + 4 * q4; float* go = (float*)(p.ws + WS_GATE) + ((size_t)(t0 + tok) * 8 + h) * 16 + 4 * q4;
    *(f32x4*)go = (f32x4){val[0] * rt, val[1] * rt, val[2] * rt, val[3] * rt};
    typedef int i32x4 __attribute__((ext_vector_type(4)));
    *(i32x4*)eo = (i32x4){ei[0], ei[1], ei[2], ei[3]};
  }
}
DI void phase_peersel(const Params& p, int bid, int nb, char* lds) {
  for (int u = bid; u < 8192; u += nb) peer_select_unit(p, u, lds);
}
DI float dpp_sum8(float d) {
  d += __uint_as_float((unsigned)__builtin_amdgcn_update_dpp(0, (int)__float_as_uint(d), 0xB1, 0xF, 0xF, true));
  d += __uint_as_float((unsigned)__builtin_amdgcn_update_dpp(0, (int)__float_as_uint(d), 0x4E, 0xF, 0xF, true));
  d += __uint_as_float((unsigned)__builtin_amdgcn_update_dpp(0, (int)__float_as_uint(d), 0x141, 0xF, 0xF, true));
  return d;
}
DI void unpack16_fp8(const u32x4 w, float (&f)[16]) {
#pragma unroll
  for (int i = 0; i < 4; ++i) { const f32x2 lo = __builtin_amdgcn_cvt_pk_f32_fp8((int)w[i], false), hi = __builtin_amdgcn_cvt_pk_f32_fp8((int)w[i], true); f[4 * i] = lo[0]; f[4 * i + 1] = lo[1]; f[4 * i + 2] = hi[0]; f[4 * i + 3] = hi[1]; }
}
DI void phase_peerdown(const Params& p, int bid, int nb) {
  const int lane = tidx() & 63, wid = tidx() >> 6, e8 = lane >> 3, c = lane & 7;
  const int x = bid & 7, gw = (bid >> 3) * 4 + wid, nw = (nb >> 3) * 4;
  const bf16_t* h2 = (const bf16_t*)(p.ws + WS_H);
  const char* tab = p.ws + WS_PU + (size_t)x * 16384 * 128 + 16 * c;
  const int* eidx = (const int*)(p.ws + WS_EIDX);
  float* pd = (float*)(p.ws + WS_PD) + (size_t)x * T_ * 128;
  for (int t = gw; t < T_; t += nw) {
    float hx[16];
    { const u32x4 a = *(const u32x4*)(h2 + (size_t)t * 1024 + 128 * x + 16 * c), b = *(const u32x4*)(h2 + (size_t)t * 1024 + 128 * x + 16 * c + 8);
#pragma unroll
      for (int e = 0; e < 4; ++e) { hx[2 * e] = bflo(a[e]); hx[2 * e + 1] = bfhi(a[e]); hx[8 + 2 * e] = bflo(b[e]); hx[8 + 2 * e + 1] = bfhi(b[e]); } }
    typedef int i32x4 __attribute__((ext_vector_type(4)));
    int ee[16];
#pragma unroll
    for (int q = 0; q < 4; ++q) { const i32x4 v = *(const i32x4*)(eidx + (size_t)t * 128 + 16 * e8 + 4 * q); ee[4 * q] = v[0]; ee[4 * q + 1] = v[1]; ee[4 * q + 2] = v[2]; ee[4 * q + 3] = v[3]; }
    float k0 = 0.f, k1 = 0.f;
    u32x4 w[16];
#pragma unroll
    for (int q = 0; q < 16; ++q) w[q] = *(const u32x4*)(tab + (size_t)ee[q] * 128);
#pragma unroll
    for (int g0 = 0; g0 < 16; g0 += 8) {
#pragma unroll
      for (int q = 0; q < 8; ++q) {
        float f[16]; unpack16_fp8(w[g0 + q], f);
        float d = 0.f;
#pragma unroll
        for (int i = 0; i < 16; ++i) d += f[i] * hx[i];
        d = dpp_sum8(d);
        if (c == q) { if (g0 == 0) k0 = d; else k1 = d; }
      }
    }
    pd[(size_t)t * 128 + 16 * e8 + c] = k0; pd[(size_t)t * 128 + 16 * e8 + 8 + c] = k1;
  }
}
DI void phase_peercoef(const Params& p, int bid, int nb) {
  const float* pd = (const float*)(p.ws + WS_PD);
  const int* eidx = (const int*)(p.ws + WS_EIDX); const float* gate = (const float*)(p.ws + WS_GATE);
  const float* uinv = (const float*)(p.ws + WS_UINV); const float* vinv = (const float*)(p.ws + WS_VINV);
  float* coef = (float*)(p.ws + WS_COEF);
  for (size_t i = (size_t)bid * NT + tidx(); i < (size_t)T_ * 128; i += (size_t)nb * NT) {
    float d = 0.f;
#pragma unroll
    for (int x = 0; x < 8; ++x) d += pd[(size_t)x * T_ * 128 + i];
    const int e = eidx[i];
    d *= uinv[e];
    coef[i] = gate[i] * 0.5f * d * (1.f + erff(d * 0.70710678118654752f)) * vinv[e];
  }
}
DI void phase_peerup(const Params& p, int bid, int nb) {
  const int lane = tidx() & 63, wid = tidx() >> 6, e8 = lane >> 3, c = lane & 7;
  const int x = bid & 7, gw = (bid >> 3) * 4 + wid, nw = (nb >> 3) * 4;
  const char* tab = p.ws + WS_PV + (size_t)x * 16384 * 128 + 16 * c;
  const int* eidx = (const int*)(p.ws + WS_EIDX); const float* coef = (const float*)(p.ws + WS_COEF);
  float* y2 = (float*)(p.ws + WS_Y2); float* ssq = (float*)(p.ws + WS_SSQ) + (size_t)x * T_;
  for (int t = gw; t < T_; t += nw) {
    typedef int i32x4 __attribute__((ext_vector_type(4)));
    int ee[16]; float cf[16];
#pragma unroll
    for (int q = 0; q < 4; ++q) { const i32x4 v = *(const i32x4*)(eidx + (size_t)t * 128 + 16 * e8 + 4 * q); const f32x4 g = *(const f32x4*)(coef + (size_t)t * 128 + 16 * e8 + 4 * q);
#pragma unroll
      for (int e = 0; e < 4; ++e) { ee[4 * q + e] = v[e]; cf[4 * q + e] = g[e]; } }
    float y[16];
#pragma unroll
    for (int i = 0; i < 16; ++i) y[i] = 0.f;
    u32x4 w[16];
#pragma unroll
    for (int q = 0; q < 16; ++q) w[q] = *(const u32x4*)(tab + (size_t)ee[q] * 128);
#pragma unroll
    for (int g0 = 0; g0 < 16; g0 += 8) {
#pragma unroll
      for (int q = 0; q < 8; ++q) {
        float f[16]; unpack16_fp8(w[g0 + q], f);
#pragma unroll
        for (int i = 0; i < 16; ++i) y[i] += cf[g0 + q] * f[i];
      }
    }
    float ss = 0.f;
#pragma unroll
    for (int i = 0; i < 16; ++i) { y[i] += __shfl_xor(y[i], 8); y[i] += __shfl_xor(y[i], 16); y[i] += __shfl_xor(y[i], 32); ss += y[i] * y[i]; }
    ss = dpp_sum8(ss);
    if (e8 == 0) {
      float* yo = y2 + (size_t)t * 1024 + 128 * x + 16 * c;
#pragma unroll
      for (int q = 0; q < 4; ++q) *(f32x4*)(yo + 4 * q) = (f32x4){y[4 * q], y[4 * q + 1], y[4 * q + 2], y[4 * q + 3]};
      if (c == 0) ssq[t] = ss;
    }
  }
}
DI void phase_final(const Params& p, int bid, int nb) {
  const int lane = tidx() & 63, gw = bid * 4 + (tidx() >> 6), nw = nb * 4;
  const float* mod = (const float*)(p.ws + WS_MOD);
  const float* y2 = (const float*)(p.ws + WS_Y2); const float* ssq = (const float*)(p.ws + WS_SSQ);
  for (int row = gw; row < T_; row += nw) {
    const int b = row >> 13;
    float ss = 0.f;
#pragma unroll
    for (int x = 0; x < 8; ++x) ss += ssq[(size_t)x * T_ + row];
    const float rstd = rsqrtf(ss * (1.f / 1024.f) + 1e-6f);
    f32x4* orow = (f32x4*)(p.out + (size_t)row * 1024); const f32x4* yr = (const f32x4*)(y2 + (size_t)row * 1024);
#pragma unroll
    for (int i = 0; i < 4; ++i) {
      const int col = 4 * lane + 256 * i;
      const f32x4 g4 = *(const f32x4*)(p.g_post_ffn + col), gt = *(const f32x4*)(mod + b * 6144 + 5120 + col);
      orow[lane + 64 * i] = orow[lane + 64 * i] + gt * (yr[lane + 64 * i] * rstd * g4);
    }
  }
}

namespace cg = cooperative_groups;
constexpr int LDS_BYTES = 75776;
DI void phase_mixer(const Params& p, int bid, int nb, char* lds) {
  if (bid < 16) gdn_scan_seq(p, bid, lds);
  unsigned* ctr = (unsigned*)(p.ws + WS_CTL);
  int* slot = (int*)(lds + LDS_BYTES - 16);
  for (;;) {
    __syncthreads();
    if (tidx() == 0) *slot = (int)atomicAdd(ctr, 1u);
    __syncthreads();
    const int u = *slot;
    if (u >= 2048) break;
    attn_unit(p, u & 31, 63 - (u >> 5), lds);
  }
}
#ifndef PROBE_PHASE
#define PROBE_PHASE -1
#endif
__global__ void __launch_bounds__(NT, 2) fwd(Params p) {
  extern __shared__ __attribute__((aligned(16))) char lds[];
  cg::grid_group grid = cg::this_grid();
  const int bid = blockIdx.x, nb = gridDim.x;
  unsigned long long tprev = 0, tprobe = 0; int nph = 0;
#define SEAM() do { asm volatile("s_waitcnt vmcnt(0)" ::: "memory");   grid.sync(); if (PROBE_PHASE >= 0) { const unsigned long long tn = __builtin_amdgcn_s_memrealtime(); if (nph == PROBE_PHASE) tprobe = tn - tprev; tprev = tn; ++nph; } } while (0)
  if (bid == 0 && tidx() < 192) ((unsigned*)(p.ws + WS_CTL))[tidx()] = 0u;
  if (PROBE_PHASE >= 0) tprev = __builtin_amdgcn_s_memrealtime();
  phase_mod(p, bid, nb, lds); phase_wconv(p, bid, nb, lds);
  SEAM();
  phase_xnorm(p, bid, nb);
  SEAM();
  phase_inproj(p, bid, nb, lds);
  SEAM();
  if (bid < 32) phase_foxcum(p, bid, 32, lds);
  phase_qknorm(p, bid, nb);
  phase_gdnprep(p, bid, nb, lds);
  SEAM();
  phase_mixer(p, bid, nb, lds);
  SEAM();
  phase_gdnout2(p, bid, nb, lds);
  SEAM();
  phase_merge(p, bid, nb, lds);
  SEAM();
  phase_wout(p, bid, nb, lds); phase_tabconv(p, bid, nb);
  SEAM();
  phase_rows1(p, bid, nb);
  SEAM();
  phase_peerq(p, bid, nb, lds);
  SEAM();
  phase_peersel(p, bid, nb, lds);
  SEAM();
  phase_peerdown(p, bid, nb);
  SEAM();
  phase_peercoef(p, bid, nb);
  SEAM();
  phase_peerup(p, bid, nb);
  SEAM();
  phase_final(p, bid, nb);
  if (PROBE_PHASE >= 0) {
    if (PROBE_PHASE == nph) { asm volatile("s_waitcnt vmcnt(0)" ::: "memory"); grid.sync(); tprobe = __builtin_amdgcn_s_memrealtime() - tprev; }
    if (bid == 0 && tidx() == 0) { const unsigned long long t0 = __builtin_amdgcn_s_memrealtime(); while (__builtin_amdgcn_s_memrealtime() - t0 < tprobe) __builtin_amdgcn_s_sleep(8); }
  }
}

extern "C" void kernel_launch(void* const* d_in, const int* in_sizes, int n_in, void* d_out, int out_size, void* d_ws, size_t ws_size, hipStream_t stream) {
  static int grid_blocks = 0;
  if (!grid_blocks) {
    int dev = 0, cus = 0, per_cu = 0;
    hipGetDevice(&dev);
    hipDeviceGetAttribute(&cus, hipDeviceAttributeMultiprocessorCount, dev);
    (void)hipFuncSetAttribute((const void*)fwd, hipFuncAttributeMaxDynamicSharedMemorySize, LDS_BYTES);
    hipOccupancyMaxActiveBlocksPerMultiprocessor(&per_cu, (const void*)fwd, NT, LDS_BYTES);
    if (per_cu < 1) per_cu = 1;
    if (per_cu > 2) per_cu = 2;
    grid_blocks = cus * per_cu;
  }
  Params p{};
  const float** f = (const float**)&p;
  for (int i = 0; i < 23; ++i) f[i] = (const float*)d_in[i];
  p.out = (float*)d_out; p.ws = (char*)d_ws;
  void* args[] = {&p};
  hipError_t e = hipLaunchCooperativeKernel((const void*)fwd, dim3(grid_blocks), dim3(NT), args, LDS_BYTES, stream);
  if (e != hipSuccess) fprintf(stderr, "cooperative launch failed: %s (grid %d)\n", hipGetErrorString(e), grid_blocks);
}
```

```cpp
#include <hip/hip_runtime.h>
#include <hip/hip_cooperative_groups.h>
#include <stdint.h>
#include <math.h>
#include <cstdio>

#define DI __device__ __forceinline__
#define LAS __attribute__((address_space(3)))
typedef unsigned short bf16_t;
typedef short bf16x8 __attribute__((ext_vector_type(8)));
typedef short s16x4 __attribute__((ext_vector_type(4)));
typedef float f32x4 __attribute__((ext_vector_type(4)));
typedef float f32x16 __attribute__((ext_vector_type(16)));
typedef float f32x2 __attribute__((ext_vector_type(2)));
typedef unsigned u32x4 __attribute__((ext_vector_type(4)));
typedef unsigned u32x2 __attribute__((ext_vector_type(2)));
typedef __bf16 bf16x2_t __attribute__((ext_vector_type(2)));

constexpr int NT = 256;
constexpr int T_ = 32768, S_ = 8192;
constexpr int PP = 5632;
constexpr int NPAD = 5760;
constexpr float LOG2E = 1.4426950408889634f;
constexpr size_t MiB = 1u << 20;

constexpr size_t WS_CTL = 0;
constexpr size_t WS_MOD = 1 * MiB;
constexpr size_t WS_WIN = 2 * MiB;
constexpr size_t WS_WFO = 14 * MiB;
constexpr size_t WS_WGO = 15 * MiB;
constexpr size_t WS_WOUT = 16 * MiB;
constexpr size_t WS_WQ = 18 * MiB;
constexpr size_t WS_KEYS = 22 * MiB;
constexpr size_t WS_SMALL = 23 * MiB;
constexpr size_t WS_FNEG = 25 * MiB;
constexpr size_t WS_KNPM = 26 * MiB + 65536;
constexpr size_t WS_GL = 26 * MiB;
constexpr size_t WS_SC = 32 * MiB;
constexpr size_t WS_H = 32 * MiB;
constexpr size_t WS_P = 96 * MiB;
constexpr size_t WS_UF = 448 * MiB;
constexpr size_t WS_WF = 480 * MiB;
constexpr size_t WS_QY = 96 * MiB;
constexpr size_t WS_PU = 224 * MiB;
constexpr size_t WS_PV = 240 * MiB;
constexpr size_t WS_UINV = 256 * MiB;
constexpr size_t WS_VINV = 256 * MiB + 65536;
constexpr size_t WS_EIDX = 288 * MiB;
constexpr size_t WS_GATE = 304 * MiB;
constexpr size_t WS_PD = 320 * MiB;
constexpr size_t WS_Y2 = 96 * MiB;
constexpr size_t WS_COEF = 32 * MiB;
constexpr size_t WS_SSQ = 48 * MiB;

DI int tidx() { int t = threadIdx.x; asm volatile("" : "+v"(t)); return t; }
DI unsigned pk2(float lo, float hi) { f32x2 v = {lo, hi}; bf16x2_t b = __builtin_convertvector(v, bf16x2_t); return __builtin_bit_cast(unsigned, b); }
DI bf16_t f2bf(float x) { return (bf16_t)(pk2(x, 0.f) & 0xffffu); }
DI float bf2f(bf16_t v) { return __uint_as_float(((unsigned)v) << 16); }
DI float bflo(unsigned u) { return __uint_as_float(u << 16); }
DI float bfhi(unsigned u) { return __uint_as_float(u & 0xffff0000u); }
DI float wave_sum(float v) {
#pragma unroll
  for (int d = 32; d >= 1; d >>= 1) v += __shfl_xor(v, d);
  return v;
}
DI unsigned wave_max_u(unsigned v) {
#pragma unroll
  for (int d = 32; d >= 1; d >>= 1) { unsigned o = (unsigned)__shfl_xor((int)v, d); v = o > v ? o : v; }
  return v;
}
DI float sigmoidf_(float x) { return 1.f / (1.f + __expf(-x)); }
DI float softplusf_(float x) { return fmaxf(x, 0.f) + log1pf(__expf(-fabsf(x))); }
DI int crow(int r, int hi) { return (r & 3) + 8 * (r >> 2) + 4 * hi; }
#define MFMA16(a, b, c) __builtin_amdgcn_mfma_f32_16x16x32_bf16((a), (b), (c), 0, 0, 0)
#define MFMA32(a, b, c) __builtin_amdgcn_mfma_f32_32x32x16_bf16((a), (b), (c), 0, 0, 0)
DI s16x4 tr16(const LAS char* p) { typedef short v4i16_t __attribute__((ext_vector_type(4))); return __builtin_bit_cast(s16x4, __builtin_amdgcn_ds_read_tr16_b64_v4i16((LAS v4i16_t*)p)); }
DI bf16x8 cat8(s16x4 lo, s16x4 hi) { return __builtin_shufflevector(lo, hi, 0, 1, 2, 3, 4, 5, 6, 7); }
DI bf16x8 pack8(float a0, float a1, float a2, float a3, float a4, float a5, float a6, float a7) {
  u32x4 p = {pk2(a0, a1), pk2(a2, a3), pk2(a4, a5), pk2(a6, a7)}; return __builtin_bit_cast(bf16x8, p);
}

struct Params {
  const float *x, *c, *w_ada, *b_ada, *g_pre_mix, *g_post_mix, *w_in, *b_fgate, *fox_w_o, *conv_w, *a_log, *dt_bias, *gdn_norm_w, *gdn_w_o,
      *b_branch_gate, *w_out, *g_pre_ffn, *g_post_ffn, *peer_w_query, *peer_keys1, *peer_keys2, *peer_u, *peer_v;
  float* out; char* ws;
};

DI void phase_mod(const Params& p, int bid, int nb, char* lds) {
  float* sc = (float*)lds;
  float* part = sc + 4096;
  const int tid = tidx();
  for (int i = tid; i < 4096; i += NT) { float v = p.c[i]; sc[i] = v / (1.f + __expf(-v)); }
  __syncthreads();
  float* mod = (float*)(p.ws + WS_MOD);
  for (int g = bid; g < 96; g += nb) {
    const int cc = tid & 63, kg = tid >> 6, col = g * 64 + cc;
    float a0 = 0.f, a1 = 0.f, a2 = 0.f, a3 = 0.f;
#pragma unroll 8
    for (int k = kg; k < 1024; k += 4) { const float w = p.w_ada[(size_t)k * 6144 + col]; a0 += sc[k] * w; a1 += sc[1024 + k] * w; a2 += sc[2048 + k] * w; a3 += sc[3072 + k] * w; }
    part[(kg * 4 + 0) * 64 + cc] = a0; part[(kg * 4 + 1) * 64 + cc] = a1; part[(kg * 4 + 2) * 64 + cc] = a2; part[(kg * 4 + 3) * 64 + cc] = a3;
    __syncthreads();
    { const int b = tid >> 6; float s = part[(0 * 4 + b) * 64 + cc] + part[(1 * 4 + b) * 64 + cc] + part[(2 * 4 + b) * 64 + cc] + part[(3 * 4 + b) * 64 + cc];
      mod[b * 6144 + col] = s + p.b_ada[col]; }
    __syncthreads();
  }
}

DI int inproj_colmap(int n) {
  if (n < 1536) return n;
  if (n < 3584) return 1544 + (n - 1536);
  if (n < 5632) return 3600 + (n - 3584);
  if (n < 5640) return 1536 + (n - 5632);
  if (n < 5648) return 3592 + (n - 5640);
  return -1;
}
DI void transpose_tile(const float* src, int ldsrc, bf16_t* dst, int K, int n0, int k0, bool permute, float* tile) {
  const int tid = tidx(), tx = tid & 63, ty = tid >> 6;
  const int n = n0 + tx; const int oc = permute ? inproj_colmap(n) : n;
#pragma unroll 4
  for (int i = 0; i < 16; ++i) { const int ky = ty + 4 * i; tile[ky * 65 + tx] = (oc >= 0) ? src[(size_t)(k0 + ky) * ldsrc + oc] : 0.f; }
  __syncthreads();
#pragma unroll 4
  for (int i = 0; i < 16; ++i) { const int ny = ty + 4 * i; dst[(size_t)(n0 + ny) * K + k0 + tx] = f2bf(tile[tx * 65 + ny]); }
  __syncthreads();
}
DI void phase_wconv(const Params& p, int bid, int nb, char* lds) {
  float* tile = (float*)lds;
  for (int t = bid; t < 2464; t += nb) {
    if (t < 1440) transpose_tile(p.w_in, 5648, (bf16_t*)(p.ws + WS_WIN), 1024, (t / 16) * 64, (t % 16) * 64, true, tile);
    else if (t < 1568) { const int u = t - 1440; transpose_tile(p.fox_w_o, 1024, (bf16_t*)(p.ws + WS_WFO), 512, (u / 8) * 64, (u % 8) * 64, false, tile); }
    else if (t < 1696) { const int u = t - 1568; transpose_tile(p.gdn_w_o, 1024, (bf16_t*)(p.ws + WS_WGO), 512, (u / 8) * 64, (u % 8) * 64, false, tile); }
    else if (t < 1952) { const int u = t - 1696; transpose_tile(p.w_out, 1024, (bf16_t*)(p.ws + WS_WOUT), 1024, (u / 16) * 64, (u % 16) * 64, false, tile); }
    else { const int u = t - 1952; transpose_tile(p.peer_w_query, 2048, (bf16_t*)(p.ws + WS_WQ), 1024, (u / 16) * 64, (u % 16) * 64, false, tile); }
  }
  bf16_t* kd = (bf16_t*)(p.ws + WS_KEYS);
  for (int i = bid * NT + tidx(); i < 32768; i += nb * NT) kd[i] = f2bf(i < 16384 ? p.peer_keys1[i] : p.peer_keys2[i - 16384]);
}
DI unsigned pk4_fp8(float a, float b, float c, float d) { int w = 0; w = __builtin_amdgcn_cvt_pk_fp8_f32(a, b, w, false); w = __builtin_amdgcn_cvt_pk_fp8_f32(c, d, w, true); return (unsigned)w; }
DI void phase_tabconv(const Params& p, int bid, int nb) {
  const int lane = tidx() & 63, gw = bid * 4 + (tidx() >> 6), nw = nb * 4;
  for (int r0 = gw * 4; r0 < 32768; r0 += nw * 4) {
    f32x4 v[4][4];
#pragma unroll
    for (int k = 0; k < 4; ++k) { const int r = r0 + k; const float* src = ((r >= 16384) ? p.peer_v : p.peer_u) + (size_t)(r & 16383) * 1024 + 16 * lane;
#pragma unroll
      for (int i = 0; i < 4; ++i) v[k][i] = *(const f32x4*)(src + 4 * i); }
#pragma unroll
    for (int k = 0; k < 4; ++k) {
      const int r = r0 + k; const bool second = r >= 16384; const int e = r & 16383;
      float am = 0.f;
#pragma unroll
      for (int i = 0; i < 4; ++i) am = fmaxf(am, fmaxf(fmaxf(fabsf(v[k][i][0]), fabsf(v[k][i][1])), fmaxf(fabsf(v[k][i][2]), fabsf(v[k][i][3]))));
#pragma unroll
      for (int d = 32; d >= 1; d >>= 1) am = fmaxf(am, __shfl_xor(am, d));
      float sc = 1.f, inv = 1.f;
      if (am > 1e-30f) { const int ex = (int)floorf(log2f(448.f / am)); sc = exp2f((float)ex); inv = exp2f((float)-ex); }
      u32x4 o;
#pragma unroll
      for (int i = 0; i < 4; ++i) o[i] = pk4_fp8(v[k][i][0] * sc, v[k][i][1] * sc, v[k][i][2] * sc, v[k][i][3] * sc);
      *(u32x4*)(p.ws + (second ? WS_PV : WS_PU) + ((size_t)(lane >> 3) * 16384 + e) * 128 + 16 * (lane & 7)) = o;
      if (lane == 0) ((float*)(p.ws + (second ? WS_VINV : WS_UINV)))[e] = inv;
    }
  }
}

DI void phase_xnorm(const Params& p, int bid, int nb) {
  const int lane = tidx() & 63, gw = bid * 4 + (tidx() >> 6), nw = nb * 4;
  const float* mod = (const float*)(p.ws + WS_MOD);
  bf16_t* h = (bf16_t*)(p.ws + WS_H);
  for (int row0 = gw * 4; row0 < T_; row0 += nw * 4) {
    const int b = row0 >> 13;
    f32x4 v[4][4];
#pragma unroll
    for (int r = 0; r < 4; ++r)
#pragma unroll
      for (int i = 0; i < 4; ++i) v[r][i] = ((const f32x4*)(p.x + (size_t)(row0 + r) * 1024))[lane + 64 * i];
    f32x4 g4[4], sh[4], sc[4];
#pragma unroll
    for (int i = 0; i < 4; ++i) { const int col = 4 * lane + 256 * i; g4[i] = *(const f32x4*)(p.g_pre_mix + col); sh[i] = *(const f32x4*)(mod + b * 6144 + col); sc[i] = *(const f32x4*)(mod + b * 6144 + 1024 + col); }
#pragma unroll
    for (int r = 0; r < 4; ++r) {
      float ss = 0.f;
#pragma unroll
      for (int i = 0; i < 4; ++i) ss += v[r][i][0] * v[r][i][0] + v[r][i][1] * v[r][i][1] + v[r][i][2] * v[r][i][2] + v[r][i][3] * v[r][i][3];
      ss = wave_sum(ss);
      const float rstd = rsqrtf(ss * (1.f / 1024.f) + 1e-6f);
#pragma unroll
      for (int i = 0; i < 4; ++i) {
        const f32x4 y = (v[r][i] * rstd * g4[i]) * (1.f + sc[i]) + sh[i];
        u32x2 o = {pk2(y[0], y[1]), pk2(y[2], y[3])};
        *(u32x2*)(h + (size_t)(row0 + r) * 1024 + 4 * lane + 256 * i) = o;
      }
    }
  }
}

struct GemmArgs { const bf16_t* A; int lda; const bf16_t* Bt; int ldb; int K; };
DI int swz(int row, int c) { return row * 128 + ((c ^ ((row >> 1) & 7)) << 4); }
DI int gsw(int r) { return (0x78 >> (2 * ((r >> 2) & 3))) & 3; }
DI int gswz(int row, int c) { return row * 64 + ((c ^ gsw(row)) << 4); }
template <class Epi>
DI void gemm_tile(const GemmArgs& g, int m0, int n0, char* lds, const Epi& epi) {
  const int tid = tidx(), lane = tid & 63, wid = tid >> 6, wr = wid >> 1, wc = wid & 1, fr = lane & 15, fq = lane >> 4;
  f32x4 acc[8][4];
#pragma unroll
  for (int i = 0; i < 8; ++i)
#pragma unroll
    for (int j = 0; j < 4; ++j) acc[i][j] = (f32x4){0.f, 0.f, 0.f, 0.f};
  const int prow = lane >> 2, pch = (lane & 3) ^ gsw(lane >> 2);
  const bf16_t* ag = g.A + (size_t)(m0 + 64 * wid + prow) * g.lda + 8 * pch;
  const bf16_t* bgp[2];
#pragma unroll
  for (int i = 0; i < 2; ++i) { const int rho = 16 * i + prow; bgp[i] = g.Bt + (size_t)(n0 + 32 * wid + 8 * ((rho & 15) >> 2) + 4 * (rho >> 4) + (rho & 3)) * g.ldb + 8 * pch; }
  const size_t a16 = (size_t)16 * g.lda;
#define GT_ISSUE(kt, st) do { _Pragma("unroll") for (int i = 0; i < 4; ++i) \
      __builtin_amdgcn_global_load_lds((const unsigned*)(ag + i * a16 + (kt) * 32), (LAS unsigned*)(lds + (st) * 24576 + (4 * wid + i) * 1024), 16, 0, 0); \
    _Pragma("unroll") for (int i = 0; i < 2; ++i) \
      __builtin_amdgcn_global_load_lds((const unsigned*)(bgp[i] + (kt) * 32), (LAS unsigned*)(lds + (st) * 24576 + 16384 + (2 * wid + i) * 1024), 16, 0, 0); } while (0)
  const int nk = g.K / 32;
  __syncthreads();
  GT_ISSUE(0, 0); GT_ISSUE(1, 1);
  int st = 0;
#pragma unroll 1
  for (int kt = 0; kt < nk; ++kt) {
    if (kt + 1 < nk) asm volatile("s_waitcnt vmcnt(6)" ::: "memory"); else asm volatile("s_waitcnt vmcnt(0)" ::: "memory");
    __builtin_amdgcn_s_barrier();
    asm volatile("" ::: "memory");
    if (kt + 2 < nk) { const int s2 = st >= 1 ? st - 1 : 2; GT_ISSUE(kt + 2, s2); }
    const char* As = lds + st * 24576; const char* Bs = As + 16384;
    bf16x8 af[8], bfm[4];
#pragma unroll
    for (int i = 0; i < 8; ++i) af[i] = *(const bf16x8*)(As + gswz(wr * 128 + i * 16 + fr, fq));
#pragma unroll
    for (int j = 0; j < 4; ++j) bfm[j] = *(const bf16x8*)(Bs + gswz(wc * 64 + j * 16 + fr, fq));
#pragma unroll
    for (int i = 0; i < 8; ++i)
#pragma unroll
      for (int j = 0; j < 4; ++j) acc[i][j] = MFMA16(bfm[j], af[i], acc[i][j]);
    asm volatile("s_waitcnt lgkmcnt(0)" ::: "memory");
    st = st == 2 ? 0 : st + 1;
  }
#undef GT_ISSUE
#pragma unroll
  for (int i = 0; i < 8; ++i)
#pragma unroll
    for (int jj = 0; jj < 2; ++jj) epi(m0 + wr * 128 + i * 16 + fr, n0 + wc * 64 + jj * 32 + 8 * fq, acc[i][2 * jj], acc[i][2 * jj + 1]);
}

struct TileMap {
  int x, r, R, Nt, ngroups, L;
  DI void init(int bid, int nb, int Nt_) { x = bid & 7; r = bid >> 3; R = nb >> 3; Nt = Nt_; ngroups = (Nt_ + 7) >> 3; L = r; }
  DI bool next(int& m, int& n) {
    for (;;) {
      if (L >= 128 * ngroups) return false;
      const int ng = L >> 7, rem = L & 127, mg = rem >> 6, ni = (rem & 63) >> 3, mi = rem & 7;
      L += R;
      m = 16 * x + 8 * mg + mi; n = 8 * ng + ni;
      if (n < Nt) return true;
    }
  }
};
struct EpiInproj {
  bf16_t* proj; float* small; const float *bbg, *b_fgate, *a_log, *dt_bias;
  DI void operator()(int row, int col, f32x4 v, f32x4 w) const {
    if (col < 3584) { u32x4 o = {pk2(v[0], v[1]), pk2(v[2], v[3]), pk2(w[0], w[1]), pk2(w[2], w[3])}; *(u32x4*)(proj + (size_t)row * PP + col) = o; }
    else if (col < 5632) {
      const f32x4 b = *(const f32x4*)(bbg + (col - 3584)), c = *(const f32x4*)(bbg + (col - 3584) + 4);
      u32x4 o = {pk2(sigmoidf_(v[0] + b[0]), sigmoidf_(v[1] + b[1])), pk2(sigmoidf_(v[2] + b[2]), sigmoidf_(v[3] + b[3])),
                 pk2(sigmoidf_(w[0] + c[0]), sigmoidf_(w[1] + c[1])), pk2(sigmoidf_(w[2] + c[2]), sigmoidf_(w[3] + c[3]))};
      *(u32x4*)(proj + (size_t)row * PP + col) = o;
    } else if (col < 5648) {
      const int j0 = col - 5632;
#pragma unroll
      for (int e = 0; e < 8; ++e) { const int j = j0 + e; const float x = e < 4 ? v[e & 3] : w[e & 3]; float r;
        if (j < 8) r = -softplusf_(-(x + b_fgate[j]));
        else if (j < 12) r = sigmoidf_(x);
        else r = -__expf(a_log[j - 12]) * softplusf_(x + dt_bias[j - 12]);
        small[(size_t)row * 16 + j] = r; }
    }
  }
};
DI void phase_inproj(const Params& p, int bid, int nb, char* lds) {
  GemmArgs g = {(const bf16_t*)(p.ws + WS_H), 1024, (const bf16_t*)(p.ws + WS_WIN), 1024, 1024};
  EpiInproj e = {(bf16_t*)(p.ws + WS_P), (float*)(p.ws + WS_SMALL), p.b_branch_gate, p.b_fgate, p.a_log, p.dt_bias};
  TileMap tm; tm.init(bid, nb, 45); int m, n; while (tm.next(m, n)) gemm_tile(g, m * 256, n * 128, lds, e);
}

DI void phase_foxcum(const Params& p, int bid, int nb, char* lds) {
  float* tot = (float*)lds;
  const float* small = (const float*)(p.ws + WS_SMALL);
  float* fneg = (float*)(p.ws + WS_FNEG);
  const int tid = tidx();
  for (int bh = bid; bh < 32; bh += nb) {
    const int b = bh >> 3, h = bh & 7;
    float v[32]; float run = 0.f;
#pragma unroll
    for (int i = 0; i < 32; ++i) { run += small[((size_t)b * S_ + tid * 32 + i) * 16 + h]; v[i] = run; }
    tot[tid] = run; __syncthreads();
    float off = 0.f; for (int j = 0; j < tid; ++j) off += tot[j];
#pragma unroll
    for (int i = 0; i < 32; ++i) fneg[(size_t)bh * S_ + tid * 32 + i] = -(v[i] + off) * LOG2E;
    __syncthreads();
  }
}
DI void phase_qknorm(const Params& p, int bid, int nb) {
  const int lane = tidx() & 63, gw = bid * 4 + (tidx() >> 6), nw = nb * 4;
  const bf16_t* proj = (const bf16_t*)(p.ws + WS_P);
  unsigned* qk = (unsigned*)(p.ws + WS_CTL) + 64;
  for (int it = gw; it < 4096; it += nw) {
    const int bh = it >> 7, j = it & 127, b = bh >> 3, h = bh & 7;
    const bf16_t* rp = proj + ((size_t)b * S_ + j * 64 + lane) * PP + h * 64;
    float sq = 0.f, sk = 0.f;
#pragma unroll
    for (int q = 0; q < 8; ++q) { const u32x4 wq = *(const u32x4*)(rp + 8 * q), wk = *(const u32x4*)(rp + 512 + 8 * q);
#pragma unroll
      for (int e = 0; e < 4; ++e) { const float a0 = bflo(wq[e]), a1 = bfhi(wq[e]), c0 = bflo(wk[e]), c1 = bfhi(wk[e]); sq += a0 * a0 + a1 * a1; sk += c0 * c0 + c1 * c1; } }
#pragma unroll
    for (int d = 32; d >= 1; d >>= 1) { sq = fmaxf(sq, __shfl_xor(sq, d)); sk = fmaxf(sk, __shfl_xor(sk, d)); }
    if (lane == 0) { atomicMax(qk + 2 * bh, __float_as_uint(sq)); atomicMax(qk + 2 * bh + 1, __float_as_uint(sk)); }
  }
}

DI int swzv(int row, int c) { return row * 128 + ((c ^ (((row >> 1) & 7) ^ ((row & 2) << 1))) << 4); }
DI void attn_unit(const Params& p, int bh, int qb, char* lds) {
  const int tid = tidx(), lane = tid & 63, wid = tid >> 6, r32 = lane & 31, hi = lane >> 5;
  const int b = bh >> 3, h = bh & 7;
  bf16_t* proj = (bf16_t*)(p.ws + WS_P);
  const float* fneg = (const float*)(p.ws + WS_FNEG) + (size_t)bh * S_;
  const size_t rowbase = (size_t)b * S_;
  char* Ks = lds; char* Vs = lds + 8192; float* Fs = (float*)(lds + 16384);
  const LAS char* Vs3 = (const LAS char*)Vs;
  const int qrow = qb * 128 + wid * 32 + r32;
  bf16_t* qptr = proj + (rowbase + qrow) * PP + h * 64;
  bf16x8 qr[4];
  {
    const float c2 = 0.125f * LOG2E;
#pragma unroll
    for (int ks = 0; ks < 4; ++ks) { const u32x4 w = *(const u32x4*)(qptr + ks * 16 + hi * 8);
      qr[ks] = pack8(bflo(w[0]) * c2, bfhi(w[0]) * c2, bflo(w[1]) * c2, bfhi(w[1]) * c2, bflo(w[2]) * c2, bfhi(w[2]) * c2, bflo(w[3]) * c2, bfhi(w[3]) * c2); }
  }
  f32x16 o0, o1;
#pragma unroll
  for (int r = 0; r < 16; ++r) { o0[r] = 0.f; o1[r] = 0.f; }
  float m = -1e30f, l = 0.f;
  const float qkmax = sqrtf(__uint_as_float(((const unsigned*)(p.ws + WS_CTL))[64 + 2 * bh])) * sqrtf(__uint_as_float(((const unsigned*)(p.ws + WS_CTL))[64 + 2 * bh + 1])) * (0.125f * LOG2E * 1.02f);
  int* flags = (int*)(lds + 16384 + 256);
  const int ntiles = 2 * qb + 2;
  const int srow = tid >> 3, sc = tid & 7;
  const bf16_t* kg = proj + (rowbase + srow) * PP + 512 + h * 64 + sc * 8;
  const bf16_t* vg = proj + (rowbase + srow) * PP + 1024 + h * 64 + sc * 8;
  u32x4 rk[2], rv[2]; f32x4 rf = {0.f, 0.f, 0.f, 0.f};
  {
    const int j0 = ntiles - 1;
#pragma unroll
    for (int i = 0; i < 2; ++i) { rk[i] = *(const u32x4*)(kg + (size_t)(j0 * 64 + 32 * i) * PP); rv[i] = *(const u32x4*)(vg + (size_t)(j0 * 64 + 32 * i) * PP); }
    if (tid < 16) rf = *(const f32x4*)(fneg + j0 * 64 + tid * 4);
  }
  if (tid < 8) flags[tid] = 0;
  const int wave_maxrow = qb * 128 + wid * 32 + 31;
  for (int j = ntiles - 1; j >= 0; --j) {
    __syncthreads();
#pragma unroll
    for (int i = 0; i < 2; ++i) { *(u32x4*)(Ks + swz(srow + 32 * i, sc)) = rk[i]; *(u32x4*)(Vs + swzv(srow + 32 * i, sc)) = rv[i]; }
    if (tid < 16) *(f32x4*)(Fs + tid * 4) = rf;
    __syncthreads();
    { const int* fl = flags + 4 * ((j + 1) & 1); if ((fl[0] & fl[1] & fl[2] & fl[3]) != 0) break; }
    float ubf = 0.f;
    if (j > 0) { ubf = fneg[j * 64 - 1]; }
    if (j > 0) {
#pragma unroll
      for (int i = 0; i < 2; ++i) { rk[i] = *(const u32x4*)(kg + (size_t)((j - 1) * 64 + 32 * i) * PP); rv[i] = *(const u32x4*)(vg + (size_t)((j - 1) * 64 + 32 * i) * PP); }
      if (tid < 16) rf = *(const f32x4*)(fneg + (j - 1) * 64 + tid * 4);
    }
    if (j * 64 <= wave_maxrow) {
    f32x16 p0, p1;
#pragma unroll
    for (int g = 0; g < 4; ++g) { const f32x4 a = *(const f32x4*)(Fs + 8 * g + 4 * hi), c = *(const f32x4*)(Fs + 32 + 8 * g + 4 * hi);
#pragma unroll
      for (int e = 0; e < 4; ++e) { p0[4 * g + e] = a[e]; p1[4 * g + e] = c[e]; } }
#pragma unroll
    for (int ks = 0; ks < 4; ++ks) {
      const bf16x8 k0 = *(const bf16x8*)(Ks + swz(r32, 2 * ks + hi)), k1 = *(const bf16x8*)(Ks + swz(32 + r32, 2 * ks + hi));
      p0 = MFMA32(k0, qr[ks], p0); p1 = MFMA32(k1, qr[ks], p1);
    }
    if (j >= 2 * qb) {
      const int kb = j * 64;
#pragma unroll
      for (int r = 0; r < 16; ++r) { const int kv = kb + crow(r, hi); if (kv > qrow) p0[r] = -INFINITY; if (kv + 32 > qrow) p1[r] = -INFINITY; }
    }
    float mx = fmaxf(p0[0], p1[0]);
#pragma unroll
    for (int r = 1; r < 16; ++r) mx = fmaxf(mx, fmaxf(p0[r], p1[r]));
    mx = fmaxf(mx, __shfl_xor(mx, 32));
    const float mn = fmaxf(m, mx), alpha = exp2f(m - mn); m = mn;
    float ps = 0.f;
#pragma unroll
    for (int r = 0; r < 16; ++r) { p0[r] = exp2f(p0[r] - mn); p1[r] = exp2f(p1[r] - mn); ps += p0[r] + p1[r]; }
    l = l * alpha + ps;
#pragma unroll
    for (int r = 0; r < 16; ++r) { o0[r] *= alpha; o1[r] *= alpha; }
    bf16x8 pf[2][2];
    pf[0][0] = pack8(p0[0], p0[1], p0[2], p0[3], p0[4], p0[5], p0[6], p0[7]);
    pf[0][1] = pack8(p0[8], p0[9], p0[10], p0[11], p0[12], p0[13], p0[14], p0[15]);
    pf[1][0] = pack8(p1[0], p1[1], p1[2], p1[3], p1[4], p1[5], p1[6], p1[7]);
    pf[1][1] = pack8(p1[8], p1[9], p1[10], p1[11], p1[12], p1[13], p1[14], p1[15]);
#pragma unroll
    for (int pb = 0; pb < 2; ++pb)
#pragma unroll
      for (int s = 0; s < 2; ++s) {
        const int rowa = 32 * pb + 16 * s + 4 * hi + ((lane & 15) >> 2);
#pragma unroll
        for (int d0 = 0; d0 < 2; ++d0) {
          const int cl = 4 * d0 + 2 * ((lane >> 4) & 1) + ((lane & 3) >> 1), sub = 8 * (lane & 1);
          const s16x4 lo = tr16(Vs3 + swzv(rowa, cl) + sub), hi4 = tr16(Vs3 + swzv(rowa + 8, cl) + sub);
          const bf16x8 vf = cat8(lo, hi4);
          if (d0 == 0) o0 = MFMA32(vf, pf[pb][s], o0); else o1 = MFMA32(vf, pf[pb][s], o1);
        }
      }
    }
    if (j > 0) {
      const float ub = qkmax + ubf + log2f((float)(j * 64));
      const int ok = __all((ub - m) <= -30.f);
      if (lane == 0) flags[4 * (j & 1) + wid] = ok;
    }
  }
  l += __shfl_xor(l, 32);
  const float inv = 1.f / l;
#pragma unroll
  for (int g = 0; g < 4; ++g) {
    u32x2 a = {pk2(o0[4 * g] * inv, o0[4 * g + 1] * inv), pk2(o0[4 * g + 2] * inv, o0[4 * g + 3] * inv)};
    u32x2 c = {pk2(o1[4 * g] * inv, o1[4 * g + 1] * inv), pk2(o1[4 * g + 2] * inv, o1[4 * g + 3] * inv)};
    *(u32x2*)(qptr + 8 * g + 4 * hi) = a; *(u32x2*)(qptr + 32 + 8 * g + 4 * hi) = c;
  }
}
DI void phase_attn(const Params& p, int bid, int nb, char* lds) {
  for (int u = bid; u < 2048; u += nb) attn_unit(p, u & 31, 63 - (u >> 5), lds);
}

constexpr int QP = 136;
DI void gdn_prep_unit(const Params& p, int U, char* lds) {
  const int tid = tidx(), lane = tid & 63, wid = tid >> 6, fr = lane & 15, fq = lane >> 4;
  const int b = U >> 9, h = (U >> 7) & 3, c = U & 127;
  const size_t t0 = (size_t)b * S_ + c * 64;
  const int s0 = c * 64;
  const bf16_t* proj = (const bf16_t*)(p.ws + WS_P);
  const float* small = (const float*)(p.ws + WS_SMALL);
  bf16_t* q_s = (bf16_t*)lds; bf16_t* k_s = q_s + 64 * QP; bf16_t* v_s = k_s + 64 * QP;
  float* Lm = (float*)(lds + 3 * 17408);
  bf16_t* T1 = (bf16_t*)Lm; bf16_t* T2 = T1 + 64 * 72;
  float* gcs = (float*)(lds + 3 * 17408 + 18432);
  bf16_t* QF = (bf16_t*)((char*)p.out) + (size_t)U * 8192;
  bf16_t* KF = (bf16_t*)((char*)p.out + 32 * MiB) + (size_t)U * 8192;
  bf16_t* AF = (bf16_t*)((char*)p.out + 64 * MiB) + (size_t)U * 4096;
  bf16_t* UF = (bf16_t*)(p.ws + WS_UF) + (size_t)U * 8192;
  bf16_t* WF = (bf16_t*)(p.ws + WS_WF) + (size_t)U * 8192;
  __syncthreads();
  if (wid == 0) {
    const float g = small[(t0 + lane) * 16 + 12 + h], bt = small[(t0 + lane) * 16 + 8 + h];
    float cs = g;
#pragma unroll
    for (int d = 1; d < 64; d <<= 1) { const float n = __shfl_up(cs, d); if (lane >= d) cs += n; }
    const float gl = __shfl(cs, 63);
    gcs[lane] = cs; gcs[64 + lane] = bt; gcs[128 + lane] = __expf(cs); gcs[192 + lane] = __expf(gl - cs);
    if (lane == 0) { gcs[256] = __expf(gl); ((float*)(p.ws + WS_GL))[U] = __expf(gl); }
  }
  __syncthreads();
  {
#pragma unroll
    for (int X = 0; X < 3; ++X) {
      const int col = 1536 + 512 * X + h * 128 + 2 * lane, cb = 512 * X + h * 128 + 2 * lane;
      float w0[4], w1[4];
#pragma unroll
      for (int j = 0; j < 4; ++j) { w0[j] = p.conv_w[j * 1536 + cb]; w1[j] = p.conv_w[j * 1536 + cb + 1]; }
      bf16_t* dst = X == 0 ? q_s : (X == 1 ? k_s : v_s);
      float xa[4], xb[4];
      const int i0 = 16 * wid;
#pragma unroll
      for (int j = 0; j < 3; ++j) { const int rr = i0 - 3 + j; unsigned u = 0u; if (s0 + rr >= 0) u = *(const unsigned*)(proj + (size_t)((long)t0 + rr) * PP + col); xa[j + 1] = bflo(u); xb[j + 1] = bfhi(u); }
      for (int i = i0; i < i0 + 16; ++i) {
        xa[0] = xa[1]; xa[1] = xa[2]; xa[2] = xa[3]; xb[0] = xb[1]; xb[1] = xb[2]; xb[2] = xb[3];
        const unsigned u = *(const unsigned*)(proj + (t0 + i) * PP + col); xa[3] = bflo(u); xb[3] = bfhi(u);
        float y0 = w0[0] * xa[0] + w0[1] * xa[1] + w0[2] * xa[2] + w0[3] * xa[3];
        float y1 = w1[0] * xb[0] + w1[1] * xb[1] + w1[2] * xb[2] + w1[3] * xb[3];
        y0 = y0 * sigmoidf_(y0); y1 = y1 * sigmoidf_(y1);
        if (X < 2) { const float ss = wave_sum(y0 * y0 + y1 * y1); const float rn = rsqrtf(ss + 1e-6f); y0 *= rn; y1 *= rn; }
        *(unsigned*)(dst + i * QP + 2 * lane) = pk2(y0, y1);
        if (X == 0) {
          const float f = 0.08838834764831845f * gcs[128 + i];
          const int d = 2 * lane, mm = d >> 5, ss2 = (d >> 4) & 1, aa = (d >> 3) & 1, hh = (d >> 2) & 1, bb = d & 3;
          const int lp = (i & 31) + 32 * hh;
          *(unsigned*)(QF + (size_t)(((((i >> 5) * 4 + mm) * 2 + ss2) * 64 + lp) * 8 + 4 * aa + bb)) = pk2(y0 * f, y1 * f);
        }
      }
    }
  }
  __syncthreads();
  {
    bf16x8 ka[4];
#pragma unroll
    for (int kk = 0; kk < 4; ++kk) ka[kk] = *(const bf16x8*)(k_s + (16 * wid + fr) * QP + kk * 32 + fq * 8);
#pragma unroll
    for (int ni = 0; ni < 4; ++ni) {
      f32x4 dkk = {0.f, 0.f, 0.f, 0.f}, dqk = {0.f, 0.f, 0.f, 0.f};
      const int i = 16 * ni + fr, jj0 = 16 * wid + 4 * fq;
      if (ni >= wid) {
#pragma unroll
        for (int kk = 0; kk < 4; ++kk) {
          const bf16x8 bk = *(const bf16x8*)(k_s + (16 * ni + fr) * QP + kk * 32 + fq * 8), bq = *(const bf16x8*)(q_s + (16 * ni + fr) * QP + kk * 32 + fq * 8);
          dkk = MFMA16(ka[kk], bk, dkk); dqk = MFMA16(ka[kk], bq, dqk);
        }
      }
      const float gi = gcs[i], bi = gcs[64 + i];
      f32x4 lv, av;
#pragma unroll
      for (int r = 0; r < 4; ++r) { const int jj = jj0 + r; const float dec = __expf(fminf(gi - gcs[jj], 0.f));
        lv[r] = (jj < i) ? bi * dkk[r] * dec : 0.f; av[r] = (jj <= i) ? dqk[r] * 0.08838834764831845f * dec : 0.f; }
      *(f32x4*)(Lm + i * 68 + jj0) = lv;
      const int lp = (i & 31) + 32 * (fq & 1);
      u32x2 o = {pk2(av[0], av[1]), pk2(av[2], av[3])};
      *(u32x2*)(AF + (size_t)((((((i >> 5) * 2 + (wid >> 1)) * 2 + (wid & 1)) * 64 + lp) * 8) + 4 * (fq >> 1))) = o;
    }
    for (int it = tid; it < 2048; it += NT) {
      const int d = it & 127, jg = it >> 7;
      float v4[4];
#pragma unroll
      for (int e = 0; e < 4; ++e) { const int jj = 4 * jg + e; v4[e] = bf2f(k_s[jj * QP + d]) * gcs[192 + jj]; }
      const int lp = (d & 31) + 32 * (jg & 1);
      u32x2 o = {pk2(v4[0], v4[1]), pk2(v4[2], v4[3])};
      *(u32x2*)(KF + (size_t)((((((d >> 5) * 2 + (jg >> 3)) * 2 + ((jg >> 2) & 1)) * 64 + lp) * 8) + 4 * ((jg >> 1) & 1))) = o;
    }
  }
  __syncthreads();
  {
    float* Ts = (float*)q_s;
    if (wid < 2 && lane < 32) {
      const int o = 32 * wid;
      for (int i = 0; i < 32; ++i) {
        float a0 = (lane == i) ? 1.f : 0.f, a1 = 0.f, a2 = 0.f, a3 = 0.f;
        const float* Li = Lm + (o + i) * 68 + o;
        int j = 0;
#pragma unroll 4
        for (; j + 4 <= i; j += 4) {
          const f32x4 Lv = *(const f32x4*)(Li + j);
          a0 -= Lv[0] * Ts[(o + j) * 64 + o + lane]; a1 -= Lv[1] * Ts[(o + j + 1) * 64 + o + lane]; a2 -= Lv[2] * Ts[(o + j + 2) * 64 + o + lane]; a3 -= Lv[3] * Ts[(o + j + 3) * 64 + o + lane];
        }
        for (; j < i; ++j) a0 -= Li[j] * Ts[(o + j) * 64 + o + lane];
        Ts[(o + i) * 64 + o + lane] = (a0 + a1) + (a2 + a3);
      }
    }
    __syncthreads();
    const int cc = tid & 31, ig = tid >> 5;
    {
      float x0 = 0.f, x1 = 0.f, x2 = 0.f, x3 = 0.f;
#pragma unroll 8
      for (int j = 0; j < 32; ++j) { const float tj = Ts[j * 64 + cc];
        x0 += Lm[(32 + 4 * ig) * 68 + j] * tj; x1 += Lm[(33 + 4 * ig) * 68 + j] * tj; x2 += Lm[(34 + 4 * ig) * 68 + j] * tj; x3 += Lm[(35 + 4 * ig) * 68 + j] * tj; }
      Ts[(4 * ig) * 64 + 32 + cc] = x0; Ts[(4 * ig + 1) * 64 + 32 + cc] = x1; Ts[(4 * ig + 2) * 64 + 32 + cc] = x2; Ts[(4 * ig + 3) * 64 + 32 + cc] = x3;
    }
    __syncthreads();
    {
      float x0 = 0.f, x1 = 0.f, x2 = 0.f, x3 = 0.f;
#pragma unroll 8
      for (int j = 0; j < 32; ++j) { const float xj = Ts[j * 64 + 32 + cc];
        x0 -= Ts[(32 + 4 * ig) * 64 + 32 + j] * xj; x1 -= Ts[(33 + 4 * ig) * 64 + 32 + j] * xj; x2 -= Ts[(34 + 4 * ig) * 64 + 32 + j] * xj; x3 -= Ts[(35 + 4 * ig) * 64 + 32 + j] * xj; }
      Ts[(32 + 4 * ig) * 64 + cc] = x0; Ts[(33 + 4 * ig) * 64 + cc] = x1; Ts[(34 + 4 * ig) * 64 + cc] = x2; Ts[(35 + 4 * ig) * 64 + cc] = x3;
    }
    __syncthreads();
    {
      const int c = tid & 63, rg = tid >> 6;
      const float f1 = gcs[64 + c], f2 = f1 * gcs[128 + c];
      asm volatile("" ::: "memory");
      for (int i = 16 * rg; i < 16 * rg + 16; ++i) { const float t = (i < 32 && c >= 32) ? 0.f : Ts[i * 64 + c]; T1[i * 72 + c] = f2bf(t * f1); T2[i * 72 + c] = f2bf(t * f2); }
    }
  }
  __syncthreads();
  {
    const LAS char* v3 = (const LAS char*)v_s; const LAS char* k3 = (const LAS char*)k_s;
    bf16x8 ta[2], tb[2];
#pragma unroll
    for (int kk = 0; kk < 2; ++kk) { ta[kk] = *(const bf16x8*)(T1 + (16 * wid + fr) * 72 + kk * 32 + fq * 8); tb[kk] = *(const bf16x8*)(T2 + (16 * wid + fr) * 72 + kk * 32 + fq * 8); }
#pragma unroll
    for (int nj = 0; nj < 8; ++nj) {
      f32x4 du = {0.f, 0.f, 0.f, 0.f}, dw = {0.f, 0.f, 0.f, 0.f};
#pragma unroll
      for (int kk = 0; kk < 2; ++kk) {
        const int jr = 32 * kk + 8 * fq + ((lane & 15) >> 2), cc = 16 * nj + 4 * (lane & 3);
        const bf16x8 vb = cat8(tr16(v3 + (jr * QP + cc) * 2), tr16(v3 + ((jr + 4) * QP + cc) * 2));
        const bf16x8 kb = cat8(tr16(k3 + (jr * QP + cc) * 2), tr16(k3 + ((jr + 4) * QP + cc) * 2));
        du = MFMA16(ta[kk], vb, du);
        dw = MFMA16(kb, tb[kk], dw);
      }
      {
        const int lp = 16 * (nj & 1) + fr + 32 * (fq & 1);
        u32x2 o = {pk2(du[0], du[1]), pk2(du[2], du[3])};
        *(u32x2*)(UF + (size_t)(((((wid >> 1) * 4 + (nj >> 1)) * 64 + lp) * 16) + 4 * (2 * (wid & 1) + (fq >> 1)))) = o;
      }
      {
        const int lp = 16 * (wid & 1) + fr + 32 * (fq & 1);
        u32x2 o = {pk2(-dw[0], -dw[1]), pk2(-dw[2], -dw[3])};
        *(u32x2*)(WF + (size_t)((((((wid >> 1) * 4 + (nj >> 1)) * 2 + (nj & 1)) * 64 + lp) * 8) + 4 * (fq >> 1))) = o;
      }
    }
  }
}
DI void phase_gdnprep(const Params& p, int bid, int nb, char* lds) {
  for (int U = bid; U < 2048; U += nb) gdn_prep_unit(p, U, lds);
}

DI bf16x8 packS(const f32x16& x, int s) { return pack8(x[8 * s], x[8 * s + 1], x[8 * s + 2], x[8 * s + 3], x[8 * s + 4], x[8 * s + 5], x[8 * s + 6], x[8 * s + 7]); }
DI void gdn_scan_seq(const Params& p, int bh16, char* lds) {
  const int tid = tidx(), lane = tid & 63, wv = tid >> 6;
  const float* glp = (const float*)(p.ws + WS_GL) + bh16 * 128;
  const char* wf = (const char*)(p.ws + WS_WF) + (size_t)bh16 * 128 * 16384 + tid * 16;
  const char* kf = (const char*)p.out + 32 * MiB + (size_t)bh16 * 128 * 16384 + tid * 16;
  const char* uf = (const char*)(p.ws + WS_UF) + (size_t)bh16 * 128 * 16384 + (size_t)(wv * 64 + lane) * 32;
  char* scp = p.ws + WS_SC + (size_t)bh16 * 128 * 32768 + (size_t)wv * 8192 + lane * 16;
#define SCAN_DMA(gsrc, ldsoff) __builtin_amdgcn_global_load_lds((const unsigned*)(gsrc), (LAS unsigned*)(lds + (ldsoff) + wv * 1024), 16, 0, 0)
#define SCAN_WK(c, slot) do { _Pragma("unroll") for (int i = 0; i < 4; ++i) { SCAN_DMA(wf + (size_t)(c) * 16384 + i * 4096, (slot) * 32768 + i * 4096); SCAN_DMA(kf + (size_t)(c) * 16384 + i * 4096, (slot) * 32768 + 16384 + i * 4096); } } while (0)
#define SCAN_U(c) do { _Pragma("unroll") for (int i2 = 0; i2 < 2; ++i2) { un[2 * i2] = *(const u32x4*)(uf + (size_t)(c) * 16384 + i2 * 8192); un[2 * i2 + 1] = *(const u32x4*)(uf + (size_t)(c) * 16384 + i2 * 8192 + 16); } gln = glp[c]; } while (0)
  f32x16 S[4];
#pragma unroll
  for (int m = 0; m < 4; ++m)
#pragma unroll
    for (int r = 0; r < 16; ++r) S[m][r] = 0.f;
  u32x4 un[4]; float gln;
  __syncthreads();
  SCAN_WK(0, 0); SCAN_U(0);
#pragma unroll 1
  for (int c = 0; c < 128; ++c) {
    __syncthreads();
    f32x16 vn[2];
#pragma unroll
    for (int i2 = 0; i2 < 2; ++i2) {
#pragma unroll
      for (int e = 0; e < 4; ++e) { vn[i2][2 * e] = bflo(un[2 * i2][e]); vn[i2][2 * e + 1] = bfhi(un[2 * i2][e]); vn[i2][8 + 2 * e] = bflo(un[2 * i2 + 1][e]); vn[i2][8 + 2 * e + 1] = bfhi(un[2 * i2 + 1][e]); }
    }
    const float gl = gln;
    asm volatile("" : "+v"(vn[0]), "+v"(vn[1]));
    __builtin_amdgcn_sched_barrier(0);
    if (c + 1 < 128) { SCAN_WK(c + 1, (c + 1) & 1); SCAN_U(c + 1); }
    const char* lw = lds + (c & 1) * 32768 + lane * 16; const char* lk = lw + 16384;
    char* sco = scp + (size_t)c * 32768;
#pragma unroll
    for (int m = 0; m < 4; ++m) {
      const bf16x8 sb0 = packS(S[m], 0), sb1 = packS(S[m], 1);
      *(bf16x8*)(sco + (m * 2 + 0) * 1024) = sb0; *(bf16x8*)(sco + (m * 2 + 1) * 1024) = sb1;
#pragma unroll
      for (int i2 = 0; i2 < 2; ++i2) {
        vn[i2] = MFMA32(*(const bf16x8*)(lw + ((i2 * 4 + m) * 2 + 0) * 1024), sb0, vn[i2]);
        vn[i2] = MFMA32(*(const bf16x8*)(lw + ((i2 * 4 + m) * 2 + 1) * 1024), sb1, vn[i2]);
      }
    }
    bf16x8 Vb[2][2];
#pragma unroll
    for (int j2 = 0; j2 < 2; ++j2) { Vb[j2][0] = packS(vn[j2], 0); Vb[j2][1] = packS(vn[j2], 1); }
#pragma unroll
    for (int m = 0; m < 4; ++m) {
#pragma unroll
      for (int r = 0; r < 16; ++r) S[m][r] *= gl;
#pragma unroll
      for (int j2 = 0; j2 < 2; ++j2)
#pragma unroll
        for (int s = 0; s < 2; ++s) S[m] = MFMA32(*(const bf16x8*)(lk + ((m * 2 + j2) * 2 + s) * 1024), Vb[j2][s], S[m]);
    }
  }
#undef SCAN_DMA
#undef SCAN_WK
#undef SCAN_U
  __syncthreads();
}
DI void gdn_out_unit(const Params& p, int U, char* lds) {
  const int tid = tidx(), lane = tid & 63, wv = tid >> 6, r32 = lane & 31, hi = lane >> 5;
  const int b = U >> 9, h = (U >> 7) & 3, c = U & 127;
  bf16_t* proj = (bf16_t*)(p.ws + WS_P);
  const bf16x8* WF = (const bf16x8*)((const bf16_t*)(p.ws + WS_WF) + (size_t)U * 8192) + lane;
  const bf16x8* QF = (const bf16x8*)((const bf16_t*)((char*)p.out) + (size_t)U * 8192) + lane;
  const bf16x8* AF = (const bf16x8*)((const bf16_t*)((char*)p.out + 64 * MiB) + (size_t)U * 4096) + lane;
  const bf16_t* UF = (const bf16_t*)(p.ws + WS_UF) + (size_t)U * 8192;
  const bf16x8* SC = (const bf16x8*)(p.ws + WS_SC + (size_t)U * 32768 + (size_t)wv * 8192) + lane;
  bf16_t* ol = (bf16_t*)lds;
  bf16x8 Sb[4][2];
#pragma unroll
  for (int m = 0; m < 4; ++m) { Sb[m][0] = SC[(m * 2 + 0) * 64]; Sb[m][1] = SC[(m * 2 + 1) * 64]; }
  f32x16 vn[2], o[2];
#pragma unroll
  for (int i2 = 0; i2 < 2; ++i2) {
    const u32x4 ua = *(const u32x4*)(UF + (size_t)((i2 * 4 + wv) * 64 + lane) * 16), ub = *(const u32x4*)(UF + (size_t)((i2 * 4 + wv) * 64 + lane) * 16 + 8);
#pragma unroll
    for (int e = 0; e < 4; ++e) { vn[i2][2 * e] = bflo(ua[e]); vn[i2][2 * e + 1] = bfhi(ua[e]); vn[i2][8 + 2 * e] = bflo(ub[e]); vn[i2][8 + 2 * e + 1] = bfhi(ub[e]); }
#pragma unroll
    for (int r = 0; r < 16; ++r) o[i2][r] = 0.f;
#pragma unroll
    for (int m = 0; m < 4; ++m)
#pragma unroll
      for (int s = 0; s < 2; ++s) {
        vn[i2] = MFMA32(WF[((i2 * 4 + m) * 2 + s) * 64], Sb[m][s], vn[i2]);
        o[i2] = MFMA32(QF[((i2 * 4 + m) * 2 + s) * 64], Sb[m][s], o[i2]);
      }
  }
  bf16x8 Vb[2][2];
#pragma unroll
  for (int j2 = 0; j2 < 2; ++j2) { Vb[j2][0] = packS(vn[j2], 0); Vb[j2][1] = packS(vn[j2], 1); }
#pragma unroll
  for (int i2 = 0; i2 < 2; ++i2)
#pragma unroll
    for (int j2 = 0; j2 <= i2; ++j2)
#pragma unroll
      for (int s = 0; s < 2; ++s) o[i2] = MFMA32(AF[((i2 * 2 + j2) * 2 + s) * 64], Vb[j2][s], o[i2]);
  __syncthreads();
#pragma unroll
  for (int i2 = 0; i2 < 2; ++i2)
#pragma unroll
    for (int r = 0; r < 16; ++r) ol[(32 * i2 + crow(r, hi)) * 136 + 32 * wv + r32] = f2bf(o[i2][r]);
  __syncthreads();
  {
    const size_t t0 = (size_t)b * S_ + c * 64;
    const int row = tid >> 2, q4 = tid & 3;
    const bf16_t* gzp = proj + (t0 + row) * PP + 3072 + h * 128 + 32 * q4;
    bf16_t* op = proj + (t0 + row) * PP + 1536 + h * 128 + 32 * q4;
    float ss = 0.f;
#pragma unroll
    for (int q = 0; q < 4; ++q) { const u32x4 w = *(const u32x4*)(ol + row * 136 + 32 * q4 + 8 * q);
#pragma unroll
      for (int e = 0; e < 4; ++e) { const float a0 = bflo(w[e]), a1 = bfhi(w[e]); ss += a0 * a0 + a1 * a1; } }
    ss += __uint_as_float((unsigned)__builtin_amdgcn_update_dpp(0, (int)__float_as_uint(ss), 0xB1, 0xF, 0xF, true));
    ss += __uint_as_float((unsigned)__builtin_amdgcn_update_dpp(0, (int)__float_as_uint(ss), 0x4E, 0xF, 0xF, true));
    const float rstd = rsqrtf(ss * (1.f / 128.f) + 1e-6f);
#pragma unroll
    for (int q = 0; q < 4; ++q) {
      const u32x4 w = *(const u32x4*)(ol + row * 136 + 32 * q4 + 8 * q), gz = *(const u32x4*)(gzp + 8 * q);
      const f32x4 n0 = *(const f32x4*)(p.gdn_norm_w + 32 * q4 + 8 * q), n1 = *(const f32x4*)(p.gdn_norm_w + 32 * q4 + 8 * q + 4);
      float y[8];
#pragma unroll
      for (int e = 0; e < 4; ++e) { const float z0 = bflo(gz[e]), z1 = bfhi(gz[e]);
        const float g0 = (2 * e < 4) ? n0[(2 * e) & 3] : n1[(2 * e) & 3], g1 = (2 * e + 1 < 4) ? n0[(2 * e + 1) & 3] : n1[(2 * e + 1) & 3];
        y[2 * e] = bflo(w[e]) * rstd * g0 * (z0 * sigmoidf_(z0));
        y[2 * e + 1] = bfhi(w[e]) * rstd * g1 * (z1 * sigmoidf_(z1)); }
      u32x4 wv4 = {pk2(y[0], y[1]), pk2(y[2], y[3]), pk2(y[4], y[5]), pk2(y[6], y[7])};
      *(u32x4*)(op + 8 * q) = wv4;
    }
  }
}
DI void phase_gdnout2(const Params& p, int bid, int nb, char* lds) {
  for (int U = bid; U < 2048; U += nb) gdn_out_unit(p, U, lds);
}
DI void phase_gdnout(const Params& p, int bid, int nb) {
  const int lane = tidx() & 63, gw = bid * 4 + (tidx() >> 6), nw = nb * 4;
  bf16_t* proj = (bf16_t*)(p.ws + WS_P);
  const f32x4 w0 = *(const f32x4*)(p.gdn_norm_w + (lane & 15) * 8), w1 = *(const f32x4*)(p.gdn_norm_w + (lane & 15) * 8 + 4);
  for (int row = gw; row < T_; row += nw) {
    bf16_t* op = proj + (size_t)row * PP + 1536 + lane * 8;
    const u32x4 ov = *(const u32x4*)op, zv = *(const u32x4*)(proj + (size_t)row * PP + 3072 + lane * 8);
    float o[8], z[8];
#pragma unroll
    for (int e = 0; e < 4; ++e) { o[2 * e] = bflo(ov[e]); o[2 * e + 1] = bfhi(ov[e]); z[2 * e] = bflo(zv[e]); z[2 * e + 1] = bfhi(zv[e]); }
    float ss = 0.f;
#pragma unroll
    for (int e = 0; e < 8; ++e) ss += o[e] * o[e];
    ss += __shfl_xor(ss, 1); ss += __shfl_xor(ss, 2); ss += __shfl_xor(ss, 4); ss += __shfl_xor(ss, 8);
    const float rstd = rsqrtf(ss * (1.f / 128.f) + 1e-6f);
    float y[8];
#pragma unroll
    for (int e = 0; e < 8; ++e) { const float w = e < 4 ? w0[e] : w1[e - 4]; y[e] = o[e] * rstd * w * (z[e] * sigmoidf_(z[e])); }
    u32x4 r = {pk2(y[0], y[1]), pk2(y[2], y[3]), pk2(y[4], y[5]), pk2(y[6], y[7])};
    *(u32x4*)op = r;
  }
}

struct EpiMergeA {
  const bf16_t* proj; bf16_t* mp;
  DI void operator()(int row, int col, f32x4 v, f32x4 w) const {
    const u32x4 g = *(const u32x4*)(proj + (size_t)row * PP + 3584 + col);
    u32x4 o = {pk2(v[0] * bflo(g[0]), v[1] * bfhi(g[0])), pk2(v[2] * bflo(g[1]), v[3] * bfhi(g[1])), pk2(w[0] * bflo(g[2]), w[1] * bfhi(g[2])), pk2(w[2] * bflo(g[3]), w[3] * bfhi(g[3]))};
    *(u32x4*)(mp + (size_t)row * 1024 + col) = o;
  }
};
struct EpiMergeB {
  const bf16_t* proj; bf16_t* mp;
  DI void operator()(int row, int col, f32x4 v, f32x4 w) const {
    const u32x4 g = *(const u32x4*)(proj + (size_t)row * PP + 4608 + col);
    const u32x4 q = *(const u32x4*)(mp + (size_t)row * 1024 + col);
    u32x4 o = {pk2(bflo(q[0]) + v[0] * bflo(g[0]), bfhi(q[0]) + v[1] * bfhi(g[0])), pk2(bflo(q[1]) + v[2] * bflo(g[1]), bfhi(q[1]) + v[3] * bfhi(g[1])),
               pk2(bflo(q[2]) + w[0] * bflo(g[2]), bfhi(q[2]) + w[1] * bfhi(g[2])), pk2(bflo(q[3]) + w[2] * bflo(g[3]), bfhi(q[3]) + w[3] * bfhi(g[3]))};
    *(u32x4*)(mp + (size_t)row * 1024 + col) = o;
  }
};
struct EpiF32 { float* out; int ld; DI void operator()(int row, int col, f32x4 v, f32x4 w) const { *(f32x4*)(out + (size_t)row * ld + col) = v; *(f32x4*)(out + (size_t)row * ld + col + 4) = w; } };
struct EpiBf16 { bf16_t* out; int ld; DI void operator()(int row, int col, f32x4 v, f32x4 w) const { u32x4 o = {pk2(v[0], v[1]), pk2(v[2], v[3]), pk2(w[0], w[1]), pk2(w[2], w[3])}; *(u32x4*)(out + (size_t)row * ld + col) = o; } };
DI void phase_merge(const Params& p, int bid, int nb, char* lds) {
  const bf16_t* proj = (const bf16_t*)(p.ws + WS_P);
  GemmArgs ga = {proj, PP, (const bf16_t*)(p.ws + WS_WFO), 512, 512};
  GemmArgs gb = {proj + 1536, PP, (const bf16_t*)(p.ws + WS_WGO), 512, 512};
  EpiMergeA ea = {proj, (bf16_t*)(p.ws + WS_H)};
  EpiMergeB eb = {proj, (bf16_t*)(p.ws + WS_H)};
  TileMap tm; tm.init(bid, nb, 8); int m, n; while (tm.next(m, n)) { gemm_tile(ga, m * 256, n * 128, lds, ea); gemm_tile(gb, m * 256, n * 128, lds, eb); }
}
DI void phase_wout(const Params& p, int bid, int nb, char* lds) {
  GemmArgs g = {(const bf16_t*)(p.ws + WS_H), 1024, (const bf16_t*)(p.ws + WS_WOUT), 1024, 1024};
  EpiF32 e = {p.out, 1024};
  TileMap tm; tm.init(bid, nb, 8); int m, n; while (tm.next(m, n)) gemm_tile(g, m * 256, n * 128, lds, e);
}
DI void phase_rows1(const Params& p, int bid, int nb) {
  const int lane = tidx() & 63, gw = bid * 4 + (tidx() >> 6), nw = nb * 4;
  const float* mod = (const float*)(p.ws + WS_MOD);
  bf16_t* h2 = (bf16_t*)(p.ws + WS_H);
  for (int row0 = gw * 2; row0 < T_; row0 += nw * 2) {
    const int b = row0 >> 13;
    f32x4 v[2][4], xv[2][4];
#pragma unroll
    for (int r = 0; r < 2; ++r)
#pragma unroll
      for (int i = 0; i < 4; ++i) { v[r][i] = ((const f32x4*)(p.out + (size_t)(row0 + r) * 1024))[lane + 64 * i]; xv[r][i] = ((const f32x4*)(p.x + (size_t)(row0 + r) * 1024))[lane + 64 * i]; }
#pragma unroll
    for (int r = 0; r < 2; ++r) {
      f32x4* mr = (f32x4*)(p.out + (size_t)(row0 + r) * 1024);
      float ss = 0.f;
#pragma unroll
      for (int i = 0; i < 4; ++i) ss += v[r][i][0] * v[r][i][0] + v[r][i][1] * v[r][i][1] + v[r][i][2] * v[r][i][2] + v[r][i][3] * v[r][i][3];
      ss = wave_sum(ss);
      const float rstd = rsqrtf(ss * (1.f / 1024.f) + 1e-6f);
      float s2 = 0.f;
#pragma unroll
      for (int i = 0; i < 4; ++i) {
        const int col = 4 * lane + 256 * i;
        const f32x4 g4 = *(const f32x4*)(p.g_post_mix + col), gt = *(const f32x4*)(mod + b * 6144 + 2048 + col);
        v[r][i] = xv[r][i] + gt * (v[r][i] * rstd * g4);
        mr[lane + 64 * i] = v[r][i];
        s2 += v[r][i][0] * v[r][i][0] + v[r][i][1] * v[r][i][1] + v[r][i][2] * v[r][i][2] + v[r][i][3] * v[r][i][3];
      }
      s2 = wave_sum(s2);
      const float rstd2 = rsqrtf(s2 * (1.f / 1024.f) + 1e-6f);
#pragma unroll
      for (int i = 0; i < 4; ++i) {
        const int col = 4 * lane + 256 * i;
        const f32x4 g4 = *(const f32x4*)(p.g_pre_ffn + col), sh = *(const f32x4*)(mod + b * 6144 + 3072 + col), sc = *(const f32x4*)(mod + b * 6144 + 4096 + col);
        const f32x4 y = (v[r][i] * rstd2 * g4) * (1.f + sc) + sh;
        u32x2 o = {pk2(y[0], y[1]), pk2(y[2], y[3])};
        *(u32x2*)(h2 + (size_t)(row0 + r) * 1024 + col) = o;
      }
    }
  }
}

DI void phase_peerq(const Params& p, int bid, int nb, char* lds) {
  GemmArgs g = {(const bf16_t*)(p.ws + WS_H), 1024, (const bf16_t*)(p.ws + WS_WQ), 1024, 1024};
  EpiBf16 e = {(bf16_t*)(p.ws + WS_QY), 2048};
  TileMap tm; tm.init(bid, nb, 16); int m, n; while (tm.next(m, n)) gemm_tile(g, m * 256, n * 128, lds, e);
}
DI unsigned ordkey(float f) { const unsigned u = __float_as_uint(f); return (u & 0x80000000u) ? ~u : (u | 0x80000000u); }
#define CE_DESC(x, y) do { const unsigned mx_ = (x) > (y) ? (x) : (y); const unsigned mn_ = (x) > (y) ? (y) : (x); (x) = mx_; (y) = mn_; } while (0)
DI void sort16_desc(unsigned (&a)[16]) {
#pragma unroll
  for (int k = 2; k <= 16; k <<= 1)
#pragma unroll
    for (int j = k >> 1; j > 0; j >>= 1)
#pragma unroll
      for (int i = 0; i < 16; ++i) {
        const int l = i ^ j;
        if (l > i) { if ((i & k) == 0) CE_DESC(a[i], a[l]); else CE_DESC(a[l], a[i]); }
      }
}
DI void merge16_desc(unsigned (&a)[16], const unsigned (&b)[16]) {
#pragma unroll
  for (int i = 0; i < 16; ++i) a[i] = a[i] > b[15 - i] ? a[i] : b[15 - i];
#pragma unroll
  for (int j = 8; j > 0; j >>= 1)
#pragma unroll
    for (int i = 0; i < 16; ++i) if ((i & j) == 0) CE_DESC(a[i], a[i + j]);
}
template <int CTRL> DI void dpp16(unsigned (&b)[16], const unsigned (&a)[16]) {
#pragma unroll
  for (int s = 0; s < 16; ++s) b[s] = (unsigned)__builtin_amdgcn_update_dpp(0, (int)a[s], CTRL, 0xF, 0xF, true);
}
__device__ const unsigned char PEER_CAND[64] = {
  0x00, 0x01, 0x02, 0x03, 0x04, 0x05, 0x06, 0x07, 0x08, 0x09, 0x0A, 0x0B, 0x0C, 0x0D, 0x0E, 0x0F,
  0x10, 0x11, 0x12, 0x13, 0x14, 0x15, 0x16, 0x17, 0x20, 0x21, 0x22, 0x23, 0x24, 0x80, 0x90, 0xA0,
  0x30, 0x31, 0x32, 0x33, 0x40, 0x41, 0x42, 0x50, 0x51, 0x60, 0x61, 0x70, 0x71, 0xB0, 0xC0, 0xD0,
  0xE0, 0xF0, 0xFF, 0xFF, 0xFF, 0xFF, 0xFF, 0xFF, 0xFF, 0xFF, 0xFF, 0xFF, 0xFF, 0xFF, 0xFF, 0xFF};
DI void peer_select_unit(const Params& p, int unit, char* lds) {
  const int tid = tidx(), lane = tid & 63, wid = tid >> 6, fr = lane & 15, fq = lane >> 4;
  const int h = unit & 7, t0 = (unit >> 3) * 32;
  float* sc = (float*)lds;
  float* topv = (float*)(lds + 64 * 132 * 4);
  int* topi = (int*)(lds + 64 * 132 * 4 + 64 * 16 * 4);
  const bf16_t* qy = (const bf16_t*)(p.ws + WS_QY);
  const bf16_t* keys = (const bf16_t*)(p.ws + WS_KEYS);
  __syncthreads();
  {
    const int set = wid >> 1, ts = wid & 1;
    bf16x8 qa[4];
#pragma unroll
    for (int kk = 0; kk < 4; ++kk) qa[kk] = *(const bf16x8*)(qy + (size_t)(t0 + 16 * ts + fr) * 2048 + h * 256 + set * 128 + kk * 32 + fq * 8);
#pragma unroll
    for (int nj = 0; nj < 8; ++nj) {
      f32x4 d = {0.f, 0.f, 0.f, 0.f};
#pragma unroll
      for (int kk = 0; kk < 4; ++kk) { const bf16x8 kb = *(const bf16x8*)(keys + set * 16384 + (16 * nj + fr) * 128 + kk * 32 + fq * 8); d = MFMA16(qa[kk], kb, d); }
#pragma unroll
      for (int r = 0; r < 4; ++r) sc[(set * 32 + 16 * ts + 4 * fq + r) * 132 + 16 * nj + fr] = d[r];
    }
  }
  __syncthreads();
#pragma unroll 1
  for (int pass = 0; pass < 2; ++pass) {
    const int rr = pass * 32 + (tid >> 3), part = tid & 7;
    unsigned a[16], bq[16];
    const float* srow = sc + rr * 132 + 16 * part;
#pragma unroll
    for (int j = 0; j < 4; ++j) {
      const f32x4 v = *(const f32x4*)(srow + 4 * j);
#pragma unroll
      for (int e = 0; e < 4; ++e) a[4 * j + e] = (ordkey(v[e]) & ~127u) | (unsigned)(127 - (16 * part + 4 * j + e));
    }
    sort16_desc(a);
    dpp16<0xB1>(bq, a); merge16_desc(a, bq);
    dpp16<0x4E>(bq, a); merge16_desc(a, bq);
    dpp16<0x141>(bq, a); merge16_desc(a, bq);
#pragma unroll
    for (int s = 0; s < 2; ++s) {
      unsigned k = 0u;
#pragma unroll
      for (int q = 0; q < 8; ++q) k = part == q ? a[2 * q + s] : k;
      const int idx = 127 - (int)(k & 127u);
      topv[rr * 16 + 2 * part + s] = sc[rr * 132 + idx]; topi[rr * 16 + 2 * part + s] = idx;
    }
  }
  __syncthreads();
  if (tid < 128) {
    const int tok = tid >> 2, q4 = tid & 3;
    unsigned c[16], bq[16];
#pragma unroll
    for (int i = 0; i < 16; ++i) {
      const unsigned code = PEER_CAND[16 * q4 + i];
      const float v = topv[tok * 16 + ((code >> 4) & 15)] + topv[(32 + tok) * 16 + (code & 15)];
      c[i] = code == 0xFFu ? 0u : ((ordkey(v) & ~255u) | (255u - code));
    }
    sort16_desc(c);
    dpp16<0xB1>(bq, c); merge16_desc(c, bq);
    dpp16<0x4E>(bq, c); merge16_desc(c, bq);
    float mx; { const int pos = 255 - (int)(c[0] & 255u); mx = topv[tok * 16 + (pos >> 4)] + topv[(32 + tok) * 16 + (pos & 15)]; }
    float val[4]; int ei[4]; float part = 0.f;
#pragma unroll
    for (int s = 0; s < 4; ++s) {
      unsigned k = 0u;
#pragma unroll
      for (int q = 0; q < 4; ++q) k = q4 == q ? c[4 * q + s] : k;
      const int pos = 255 - (int)(k & 255u); const int a = pos >> 4, b = pos & 15;
      const float v = topv[tok * 16 + a] + topv[(32 + tok) * 16 + b]; ei[s] = topi[tok * 16 + a] * 128 + topi[(32 + tok) * 16 + b];
      val[s] = __expf(v - mx); part += val[s];
    }
    part += __uint_as_float((unsigned)__builtin_amdgcn_update_dpp(0, (int)__float_as_uint(part), 0xB1, 0xF, 0xF, true));
    part += __uint_as_float((unsigned)__builtin_amdgcn_update_dpp(0, (int)__float_as_uint(part), 0x4E, 0xF, 0xF, true));
    const float rt = 1.f / part;
    int* eo = (int*)(p.ws + WS_EIDX) + ((size_t)(t0 + tok) * 8 + h) * 16 + 4 * q4; float* go = (float*)(p.ws + WS_GATE) + ((size_t)(t0 + tok) * 8 + h) * 16 + 4 * q4;
    *(f32x4*)go = (f32x4){val[0] * rt, val[1] * rt, val[2] * rt, val[3] * rt};
    typedef int i32x4 __attribute__((ext_vector_type(4)));
    *(i32x4*)eo = (i32x4){ei[0], ei[1], ei[2], ei[3]};
  }
}
DI void phase_peersel(const Params& p, int bid, int nb, char* lds) {
  for (int u = bid; u < 8192; u += nb) peer_select_unit(p, u, lds);
}
DI float dpp_sum8(float d) {
  d += __uint_as_float((unsigned)__builtin_amdgcn_update_dpp(0, (int)__float_as_uint(d), 0xB1, 0xF, 0xF, true));
  d += __uint_as_float((unsigned)__builtin_amdgcn_update_dpp(0, (int)__float_as_uint(d), 0x4E, 0xF, 0xF, true));
  d += __uint_as_float((unsigned)__builtin_amdgcn_update_dpp(0, (int)__float_as_uint(d), 0x141, 0xF, 0xF, true));
  return d;
}
DI void unpack8x2_fp8(const u32x4 w, f32x2 (&f)[8]) {
#pragma unroll
  for (int i = 0; i < 4; ++i) { f[2 * i] = __builtin_amdgcn_cvt_pk_f32_fp8((int)w[i], false); f[2 * i + 1] = __builtin_amdgcn_cvt_pk_f32_fp8((int)w[i], true); }
}
DI void unpack16_fp8(const u32x4 w, float (&f)[16]) {
#pragma unroll
  for (int i = 0; i < 4; ++i) { const f32x2 lo = __builtin_amdgcn_cvt_pk_f32_fp8((int)w[i], false), hi = __builtin_amdgcn_cvt_pk_f32_fp8((int)w[i], true); f[4 * i] = lo[0]; f[4 * i + 1] = lo[1]; f[4 * i + 2] = hi[0]; f[4 * i + 3] = hi[1]; }
}
typedef int i32x4_t __attribute__((ext_vector_type(4)));
DI void phase_peerdown(const Params& p, int bid, int nb) {
  const int lane = tidx() & 63, wid = tidx() >> 6, e8 = lane >> 3, c = lane & 7;
  const int x = bid & 7, gw = (bid >> 3) * 4 + wid, nw = (nb >> 3) * 4;
  const bf16_t* h2 = (const bf16_t*)(p.ws + WS_H) + 128 * x + 16 * c;
  const char* tab = p.ws + WS_PU + (size_t)x * 16384 * 128 + 16 * c;
  const int* eidx = (const int*)(p.ws + WS_EIDX) + 16 * e8;
  float* pd = (float*)(p.ws + WS_PD) + (size_t)x * T_ * 128 + 16 * e8 + c;
#define PD_IDX(t, E, H) do { _Pragma("unroll") for (int q = 0; q < 4; ++q) E[q] = *(const i32x4_t*)(eidx + (size_t)(t) * 128 + 4 * q); \
    H[0] = *(const u32x4*)(h2 + (size_t)(t) * 1024); H[1] = *(const u32x4*)(h2 + (size_t)(t) * 1024 + 8); } while (0)
#define PD_TAB(E, W) do { _Pragma("unroll") for (int q = 0; q < 16; ++q) W[q] = *(const u32x4*)(tab + (size_t)E[q >> 2][q & 3] * 128); } while (0)
#define PD_MATH(t, W, H) do { f32x2 hx[8]; \
    _Pragma("unroll") for (int e = 0; e < 4; ++e) { hx[e] = (f32x2){bflo(H[0][e]), bfhi(H[0][e])}; hx[4 + e] = (f32x2){bflo(H[1][e]), bfhi(H[1][e])}; } \
    float k0 = 0.f, k1 = 0.f; \
    _Pragma("unroll") for (int q = 0; q < 16; ++q) { f32x2 f[8]; unpack8x2_fp8(W[q], f); f32x2 d2 = f[0] * hx[0]; \
      _Pragma("unroll") for (int i = 1; i < 8; ++i) d2 = __builtin_elementwise_fma(f[i], hx[i], d2); \
      const float d = dpp_sum8(d2[0] + d2[1]); if (c == (q & 7)) { if (q < 8) k0 = d; else k1 = d; } } \
    pd[(size_t)(t) * 128] = k0; pd[(size_t)(t) * 128 + 8] = k1; } while (0)
  i32x4_t eA[4], eB[4]; u32x4 hA[2], hB[2], w[16];
  int t = gw; if (t >= T_) return;
  PD_IDX(t, eA, hA);
  for (;;) {
    PD_TAB(eA, w);
    const int t1 = t + nw; if (t1 < T_) PD_IDX(t1, eB, hB);
    PD_MATH(t, w, hA);
    if (t1 >= T_) break;
    PD_TAB(eB, w);
    const int t2 = t1 + nw; if (t2 < T_) PD_IDX(t2, eA, hA);
    PD_MATH(t1, w, hB);
    if (t2 >= T_) break;
    t = t2;
  }
#undef PD_IDX
#undef PD_TAB
#undef PD_MATH
}
DI void phase_peercoef(const Params& p, int bid, int nb) {
  const float* pd = (const float*)(p.ws + WS_PD);
  const int* eidx = (const int*)(p.ws + WS_EIDX); const float* gate = (const float*)(p.ws + WS_GATE);
  const float* uinv = (const float*)(p.ws + WS_UINV); const float* vinv = (const float*)(p.ws + WS_VINV);
  float* coef = (float*)(p.ws + WS_COEF);
  for (size_t i4 = ((size_t)bid * NT + tidx()) * 4; i4 < (size_t)T_ * 128; i4 += (size_t)nb * NT * 4) {
    f32x4 d = {0.f, 0.f, 0.f, 0.f};
#pragma unroll
    for (int x = 0; x < 8; ++x) d += *(const f32x4*)(pd + (size_t)x * T_ * 128 + i4);
    typedef int i32x4 __attribute__((ext_vector_type(4)));
    const i32x4 e = *(const i32x4*)(eidx + i4); const f32x4 g = *(const f32x4*)(gate + i4);
    f32x4 o;
#pragma unroll
    for (int k = 0; k < 4; ++k) { const float dk = d[k] * uinv[e[k]]; o[k] = g[k] * 0.5f * dk * (1.f + erff(dk * 0.70710678118654752f)) * vinv[e[k]]; }
    *(f32x4*)(coef + i4) = o;
  }
}
DI void phase_peerup(const Params& p, int bid, int nb) {
  const int lane = tidx() & 63, wid = tidx() >> 6, e8 = lane >> 3, c = lane & 7;
  const int x = bid & 7, gw = (bid >> 3) * 4 + wid, nw = (nb >> 3) * 4;
  const char* tab = p.ws + WS_PV + (size_t)x * 16384 * 128 + 16 * c;
  const int* eidx = (const int*)(p.ws + WS_EIDX) + 16 * e8; const float* coef = (const float*)(p.ws + WS_COEF) + 16 * e8;
  float* y2 = (float*)(p.ws + WS_Y2) + 128 * x + 16 * c; float* ssq = (float*)(p.ws + WS_SSQ) + (size_t)x * T_;
#define PU_IDX(t, E, C) do { _Pragma("unroll") for (int q = 0; q < 4; ++q) { E[q] = *(const i32x4_t*)(eidx + (size_t)(t) * 128 + 4 * q); C[q] = *(const f32x4*)(coef + (size_t)(t) * 128 + 4 * q); } } while (0)
#define PU_TAB(E, W) do { _Pragma("unroll") for (int q = 0; q < 16; ++q) W[q] = *(const u32x4*)(tab + (size_t)E[q >> 2][q & 3] * 128); } while (0)
#define PU_MATH(t, W, C) do { f32x2 yp[8]; \
    _Pragma("unroll") for (int i = 0; i < 8; ++i) yp[i] = (f32x2){0.f, 0.f}; \
    _Pragma("unroll") for (int q = 0; q < 16; ++q) { f32x2 f[8]; unpack8x2_fp8(W[q], f); const float cq = C[q >> 2][q & 3]; const f32x2 cc = {cq, cq}; \
      _Pragma("unroll") for (int i = 0; i < 8; ++i) yp[i] = __builtin_elementwise_fma(f[i], cc, yp[i]); } \
    float y[16]; float ss = 0.f; \
    _Pragma("unroll") for (int i = 0; i < 8; ++i) { y[2 * i] = yp[i][0]; y[2 * i + 1] = yp[i][1]; } \
    _Pragma("unroll") for (int i = 0; i < 16; ++i) { y[i] += __shfl_xor(y[i], 8); y[i] += __shfl_xor(y[i], 16); y[i] += __shfl_xor(y[i], 32); ss += y[i] * y[i]; } \
    ss = dpp_sum8(ss); \
    if (e8 == 0) { float* yo = y2 + (size_t)(t) * 1024; \
      _Pragma("unroll") for (int q = 0; q < 4; ++q) *(f32x4*)(yo + 4 * q) = (f32x4){y[4 * q], y[4 * q + 1], y[4 * q + 2], y[4 * q + 3]}; \
      if (c == 0) ssq[t] = ss; } } while (0)
  i32x4_t eA[4], eB[4]; f32x4 cA[4], cB[4]; u32x4 w[16];
  int t = gw; if (t >= T_) return;
  PU_IDX(t, eA, cA);
  for (;;) {
    PU_TAB(eA, w);
    const int t1 = t + nw; if (t1 < T_) PU_IDX(t1, eB, cB);
    PU_MATH(t, w, cA);
    if (t1 >= T_) break;
    PU_TAB(eB, w);
    const int t2 = t1 + nw; if (t2 < T_) PU_IDX(t2, eA, cA);
    PU_MATH(t1, w, cB);
    if (t2 >= T_) break;
    t = t2;
  }
#undef PU_IDX
#undef PU_TAB
#undef PU_MATH
}
DI void phase_final(const Params& p, int bid, int nb) {
  const int lane = tidx() & 63, gw = bid * 4 + (tidx() >> 6), nw = nb * 4;
  const float* mod = (const float*)(p.ws + WS_MOD);
  const float* y2 = (const float*)(p.ws + WS_Y2); const float* ssq = (const float*)(p.ws + WS_SSQ);
  for (int row0 = gw * 2; row0 < T_; row0 += nw * 2) {
    const int b = row0 >> 13;
    f32x4 ov[2][4], yv[2][4]; float ss[2] = {0.f, 0.f};
#pragma unroll
    for (int r = 0; r < 2; ++r) {
#pragma unroll
      for (int i = 0; i < 4; ++i) { ov[r][i] = ((const f32x4*)(p.out + (size_t)(row0 + r) * 1024))[lane + 64 * i]; yv[r][i] = ((const f32x4*)(y2 + (size_t)(row0 + r) * 1024))[lane + 64 * i]; }
#pragma unroll
      for (int x = 0; x < 8; ++x) ss[r] += ssq[(size_t)x * T_ + row0 + r];
    }
#pragma unroll
    for (int r = 0; r < 2; ++r) {
      const float rstd = rsqrtf(ss[r] * (1.f / 1024.f) + 1e-6f);
      f32x4* orow = (f32x4*)(p.out + (size_t)(row0 + r) * 1024);
#pragma unroll
      for (int i = 0; i < 4; ++i) {
        const int col = 4 * lane + 256 * i;
        const f32x4 g4 = *(const f32x4*)(p.g_post_ffn + col), gt = *(const f32x4*)(mod + b * 6144 + 5120 + col);
        orow[lane + 64 * i] = ov[r][i] + gt * (yv[r][i] * rstd * g4);
      }
    }
  }
}

namespace cg = cooperative_groups;
constexpr int LDS_BYTES = 75776;
DI void phase_mixer(const Params& p, int bid, int nb, char* lds) {
  if (bid < 16) gdn_scan_seq(p, bid, lds);
  unsigned* ctr = (unsigned*)(p.ws + WS_CTL);
  int* slot = (int*)(lds + LDS_BYTES - 16);
  for (;;) {
    __syncthreads();
    if (tidx() == 0) *slot = (int)atomicAdd(ctr, 1u);
    __syncthreads();
    const int u = *slot;
    if (u >= 2048) break;
    attn_unit(p, u & 31, 63 - (u >> 5), lds);
  }
}
#define XB_TMO      128
#define XB_XCNT(j)  (256  + 64 * (j))
#define XB_XSUB(j)  (1280 + 64 * (j))
#define XB_XGEN(j)  (2304 + 64 * (j))
#define XB_TOP      3328
#define XB_TOPGEN   3392
#define XCD_BAR_WORDS 3456
#define XB_SPIN_CAP (1u << 22)
DI unsigned xb_ld(unsigned* p)              { return __hip_atomic_load(p, __ATOMIC_RELAXED, __HIP_MEMORY_SCOPE_AGENT); }
DI unsigned xb_add(unsigned* p, unsigned v) { return __hip_atomic_fetch_add(p, v, __ATOMIC_RELAXED, __HIP_MEMORY_SCOPE_AGENT); }
DI unsigned xb_xcc_id() { return (unsigned)__builtin_amdgcn_s_getreg((3 << 11) | 20) & 0xFu; }
#define XB_SPIN(cond, bar) do { unsigned _sp = 0; while (cond) { __builtin_amdgcn_s_sleep(1); \
    if ((++_sp & 255u) == 0u) { if (xb_ld(&(bar)[XB_TMO])) break; if (_sp > XB_SPIN_CAP) { atomicAdd(&(bar)[XB_TMO], 1u); break; } } } } while (0)
struct XcdBarrier { unsigned* bar; unsigned x; volatile LAS unsigned* st; };
DI XcdBarrier xcd_barrier_post(unsigned* bar, volatile LAS unsigned* st) {
  XcdBarrier b; b.bar = bar; b.x = xb_xcc_id(); b.st = st;
  if (threadIdx.x == 0) (void)xb_add(&bar[XB_XCNT(b.x)], 1u);
  return b;
}
DI void xcd_barrier_complete(unsigned* bar, unsigned x, unsigned& nloc, unsigned& nx) {
  const unsigned G = gridDim.x * gridDim.y * gridDim.z;
  unsigned sum, cnt, mine, sp = 0u;
  for (;;) {
    sum = 0u; cnt = 0u; mine = 0u;
#pragma unroll
    for (unsigned j = 0; j < 16; ++j) { const unsigned c = xb_ld(&bar[XB_XCNT(j)]); sum += c; cnt += (c > 0u) ? 1u : 0u; mine = (j == x) ? c : mine; }
    if (sum == G) break;
    __builtin_amdgcn_s_sleep(1);
    if ((++sp & 255u) == 0u) { if (xb_ld(&bar[XB_TMO])) break; if (sp > XB_SPIN_CAP) { atomicAdd(&bar[XB_TMO], 1u); break; } }
  }
  nloc = mine > 0u ? mine : 1u; nx = cnt > 0u ? cnt : 1u;
}
DI void xcd_barrier(const XcdBarrier& b) {
  asm volatile("s_waitcnt vmcnt(0)" ::: "memory");
  __syncthreads();
  if (threadIdx.x == 0) {
    unsigned* bar = b.bar;
    __builtin_amdgcn_s_waitcnt(0);
    unsigned nloc = b.st[0], nx = b.st[1];
    if (nloc == 0u) { xcd_barrier_complete(bar, b.x, nloc, nx); b.st[0] = nloc; b.st[1] = nx; }
    const unsigned old = xb_add(&bar[XB_XSUB(b.x)], 1u);
    const unsigned gen = old / nloc;
    if (old + 1u == (gen + 1u) * nloc) {
      __builtin_amdgcn_fence(__ATOMIC_RELEASE, "agent");
      asm volatile("s_waitcnt vmcnt(0)" ::: "memory");
      const unsigned og = xb_add(&bar[XB_TOP], 1u);
      const unsigned tg = og / nx;
      if (og + 1u == (tg + 1u) * nx) xb_add(&bar[XB_TOPGEN], 1u);
      else XB_SPIN(xb_ld(&bar[XB_TOPGEN]) == tg, bar);
      __builtin_amdgcn_fence(__ATOMIC_ACQUIRE, "agent");
      xb_add(&bar[XB_XGEN(b.x)], 1u);
      asm volatile("s_waitcnt vmcnt(0)" ::: "memory");
    } else {
      XB_SPIN(xb_ld(&bar[XB_XGEN(b.x)]) == gen, bar);
      __builtin_amdgcn_fence(__ATOMIC_ACQUIRE, "agent");
      asm volatile("s_waitcnt vmcnt(0)" ::: "memory");
    }
  }
  __syncthreads();
}

#ifndef PROBE_PHASE
#define PROBE_PHASE -1
#endif
__global__ void __launch_bounds__(NT, 2) fwd(Params p) {
  extern __shared__ __attribute__((aligned(16))) char lds[];
  cg::grid_group grid = cg::this_grid();
  const int bid = blockIdx.x, nb = gridDim.x;
  unsigned long long tprev = 0, tprobe = 0; int nph = 0;
  volatile LAS unsigned* xst = (volatile LAS unsigned*)(lds + LDS_BYTES - 12);
  if (threadIdx.x == 0) { xst[0] = 0u; xst[1] = 0u; }
  unsigned* xbar = (unsigned*)(p.ws + WS_CTL) + 1024;
  if (bid == 0) for (int i = threadIdx.x; i < XCD_BAR_WORDS; i += NT) xbar[i] = 0u;
  XcdBarrier xb; xb.bar = xbar; xb.x = 0u; xb.st = xst;
  bool first_seam = true;
#define SEAM() do { if (first_seam) { asm volatile("s_waitcnt vmcnt(0)" ::: "memory"); grid.sync(); xb = xcd_barrier_post(xbar, xst); first_seam = false; } else xcd_barrier(xb); \
    if (PROBE_PHASE >= 0) { const unsigned long long tn = __builtin_amdgcn_s_memrealtime(); if (nph == PROBE_PHASE) tprobe = tn - tprev; tprev = tn; ++nph; } } while (0)
  if (bid == 0 && tidx() < 192) ((unsigned*)(p.ws + WS_CTL))[tidx()] = 0u;
  if (PROBE_PHASE >= 0) tprev = __builtin_amdgcn_s_memrealtime();
  phase_mod(p, bid, nb, lds); phase_wconv(p, bid, nb, lds);
  SEAM();
  phase_xnorm(p, bid, nb);
  SEAM();
  phase_inproj(p, bid, nb, lds);
  SEAM();
  if (bid < 32) phase_foxcum(p, bid, 32, lds);
  phase_qknorm(p, bid, nb);
  phase_gdnprep(p, bid, nb, lds);
  SEAM();
  phase_mixer(p, bid, nb, lds);
  SEAM();
  phase_gdnout2(p, bid, nb, lds);
  SEAM();
  phase_merge(p, bid, nb, lds);
  SEAM();
  phase_wout(p, bid, nb, lds); phase_tabconv(p, bid, nb);
  SEAM();
  phase_rows1(p, bid, nb);
  SEAM();
  phase_peerq(p, bid, nb, lds);
  SEAM();
  phase_peersel(p, bid, nb, lds);
  SEAM();
  phase_peerdown(p, bid, nb);
  SEAM();
  phase_peercoef(p, bid, nb);
  SEAM();
  phase_peerup(p, bid, nb);
  SEAM();
  phase_final(p, bid, nb);
  if (PROBE_PHASE >= 0) {
    if (PROBE_PHASE == nph) { xcd_barrier(xb); tprobe = __builtin_amdgcn_s_memrealtime() - tprev; }
    if (bid == 0 && tidx() == 0) { const unsigned long long t0 = __builtin_amdgcn_s_memrealtime(); while (__builtin_amdgcn_s_memrealtime() - t0 < tprobe) __builtin_amdgcn_s_sleep(8); }
  }
}

extern "C" void kernel_launch(void* const* d_in, const int* in_sizes, int n_in, void* d_out, int out_size, void* d_ws, size_t ws_size, hipStream_t stream) {
  static int grid_blocks = 0;
  if (!grid_blocks) {
    int dev = 0, cus = 0, per_cu = 0;
    hipGetDevice(&dev);
    hipDeviceGetAttribute(&cus, hipDeviceAttributeMultiprocessorCount, dev);
    (void)hipFuncSetAttribute((const void*)fwd, hipFuncAttributeMaxDynamicSharedMemorySize, LDS_BYTES);
    hipOccupancyMaxActiveBlocksPerMultiprocessor(&per_cu, (const void*)fwd, NT, LDS_BYTES);
    if (per_cu < 1) per_cu = 1;
    if (per_cu > 2) per_cu = 2;
    grid_blocks = cus * per_cu;
  }
  Params p{};
  const float** f = (const float**)&p;
  for (int i = 0; i < 23; ++i) f[i] = (const float*)d_in[i];
  p.out = (float*)d_out; p.ws = (char*)d_ws;
  void* args[] = {&p};
  hipError_t e = hipLaunchCooperativeKernel((const void*)fwd, dim3(grid_blocks), dim3(NT), args, LDS_BYTES, stream);
  if (e != hipSuccess) fprintf(stderr, "cooperative launch failed: %s (grid %d)\n", hipGetErrorString(e), grid_blocks);
}
```

```cpp
#include <hip/hip_runtime.h>
#include <hip/hip_cooperative_groups.h>
#include <stdint.h>
#include <math.h>
#include <cstdio>

#define DI __device__ __forceinline__
#define LAS __attribute__((address_space(3)))
typedef unsigned short bf16_t;
typedef short bf16x8 __attribute__((ext_vector_type(8)));
typedef short s16x4 __attribute__((ext_vector_type(4)));
typedef float f32x4 __attribute__((ext_vector_type(4)));
typedef float f32x16 __attribute__((ext_vector_type(16)));
typedef float f32x2 __attribute__((ext_vector_type(2)));
typedef unsigned u32x4 __attribute__((ext_vector_type(4)));
typedef unsigned u32x2 __attribute__((ext_vector_type(2)));
typedef __bf16 bf16x2_t __attribute__((ext_vector_type(2)));

constexpr int NT = 256;
constexpr int T_ = 32768, S_ = 8192;
constexpr int PP = 5632;
constexpr int NPAD = 5760;
constexpr float LOG2E = 1.4426950408889634f;
constexpr size_t MiB = 1u << 20;

constexpr size_t WS_CTL = 0;
constexpr size_t WS_MOD = 1 * MiB;
constexpr size_t WS_WIN = 2 * MiB;
constexpr size_t WS_WFO = 14 * MiB;
constexpr size_t WS_WGO = 15 * MiB;
constexpr size_t WS_WOUT = 16 * MiB;
constexpr size_t WS_WQ = 18 * MiB;
constexpr size_t WS_KEYS = 22 * MiB;
constexpr size_t WS_SMALL = 23 * MiB;
constexpr size_t WS_FNEG = 25 * MiB;
constexpr size_t WS_KNPM = 26 * MiB + 65536;
constexpr size_t WS_GL = 26 * MiB;
constexpr size_t WS_SC = 32 * MiB;
constexpr size_t WS_H = 32 * MiB;
constexpr size_t WS_P = 96 * MiB;
constexpr size_t WS_UF = 448 * MiB;
constexpr size_t WS_WF = 480 * MiB;
constexpr size_t WS_QY = 96 * MiB;
constexpr size_t WS_PU = 224 * MiB;
constexpr size_t WS_PV = 240 * MiB;
constexpr size_t WS_UINV = 256 * MiB;
constexpr size_t WS_VINV = 256 * MiB + 65536;
constexpr size_t WS_EIDX = 288 * MiB;
constexpr size_t WS_GATE = 304 * MiB;
constexpr size_t WS_PD = 320 * MiB;
constexpr size_t WS_Y2 = 96 * MiB;
constexpr size_t WS_COEF = 32 * MiB;
constexpr size_t WS_SSQ = 48 * MiB;

DI int tidx() { int t = threadIdx.x; asm volatile("" : "+v"(t)); return t; }
DI unsigned pk2(float lo, float hi) { f32x2 v = {lo, hi}; bf16x2_t b = __builtin_convertvector(v, bf16x2_t); return __builtin_bit_cast(unsigned, b); }
DI bf16_t f2bf(float x) { return (bf16_t)(pk2(x, 0.f) & 0xffffu); }
DI float bf2f(bf16_t v) { return __uint_as_float(((unsigned)v) << 16); }
DI float bflo(unsigned u) { return __uint_as_float(u << 16); }
DI float bfhi(unsigned u) { return __uint_as_float(u & 0xffff0000u); }
DI float wave_sum(float v) {
#pragma unroll
  for (int d = 32; d >= 1; d >>= 1) v += __shfl_xor(v, d);
  return v;
}
DI unsigned wave_max_u(unsigned v) {
#pragma unroll
  for (int d = 32; d >= 1; d >>= 1) { unsigned o = (unsigned)__shfl_xor((int)v, d); v = o > v ? o : v; }
  return v;
}
DI float sigmoidf_(float x) { return __builtin_amdgcn_rcpf(1.f + __expf(-x)); }
DI float softplusf_(float x) { return fmaxf(x, 0.f) + log1pf(__expf(-fabsf(x))); }
DI int crow(int r, int hi) { return (r & 3) + 8 * (r >> 2) + 4 * hi; }
#define MFMA16(a, b, c) __builtin_amdgcn_mfma_f32_16x16x32_bf16((a), (b), (c), 0, 0, 0)
#define MFMA32(a, b, c) __builtin_amdgcn_mfma_f32_32x32x16_bf16((a), (b), (c), 0, 0, 0)
DI s16x4 tr16(const LAS char* p) { typedef short v4i16_t __attribute__((ext_vector_type(4))); return __builtin_bit_cast(s16x4, __builtin_amdgcn_ds_read_tr16_b64_v4i16((LAS v4i16_t*)p)); }
DI bf16x8 cat8(s16x4 lo, s16x4 hi) { return __builtin_shufflevector(lo, hi, 0, 1, 2, 3, 4, 5, 6, 7); }
DI bf16x8 pack8(float a0, float a1, float a2, float a3, float a4, float a5, float a6, float a7) {
  u32x4 p = {pk2(a0, a1), pk2(a2, a3), pk2(a4, a5), pk2(a6, a7)}; return __builtin_bit_cast(bf16x8, p);
}

struct Params {
  const float *x, *c, *w_ada, *b_ada, *g_pre_mix, *g_post_mix, *w_in, *b_fgate, *fox_w_o, *conv_w, *a_log, *dt_bias, *gdn_norm_w, *gdn_w_o,
      *b_branch_gate, *w_out, *g_pre_ffn, *g_post_ffn, *peer_w_query, *peer_keys1, *peer_keys2, *peer_u, *peer_v;
  float* out; char* ws;
};

DI void phase_mod(const Params& p, int bid, int nb, char* lds) {
  float* sc = (float*)lds;
  float* part = sc + 4096;
  const int tid = tidx();
  for (int i = tid; i < 4096; i += NT) { float v = p.c[i]; sc[i] = v / (1.f + __expf(-v)); }
  __syncthreads();
  float* mod = (float*)(p.ws + WS_MOD);
  for (int g = bid; g < 96; g += nb) {
    const int cc = tid & 63, kg = tid >> 6, col = g * 64 + cc;
    float a0 = 0.f, a1 = 0.f, a2 = 0.f, a3 = 0.f;
#pragma unroll 8
    for (int k = kg; k < 1024; k += 4) { const float w = p.w_ada[(size_t)k * 6144 + col]; a0 += sc[k] * w; a1 += sc[1024 + k] * w; a2 += sc[2048 + k] * w; a3 += sc[3072 + k] * w; }
    part[(kg * 4 + 0) * 64 + cc] = a0; part[(kg * 4 + 1) * 64 + cc] = a1; part[(kg * 4 + 2) * 64 + cc] = a2; part[(kg * 4 + 3) * 64 + cc] = a3;
    __syncthreads();
    { const int b = tid >> 6; float s = part[(0 * 4 + b) * 64 + cc] + part[(1 * 4 + b) * 64 + cc] + part[(2 * 4 + b) * 64 + cc] + part[(3 * 4 + b) * 64 + cc];
      mod[b * 6144 + col] = s + p.b_ada[col]; }
    __syncthreads();
  }
}

DI int inproj_colmap(int n) {
  if (n < 1536) return n;
  if (n < 3584) return 1544 + (n - 1536);
  if (n < 5632) return 3600 + (n - 3584);
  if (n < 5640) return 1536 + (n - 5632);
  if (n < 5648) return 3592 + (n - 5640);
  return -1;
}
DI void transpose_tile(const float* src, int ldsrc, bf16_t* dst, int K, int n0, int k0, bool permute, float* tile) {
  const int tid = tidx(), tx = tid & 63, ty = tid >> 6;
  const int n = n0 + tx; const int oc = permute ? inproj_colmap(n) : n;
#pragma unroll 4
  for (int i = 0; i < 16; ++i) { const int ky = ty + 4 * i; tile[ky * 65 + tx] = (oc >= 0) ? src[(size_t)(k0 + ky) * ldsrc + oc] : 0.f; }
  __syncthreads();
#pragma unroll 4
  for (int i = 0; i < 16; ++i) { const int ny = ty + 4 * i; dst[(size_t)(n0 + ny) * K + k0 + tx] = f2bf(tile[tx * 65 + ny]); }
  __syncthreads();
}
DI void phase_wconv(const Params& p, int bid, int nb, char* lds) {
  float* tile = (float*)lds;
  for (int t = bid; t < 2464; t += nb) {
    if (t < 1440) transpose_tile(p.w_in, 5648, (bf16_t*)(p.ws + WS_WIN), 1024, (t / 16) * 64, (t % 16) * 64, true, tile);
    else if (t < 1568) { const int u = t - 1440; transpose_tile(p.fox_w_o, 1024, (bf16_t*)(p.ws + WS_WFO), 512, (u / 8) * 64, (u % 8) * 64, false, tile); }
    else if (t < 1696) { const int u = t - 1568; transpose_tile(p.gdn_w_o, 1024, (bf16_t*)(p.ws + WS_WGO), 512, (u / 8) * 64, (u % 8) * 64, false, tile); }
    else if (t < 1952) { const int u = t - 1696; transpose_tile(p.w_out, 1024, (bf16_t*)(p.ws + WS_WOUT), 1024, (u / 16) * 64, (u % 16) * 64, false, tile); }
    else { const int u = t - 1952; transpose_tile(p.peer_w_query, 2048, (bf16_t*)(p.ws + WS_WQ), 1024, (u / 16) * 64, (u % 16) * 64, false, tile); }
  }
  bf16_t* kd = (bf16_t*)(p.ws + WS_KEYS);
  for (int i = bid * NT + tidx(); i < 32768; i += nb * NT) kd[i] = f2bf(i < 16384 ? p.peer_keys1[i] : p.peer_keys2[i - 16384]);
}
DI unsigned pk4_fp8(float a, float b, float c, float d) { int w = 0; w = __builtin_amdgcn_cvt_pk_fp8_f32(a, b, w, false); w = __builtin_amdgcn_cvt_pk_fp8_f32(c, d, w, true); return (unsigned)w; }
DI void phase_tabconv(const Params& p, int bid, int nb) {
  const int lane = tidx() & 63, gw = bid * 4 + (tidx() >> 6), nw = nb * 4;
  for (int r0 = gw * 4; r0 < 32768; r0 += nw * 4) {
    f32x4 v[4][4];
#pragma unroll
    for (int k = 0; k < 4; ++k) { const int r = r0 + k; const float* src = ((r >= 16384) ? p.peer_v : p.peer_u) + (size_t)(r & 16383) * 1024 + 16 * lane;
#pragma unroll
      for (int i = 0; i < 4; ++i) v[k][i] = *(const f32x4*)(src + 4 * i); }
#pragma unroll
    for (int k = 0; k < 4; ++k) {
      const int r = r0 + k; const bool second = r >= 16384; const int e = r & 16383;
      float am = 0.f;
#pragma unroll
      for (int i = 0; i < 4; ++i) am = fmaxf(am, fmaxf(fmaxf(fabsf(v[k][i][0]), fabsf(v[k][i][1])), fmaxf(fabsf(v[k][i][2]), fabsf(v[k][i][3]))));
#pragma unroll
      for (int d = 32; d >= 1; d >>= 1) am = fmaxf(am, __shfl_xor(am, d));
      float sc = 1.f, inv = 1.f;
      if (am > 1e-30f) { const int ex = (int)floorf(log2f(448.f / am)); sc = exp2f((float)ex); inv = exp2f((float)-ex); }
      u32x4 o;
#pragma unroll
      for (int i = 0; i < 4; ++i) o[i] = pk4_fp8(v[k][i][0] * sc, v[k][i][1] * sc, v[k][i][2] * sc, v[k][i][3] * sc);
      *(u32x4*)(p.ws + (second ? WS_PV : WS_PU) + ((size_t)(lane >> 3) * 16384 + e) * 128 + 16 * (lane & 7)) = o;
      if (lane == 0) ((float*)(p.ws + (second ? WS_VINV : WS_UINV)))[e] = inv;
    }
  }
}

DI void phase_xnorm(const Params& p, int bid, int nb) {
  const int lane = tidx() & 63, gw = bid * 4 + (tidx() >> 6), nw = nb * 4;
  const float* mod = (const float*)(p.ws + WS_MOD);
  bf16_t* h = (bf16_t*)(p.ws + WS_H);
  for (int row0 = gw * 4; row0 < T_; row0 += nw * 4) {
    const int b = row0 >> 13;
    f32x4 v[4][4];
#pragma unroll
    for (int r = 0; r < 4; ++r)
#pragma unroll
      for (int i = 0; i < 4; ++i) v[r][i] = ((const f32x4*)(p.x + (size_t)(row0 + r) * 1024))[lane + 64 * i];
    f32x4 g4[4], sh[4], sc[4];
#pragma unroll
    for (int i = 0; i < 4; ++i) { const int col = 4 * lane + 256 * i; g4[i] = *(const f32x4*)(p.g_pre_mix + col); sh[i] = *(const f32x4*)(mod + b * 6144 + col); sc[i] = *(const f32x4*)(mod + b * 6144 + 1024 + col); }
#pragma unroll
    for (int r = 0; r < 4; ++r) {
      float ss = 0.f;
#pragma unroll
      for (int i = 0; i < 4; ++i) ss += v[r][i][0] * v[r][i][0] + v[r][i][1] * v[r][i][1] + v[r][i][2] * v[r][i][2] + v[r][i][3] * v[r][i][3];
      ss = wave_sum(ss);
      const float rstd = rsqrtf(ss * (1.f / 1024.f) + 1e-6f);
#pragma unroll
      for (int i = 0; i < 4; ++i) {
        const f32x4 y = (v[r][i] * rstd * g4[i]) * (1.f + sc[i]) + sh[i];
        u32x2 o = {pk2(y[0], y[1]), pk2(y[2], y[3])};
        *(u32x2*)(h + (size_t)(row0 + r) * 1024 + 4 * lane + 256 * i) = o;
      }
    }
  }
}

struct GemmArgs { const bf16_t* A; int lda; const bf16_t* Bt; int ldb; int K; };
DI int swz(int row, int c) { return row * 128 + ((c ^ ((row >> 1) & 7)) << 4); }
DI int gsw(int r) { return (0x78 >> (2 * ((r >> 2) & 3))) & 3; }
DI int gswz(int row, int c) { return row * 64 + ((c ^ gsw(row)) << 4); }
template <class Epi>
DI void gemm_tile(const GemmArgs& g, int m0, int n0, char* lds, const Epi& epi) {
  const int tid = tidx(), lane = tid & 63, wid = tid >> 6, wr = wid >> 1, wc = wid & 1, fr = lane & 15, fq = lane >> 4;
  f32x4 acc[8][4];
#pragma unroll
  for (int i = 0; i < 8; ++i)
#pragma unroll
    for (int j = 0; j < 4; ++j) acc[i][j] = (f32x4){0.f, 0.f, 0.f, 0.f};
  const int prow = lane >> 2, pch = (lane & 3) ^ gsw(lane >> 2);
  const bf16_t* ag = g.A + (size_t)(m0 + 64 * wid + prow) * g.lda + 8 * pch;
  const bf16_t* bgp[2];
#pragma unroll
  for (int i = 0; i < 2; ++i) { const int rho = 16 * i + prow; bgp[i] = g.Bt + (size_t)(n0 + 32 * wid + 8 * ((rho & 15) >> 2) + 4 * (rho >> 4) + (rho & 3)) * g.ldb + 8 * pch; }
  const size_t a16 = (size_t)16 * g.lda;
#define GT_ISSUE(kt, st) do { _Pragma("unroll") for (int i = 0; i < 4; ++i) \
      __builtin_amdgcn_global_load_lds((const unsigned*)(ag + i * a16 + (kt) * 32), (LAS unsigned*)(lds + (st) * 24576 + (4 * wid + i) * 1024), 16, 0, 0); \
    _Pragma("unroll") for (int i = 0; i < 2; ++i) \
      __builtin_amdgcn_global_load_lds((const unsigned*)(bgp[i] + (kt) * 32), (LAS unsigned*)(lds + (st) * 24576 + 16384 + (2 * wid + i) * 1024), 16, 0, 0); } while (0)
  const int nk = g.K / 32;
  __syncthreads();
  GT_ISSUE(0, 0); GT_ISSUE(1, 1);
  int st = 0;
#pragma unroll 1
  for (int kt = 0; kt < nk; ++kt) {
    if (kt + 1 < nk) asm volatile("s_waitcnt vmcnt(6)" ::: "memory"); else asm volatile("s_waitcnt vmcnt(0)" ::: "memory");
    __builtin_amdgcn_s_barrier();
    asm volatile("" ::: "memory");
    if (kt + 2 < nk) { const int s2 = st >= 1 ? st - 1 : 2; GT_ISSUE(kt + 2, s2); }
    const char* As = lds + st * 24576; const char* Bs = As + 16384;
    bf16x8 af[8], bfm[4];
#pragma unroll
    for (int i = 0; i < 8; ++i) af[i] = *(const bf16x8*)(As + gswz(wr * 128 + i * 16 + fr, fq));
#pragma unroll
    for (int j = 0; j < 4; ++j) bfm[j] = *(const bf16x8*)(Bs + gswz(wc * 64 + j * 16 + fr, fq));
#pragma unroll
    for (int i = 0; i < 8; ++i)
#pragma unroll
      for (int j = 0; j < 4; ++j) acc[i][j] = MFMA16(bfm[j], af[i], acc[i][j]);
    asm volatile("s_waitcnt lgkmcnt(0)" ::: "memory");
    st = st == 2 ? 0 : st + 1;
  }
#undef GT_ISSUE
#pragma unroll
  for (int i = 0; i < 8; ++i)
#pragma unroll
    for (int jj = 0; jj < 2; ++jj) epi(m0 + wr * 128 + i * 16 + fr, n0 + wc * 64 + jj * 32 + 8 * fq, acc[i][2 * jj], acc[i][2 * jj + 1]);
}

struct TileMap {
  int x, r, R, Nt, ngroups, L;
  DI void init(int bid, int nb, int Nt_) { x = bid & 7; r = bid >> 3; R = nb >> 3; Nt = Nt_; ngroups = (Nt_ + 7) >> 3; L = r; }
  DI bool next(int& m, int& n) {
    for (;;) {
      if (L >= 128 * ngroups) return false;
      const int ng = L >> 7, rem = L & 127, mg = rem >> 6, ni = (rem & 63) >> 3, mi = rem & 7;
      L += R;
      m = 16 * x + 8 * mg + mi; n = 8 * ng + ni;
      if (n < Nt) return true;
    }
  }
};
struct EpiInproj {
  bf16_t* proj; float* small; const float *bbg, *b_fgate, *a_log, *dt_bias;
  DI void operator()(int row, int col, f32x4 v, f32x4 w) const {
    if (col < 3584) { u32x4 o = {pk2(v[0], v[1]), pk2(v[2], v[3]), pk2(w[0], w[1]), pk2(w[2], w[3])}; *(u32x4*)(proj + (size_t)row * PP + col) = o; }
    else if (col < 5632) {
      const f32x4 b = *(const f32x4*)(bbg + (col - 3584)), c = *(const f32x4*)(bbg + (col - 3584) + 4);
      u32x4 o = {pk2(sigmoidf_(v[0] + b[0]), sigmoidf_(v[1] + b[1])), pk2(sigmoidf_(v[2] + b[2]), sigmoidf_(v[3] + b[3])),
                 pk2(sigmoidf_(w[0] + c[0]), sigmoidf_(w[1] + c[1])), pk2(sigmoidf_(w[2] + c[2]), sigmoidf_(w[3] + c[3]))};
      *(u32x4*)(proj + (size_t)row * PP + col) = o;
    } else if (col < 5648) {
      const int j0 = col - 5632;
#pragma unroll
      for (int e = 0; e < 8; ++e) { const int j = j0 + e; const float x = e < 4 ? v[e & 3] : w[e & 3]; float r;
        if (j < 8) r = -softplusf_(-(x + b_fgate[j]));
        else if (j < 12) r = sigmoidf_(x);
        else r = -__expf(a_log[j - 12]) * softplusf_(x + dt_bias[j - 12]);
        small[(size_t)row * 16 + j] = r; }
    }
  }
};
DI void phase_inproj(const Params& p, int bid, int nb, char* lds) {
  GemmArgs g = {(const bf16_t*)(p.ws + WS_H), 1024, (const bf16_t*)(p.ws + WS_WIN), 1024, 1024};
  EpiInproj e = {(bf16_t*)(p.ws + WS_P), (float*)(p.ws + WS_SMALL), p.b_branch_gate, p.b_fgate, p.a_log, p.dt_bias};
  TileMap tm; tm.init(bid, nb, 45); int m, n; while (tm.next(m, n)) gemm_tile(g, m * 256, n * 128, lds, e);
}

DI void phase_foxcum(const Params& p, int bid, int nb, char* lds) {
  float* tot = (float*)lds;
  const float* small = (const float*)(p.ws + WS_SMALL);
  float* fneg = (float*)(p.ws + WS_FNEG);
  const int tid = tidx();
  for (int bh = bid; bh < 32; bh += nb) {
    const int b = bh >> 3, h = bh & 7;
    float v[32]; float run = 0.f;
#pragma unroll
    for (int i = 0; i < 32; ++i) { run += small[((size_t)b * S_ + tid * 32 + i) * 16 + h]; v[i] = run; }
    tot[tid] = run; __syncthreads();
    float off = 0.f; for (int j = 0; j < tid; ++j) off += tot[j];
#pragma unroll
    for (int i = 0; i < 32; ++i) fneg[(size_t)bh * S_ + tid * 32 + i] = -(v[i] + off) * LOG2E;
    __syncthreads();
  }
}
DI void phase_qknorm(const Params& p, int bid, int nb) {
  const int lane = tidx() & 63, gw = bid * 4 + (tidx() >> 6), nw = nb * 4;
  const bf16_t* proj = (const bf16_t*)(p.ws + WS_P);
  unsigned* qk = (unsigned*)(p.ws + WS_CTL) + 64;
  for (int it = gw; it < 4096; it += nw) {
    const int bh = it >> 7, j = it & 127, b = bh >> 3, h = bh & 7;
    const bf16_t* rp = proj + ((size_t)b * S_ + j * 64 + lane) * PP + h * 64;
    float sq = 0.f, sk = 0.f;
#pragma unroll
    for (int q = 0; q < 8; ++q) { const u32x4 wq = *(const u32x4*)(rp + 8 * q), wk = *(const u32x4*)(rp + 512 + 8 * q);
#pragma unroll
      for (int e = 0; e < 4; ++e) { const float a0 = bflo(wq[e]), a1 = bfhi(wq[e]), c0 = bflo(wk[e]), c1 = bfhi(wk[e]); sq += a0 * a0 + a1 * a1; sk += c0 * c0 + c1 * c1; } }
#pragma unroll
    for (int d = 32; d >= 1; d >>= 1) { sq = fmaxf(sq, __shfl_xor(sq, d)); sk = fmaxf(sk, __shfl_xor(sk, d)); }
    if (lane == 0) { atomicMax(qk + 2 * bh, __float_as_uint(sq)); atomicMax(qk + 2 * bh + 1, __float_as_uint(sk)); }
  }
}

DI int swzv(int row, int c) { return row * 128 + ((c ^ (((row >> 1) & 7) ^ ((row & 2) << 1))) << 4); }
DI void attn_unit(const Params& p, int bh, int qb, char* lds) {
  const int tid = tidx(), lane = tid & 63, wid = tid >> 6, r32 = lane & 31, hi = lane >> 5;
  const int b = bh >> 3, h = bh & 7;
  bf16_t* proj = (bf16_t*)(p.ws + WS_P);
  const float* fneg = (const float*)(p.ws + WS_FNEG) + (size_t)bh * S_;
  const size_t rowbase = (size_t)b * S_;
  char* Ks = lds; char* Vs = lds + 8192; float* Fs = (float*)(lds + 16384);
  const LAS char* Vs3 = (const LAS char*)Vs;
  const int qrow = qb * 128 + wid * 32 + r32;
  bf16_t* qptr = proj + (rowbase + qrow) * PP + h * 64;
  bf16x8 qr[4];
  {
    const float c2 = 0.125f * LOG2E;
#pragma unroll
    for (int ks = 0; ks < 4; ++ks) { const u32x4 w = *(const u32x4*)(qptr + ks * 16 + hi * 8);
      qr[ks] = pack8(bflo(w[0]) * c2, bfhi(w[0]) * c2, bflo(w[1]) * c2, bfhi(w[1]) * c2, bflo(w[2]) * c2, bfhi(w[2]) * c2, bflo(w[3]) * c2, bfhi(w[3]) * c2); }
  }
  f32x16 o0, o1;
#pragma unroll
  for (int r = 0; r < 16; ++r) { o0[r] = 0.f; o1[r] = 0.f; }
  float m = -1e30f, l = 0.f;
  const float qkmax = sqrtf(__uint_as_float(((const unsigned*)(p.ws + WS_CTL))[64 + 2 * bh])) * sqrtf(__uint_as_float(((const unsigned*)(p.ws + WS_CTL))[64 + 2 * bh + 1])) * (0.125f * LOG2E * 1.02f);
  int* flags = (int*)(lds + 16384 + 256);
  const int ntiles = 2 * qb + 2;
  const int srow = tid >> 3, sc = tid & 7;
  const bf16_t* kg = proj + (rowbase + srow) * PP + 512 + h * 64 + sc * 8;
  const bf16_t* vg = proj + (rowbase + srow) * PP + 1024 + h * 64 + sc * 8;
  u32x4 rk[2], rv[2]; f32x4 rf = {0.f, 0.f, 0.f, 0.f};
  {
    const int j0 = ntiles - 1;
#pragma unroll
    for (int i = 0; i < 2; ++i) { rk[i] = *(const u32x4*)(kg + (size_t)(j0 * 64 + 32 * i) * PP); rv[i] = *(const u32x4*)(vg + (size_t)(j0 * 64 + 32 * i) * PP); }
    if (tid < 16) rf = *(const f32x4*)(fneg + j0 * 64 + tid * 4);
  }
  if (tid < 8) flags[tid] = 0;
  const int wave_maxrow = qb * 128 + wid * 32 + 31;
  for (int j = ntiles - 1; j >= 0; --j) {
    __syncthreads();
#pragma unroll
    for (int i = 0; i < 2; ++i) { *(u32x4*)(Ks + swz(srow + 32 * i, sc)) = rk[i]; *(u32x4*)(Vs + swzv(srow + 32 * i, sc)) = rv[i]; }
    if (tid < 16) *(f32x4*)(Fs + tid * 4) = rf;
    __syncthreads();
    { const int* fl = flags + 4 * ((j + 1) & 1); if ((fl[0] & fl[1] & fl[2] & fl[3]) != 0) break; }
    float ubf = 0.f;
    if (j > 0) { ubf = fneg[j * 64 - 1]; }
    if (j > 0) {
#pragma unroll
      for (int i = 0; i < 2; ++i) { rk[i] = *(const u32x4*)(kg + (size_t)((j - 1) * 64 + 32 * i) * PP); rv[i] = *(const u32x4*)(vg + (size_t)((j - 1) * 64 + 32 * i) * PP); }
      if (tid < 16) rf = *(const f32x4*)(fneg + (j - 1) * 64 + tid * 4);
    }
    if (j * 64 <= wave_maxrow) {
    f32x16 p0, p1;
#pragma unroll
    for (int g = 0; g < 4; ++g) { const f32x4 a = *(const f32x4*)(Fs + 8 * g + 4 * hi), c = *(const f32x4*)(Fs + 32 + 8 * g + 4 * hi);
#pragma unroll
      for (int e = 0; e < 4; ++e) { p0[4 * g + e] = a[e]; p1[4 * g + e] = c[e]; } }
#pragma unroll
    for (int ks = 0; ks < 4; ++ks) {
      const bf16x8 k0 = *(const bf16x8*)(Ks + swz(r32, 2 * ks + hi)), k1 = *(const bf16x8*)(Ks + swz(32 + r32, 2 * ks + hi));
      p0 = MFMA32(k0, qr[ks], p0); p1 = MFMA32(k1, qr[ks], p1);
    }
    if (j >= 2 * qb) {
      const int kb = j * 64;
#pragma unroll
      for (int r = 0; r < 16; ++r) { const int kv = kb + crow(r, hi); if (kv > qrow) p0[r] = -INFINITY; if (kv + 32 > qrow) p1[r] = -INFINITY; }
    }
    float mx = fmaxf(p0[0], p1[0]);
#pragma unroll
    for (int r = 1; r < 16; ++r) mx = fmaxf(mx, fmaxf(p0[r], p1[r]));
    mx = fmaxf(mx, __shfl_xor(mx, 32));
    const float mn = fmaxf(m, mx), alpha = exp2f(m - mn); m = mn;
    float ps = 0.f;
#pragma unroll
    for (int r = 0; r < 16; ++r) { p0[r] = exp2f(p0[r] - mn); p1[r] = exp2f(p1[r] - mn); ps += p0[r] + p1[r]; }
    l = l * alpha + ps;
#pragma unroll
    for (int r = 0; r < 16; ++r) { o0[r] *= alpha; o1[r] *= alpha; }
    bf16x8 pf[2][2];
    pf[0][0] = pack8(p0[0], p0[1], p0[2], p0[3], p0[4], p0[5], p0[6], p0[7]);
    pf[0][1] = pack8(p0[8], p0[9], p0[10], p0[11], p0[12], p0[13], p0[14], p0[15]);
    pf[1][0] = pack8(p1[0], p1[1], p1[2], p1[3], p1[4], p1[5], p1[6], p1[7]);
    pf[1][1] = pack8(p1[8], p1[9], p1[10], p1[11], p1[12], p1[13], p1[14], p1[15]);
#pragma unroll
    for (int pb = 0; pb < 2; ++pb)
#pragma unroll
      for (int s = 0; s < 2; ++s) {
        const int rowa = 32 * pb + 16 * s + 4 * hi + ((lane & 15) >> 2);
#pragma unroll
        for (int d0 = 0; d0 < 2; ++d0) {
          const int cl = 4 * d0 + 2 * ((lane >> 4) & 1) + ((lane & 3) >> 1), sub = 8 * (lane & 1);
          const s16x4 lo = tr16(Vs3 + swzv(rowa, cl) + sub), hi4 = tr16(Vs3 + swzv(rowa + 8, cl) + sub);
          const bf16x8 vf = cat8(lo, hi4);
          if (d0 == 0) o0 = MFMA32(vf, pf[pb][s], o0); else o1 = MFMA32(vf, pf[pb][s], o1);
        }
      }
    }
    if (j > 0) {
      const float ub = qkmax + ubf + log2f((float)(j * 64));
      const int ok = __all((ub - m) <= -30.f);
      if (lane == 0) flags[4 * (j & 1) + wid] = ok;
    }
  }
  l += __shfl_xor(l, 32);
  const float inv = 1.f / l;
#pragma unroll
  for (int g = 0; g < 4; ++g) {
    u32x2 a = {pk2(o0[4 * g] * inv, o0[4 * g + 1] * inv), pk2(o0[4 * g + 2] * inv, o0[4 * g + 3] * inv)};
    u32x2 c = {pk2(o1[4 * g] * inv, o1[4 * g + 1] * inv), pk2(o1[4 * g + 2] * inv, o1[4 * g + 3] * inv)};
    *(u32x2*)(qptr + 8 * g + 4 * hi) = a; *(u32x2*)(qptr + 32 + 8 * g + 4 * hi) = c;
  }
}
DI void phase_attn(const Params& p, int bid, int nb, char* lds) {
  for (int u = bid; u < 2048; u += nb) attn_unit(p, u & 31, 63 - (u >> 5), lds);
}

constexpr int QP = 136;
DI void gdn_prep_unit(const Params& p, int U, char* lds) {
  const int tid = tidx(), lane = tid & 63, wid = tid >> 6, fr = lane & 15, fq = lane >> 4;
  const int b = U >> 9, h = (U >> 7) & 3, c = U & 127;
  const size_t t0 = (size_t)b * S_ + c * 64;
  const int s0 = c * 64;
  const bf16_t* proj = (const bf16_t*)(p.ws + WS_P);
  const float* small = (const float*)(p.ws + WS_SMALL);
  bf16_t* q_s = (bf16_t*)lds; bf16_t* k_s = q_s + 64 * QP; bf16_t* v_s = k_s + 64 * QP;
  float* Lm = (float*)(lds + 3 * 17408);
  bf16_t* T1 = (bf16_t*)Lm; bf16_t* T2 = T1 + 64 * 72;
  float* gcs = (float*)(lds + 3 * 17408 + 18432);
  bf16_t* QF = (bf16_t*)((char*)p.out) + (size_t)U * 8192;
  bf16_t* KF = (bf16_t*)((char*)p.out + 32 * MiB) + (size_t)U * 8192;
  bf16_t* AF = (bf16_t*)((char*)p.out + 64 * MiB) + (size_t)U * 4096;
  bf16_t* UF = (bf16_t*)(p.ws + WS_UF) + (size_t)U * 8192;
  bf16_t* WF = (bf16_t*)(p.ws + WS_WF) + (size_t)U * 8192;
  __syncthreads();
  if (wid == 0) {
    const float g = small[(t0 + lane) * 16 + 12 + h], bt = small[(t0 + lane) * 16 + 8 + h];
    float cs = g;
#pragma unroll
    for (int d = 1; d < 64; d <<= 1) { const float n = __shfl_up(cs, d); if (lane >= d) cs += n; }
    const float gl = __shfl(cs, 63);
    gcs[lane] = cs; gcs[64 + lane] = bt; gcs[128 + lane] = __expf(cs); gcs[192 + lane] = __expf(gl - cs);
    if (lane == 0) { gcs[256] = __expf(gl); ((float*)(p.ws + WS_GL))[U] = __expf(gl); }
  }
  __syncthreads();
  {
#pragma unroll
    for (int X = 0; X < 3; ++X) {
      const int col = 1536 + 512 * X + h * 128 + 2 * lane, cb = 512 * X + h * 128 + 2 * lane;
      float w0[4], w1[4];
#pragma unroll
      for (int j = 0; j < 4; ++j) { w0[j] = p.conv_w[j * 1536 + cb]; w1[j] = p.conv_w[j * 1536 + cb + 1]; }
      bf16_t* dst = X == 0 ? q_s : (X == 1 ? k_s : v_s);
      const int i0 = 16 * wid;
      unsigned raw[19];
      {
        const bf16_t* sb = proj + ((long)t0 - 3) * PP;
        unsigned vo[19];
#pragma unroll
        for (int j = 0; j < 19; ++j) { const int rr = i0 - 3 + j; const int rc = (s0 + rr >= 0) ? rr : -s0; vo[j] = (unsigned)(((rc + 3) * PP + col) * 2); }
        asm volatile("global_load_dword %0, %10, %20\n\tglobal_load_dword %1, %11, %20\n\tglobal_load_dword %2, %12, %20\n\tglobal_load_dword %3, %13, %20\n\tglobal_load_dword %4, %14, %20\n\t"
                     "global_load_dword %5, %15, %20\n\tglobal_load_dword %6, %16, %20\n\tglobal_load_dword %7, %17, %20\n\tglobal_load_dword %8, %18, %20\n\tglobal_load_dword %9, %19, %20\n\ts_waitcnt vmcnt(0)"
                     : "=&v"(raw[0]), "=&v"(raw[1]), "=&v"(raw[2]), "=&v"(raw[3]), "=&v"(raw[4]), "=&v"(raw[5]), "=&v"(raw[6]), "=&v"(raw[7]), "=&v"(raw[8]), "=&v"(raw[9])
                     : "v"(vo[0]), "v"(vo[1]), "v"(vo[2]), "v"(vo[3]), "v"(vo[4]), "v"(vo[5]), "v"(vo[6]), "v"(vo[7]), "v"(vo[8]), "v"(vo[9]), "s"(sb) : "memory");
        asm volatile("global_load_dword %0, %9, %18\n\tglobal_load_dword %1, %10, %18\n\tglobal_load_dword %2, %11, %18\n\tglobal_load_dword %3, %12, %18\n\tglobal_load_dword %4, %13, %18\n\t"
                     "global_load_dword %5, %14, %18\n\tglobal_load_dword %6, %15, %18\n\tglobal_load_dword %7, %16, %18\n\tglobal_load_dword %8, %17, %18\n\ts_waitcnt vmcnt(0)"
                     : "=&v"(raw[10]), "=&v"(raw[11]), "=&v"(raw[12]), "=&v"(raw[13]), "=&v"(raw[14]), "=&v"(raw[15]), "=&v"(raw[16]), "=&v"(raw[17]), "=&v"(raw[18])
                     : "v"(vo[10]), "v"(vo[11]), "v"(vo[12]), "v"(vo[13]), "v"(vo[14]), "v"(vo[15]), "v"(vo[16]), "v"(vo[17]), "v"(vo[18]), "s"(sb) : "memory");
#pragma unroll
        for (int j = 0; j < 3; ++j) if (s0 + i0 - 3 + j < 0) raw[j] = 0u;
      }
      float y0[16], y1[16], ssr[16];
#pragma unroll
      for (int ii = 0; ii < 16; ++ii) {
        float a0 = w0[0] * bflo(raw[ii]) + w0[1] * bflo(raw[ii + 1]) + w0[2] * bflo(raw[ii + 2]) + w0[3] * bflo(raw[ii + 3]);
        float a1 = w1[0] * bfhi(raw[ii]) + w1[1] * bfhi(raw[ii + 1]) + w1[2] * bfhi(raw[ii + 2]) + w1[3] * bfhi(raw[ii + 3]);
        a0 = a0 * sigmoidf_(a0); a1 = a1 * sigmoidf_(a1);
        y0[ii] = a0; y1[ii] = a1; ssr[ii] = a0 * a0 + a1 * a1;
      }
      if (X < 2) {
#pragma unroll
        for (int d = 32; d >= 1; d >>= 1)
#pragma unroll
          for (int ii = 0; ii < 16; ++ii) ssr[ii] += __shfl_xor(ssr[ii], d);
      }
#pragma unroll
      for (int ii = 0; ii < 16; ++ii) {
        const int i = i0 + ii;
        float a0 = y0[ii], a1 = y1[ii];
        if (X < 2) { const float rn = rsqrtf(ssr[ii] + 1e-6f); a0 *= rn; a1 *= rn; }
        *(unsigned*)(dst + i * QP + 2 * lane) = pk2(a0, a1);
        if (X == 0) {
          const float f = 0.08838834764831845f * gcs[128 + i];
          const int d = 2 * lane, mm = d >> 5, ss2 = (d >> 4) & 1, aa = (d >> 3) & 1, hh = (d >> 2) & 1, bb = d & 3;
          const int lp = (i & 31) + 32 * hh;
          *(unsigned*)(QF + (size_t)(((((i >> 5) * 4 + mm) * 2 + ss2) * 64 + lp) * 8 + 4 * aa + bb)) = pk2(a0 * f, a1 * f);
        }
      }
    }
  }
  __syncthreads();
  {
    bf16x8 ka[4];
#pragma unroll
    for (int kk = 0; kk < 4; ++kk) ka[kk] = *(const bf16x8*)(k_s + (16 * wid + fr) * QP + kk * 32 + fq * 8);
#pragma unroll
    for (int ni = 0; ni < 4; ++ni) {
      f32x4 dkk = {0.f, 0.f, 0.f, 0.f}, dqk = {0.f, 0.f, 0.f, 0.f};
      const int i = 16 * ni + fr, jj0 = 16 * wid + 4 * fq;
      if (ni >= wid) {
#pragma unroll
        for (int kk = 0; kk < 4; ++kk) {
          const bf16x8 bk = *(const bf16x8*)(k_s + (16 * ni + fr) * QP + kk * 32 + fq * 8), bq = *(const bf16x8*)(q_s + (16 * ni + fr) * QP + kk * 32 + fq * 8);
          dkk = MFMA16(ka[kk], bk, dkk); dqk = MFMA16(ka[kk], bq, dqk);
        }
      }
      const float gi = gcs[i], bi = gcs[64 + i];
      f32x4 lv, av;
#pragma unroll
      for (int r = 0; r < 4; ++r) { const int jj = jj0 + r; const float dec = __expf(fminf(gi - gcs[jj], 0.f));
        lv[r] = (jj < i) ? bi * dkk[r] * dec : 0.f; av[r] = (jj <= i) ? dqk[r] * 0.08838834764831845f * dec : 0.f; }
      *(f32x4*)(Lm + i * 68 + jj0) = lv;
      const int lp = (i & 31) + 32 * (fq & 1);
      u32x2 o = {pk2(av[0], av[1]), pk2(av[2], av[3])};
      *(u32x2*)(AF + (size_t)((((((i >> 5) * 2 + (wid >> 1)) * 2 + (wid & 1)) * 64 + lp) * 8) + 4 * (fq >> 1))) = o;
    }
    for (int it = tid; it < 2048; it += NT) {
      const int d = it & 127, jg = it >> 7;
      float v4[4];
#pragma unroll
      for (int e = 0; e < 4; ++e) { const int jj = 4 * jg + e; v4[e] = bf2f(k_s[jj * QP + d]) * gcs[192 + jj]; }
      const int lp = (d & 31) + 32 * (jg & 1);
      u32x2 o = {pk2(v4[0], v4[1]), pk2(v4[2], v4[3])};
      *(u32x2*)(KF + (size_t)((((((d >> 5) * 2 + (jg >> 3)) * 2 + ((jg >> 2) & 1)) * 64 + lp) * 8) + 4 * ((jg >> 1) & 1))) = o;
    }
  }
  __syncthreads();
  {
    float* Ts = (float*)q_s;
    if (wid < 2 && lane < 32) {
      const int o = 32 * wid;
      for (int i = 0; i < 32; ++i) {
        float a0 = (lane == i) ? 1.f : 0.f, a1 = 0.f, a2 = 0.f, a3 = 0.f;
        const float* Li = Lm + (o + i) * 68 + o;
        int j = 0;
#pragma unroll 4
        for (; j + 4 <= i; j += 4) {
          const f32x4 Lv = *(const f32x4*)(Li + j);
          a0 -= Lv[0] * Ts[(o + j) * 64 + o + lane]; a1 -= Lv[1] * Ts[(o + j + 1) * 64 + o + lane]; a2 -= Lv[2] * Ts[(o + j + 2) * 64 + o + lane]; a3 -= Lv[3] * Ts[(o + j + 3) * 64 + o + lane];
        }
        for (; j < i; ++j) a0 -= Li[j] * Ts[(o + j) * 64 + o + lane];
        Ts[(o + i) * 64 + o + lane] = (a0 + a1) + (a2 + a3);
      }
    }
    __syncthreads();
    const int cc = tid & 31, ig = tid >> 5;
    {
      float x0 = 0.f, x1 = 0.f, x2 = 0.f, x3 = 0.f;
#pragma unroll 8
      for (int j = 0; j < 32; ++j) { const float tj = Ts[j * 64 + cc];
        x0 += Lm[(32 + 4 * ig) * 68 + j] * tj; x1 += Lm[(33 + 4 * ig) * 68 + j] * tj; x2 += Lm[(34 + 4 * ig) * 68 + j] * tj; x3 += Lm[(35 + 4 * ig) * 68 + j] * tj; }
      Ts[(4 * ig) * 64 + 32 + cc] = x0; Ts[(4 * ig + 1) * 64 + 32 + cc] = x1; Ts[(4 * ig + 2) * 64 + 32 + cc] = x2; Ts[(4 * ig + 3) * 64 + 32 + cc] = x3;
    }
    __syncthreads();
    {
      float x0 = 0.f, x1 = 0.f, x2 = 0.f, x3 = 0.f;
#pragma unroll 8
      for (int j = 0; j < 32; ++j) { const float xj = Ts[j * 64 + 32 + cc];
        x0 -= Ts[(32 + 4 * ig) * 64 + 32 + j] * xj; x1 -= Ts[(33 + 4 * ig) * 64 + 32 + j] * xj; x2 -= Ts[(34 + 4 * ig) * 64 + 32 + j] * xj; x3 -= Ts[(35 + 4 * ig) * 64 + 32 + j] * xj; }
      Ts[(32 + 4 * ig) * 64 + cc] = x0; Ts[(33 + 4 * ig) * 64 + cc] = x1; Ts[(34 + 4 * ig) * 64 + cc] = x2; Ts[(35 + 4 * ig) * 64 + cc] = x3;
    }
    __syncthreads();
    {
      const int c = tid & 63, rg = tid >> 6;
      const float f1 = gcs[64 + c], f2 = f1 * gcs[128 + c];
      asm volatile("" ::: "memory");
      for (int i = 16 * rg; i < 16 * rg + 16; ++i) { const float t = (i < 32 && c >= 32) ? 0.f : Ts[i * 64 + c]; T1[i * 72 + c] = f2bf(t * f1); T2[i * 72 + c] = f2bf(t * f2); }
    }
  }
  __syncthreads();
  {
    const LAS char* v3 = (const LAS char*)v_s; const LAS char* k3 = (const LAS char*)k_s;
    bf16x8 ta[2], tb[2];
#pragma unroll
    for (int kk = 0; kk < 2; ++kk) { ta[kk] = *(const bf16x8*)(T1 + (16 * wid + fr) * 72 + kk * 32 + fq * 8); tb[kk] = *(const bf16x8*)(T2 + (16 * wid + fr) * 72 + kk * 32 + fq * 8); }
#pragma unroll
    for (int nj = 0; nj < 8; ++nj) {
      f32x4 du = {0.f, 0.f, 0.f, 0.f}, dw = {0.f, 0.f, 0.f, 0.f};
#pragma unroll
      for (int kk = 0; kk < 2; ++kk) {
        const int jr = 32 * kk + 8 * fq + ((lane & 15) >> 2), cc = 16 * nj + 4 * (lane & 3);
        const bf16x8 vb = cat8(tr16(v3 + (jr * QP + cc) * 2), tr16(v3 + ((jr + 4) * QP + cc) * 2));
        const bf16x8 kb = cat8(tr16(k3 + (jr * QP + cc) * 2), tr16(k3 + ((jr + 4) * QP + cc) * 2));
        du = MFMA16(ta[kk], vb, du);
        dw = MFMA16(kb, tb[kk], dw);
      }
      {
        const int lp = 16 * (nj & 1) + fr + 32 * (fq & 1);
        u32x2 o = {pk2(du[0], du[1]), pk2(du[2], du[3])};
        *(u32x2*)(UF + (size_t)(((((wid >> 1) * 4 + (nj >> 1)) * 64 + lp) * 16) + 4 * (2 * (wid & 1) + (fq >> 1)))) = o;
      }
      {
        const int lp = 16 * (wid & 1) + fr + 32 * (fq & 1);
        u32x2 o = {pk2(-dw[0], -dw[1]), pk2(-dw[2], -dw[3])};
        *(u32x2*)(WF + (size_t)((((((wid >> 1) * 4 + (nj >> 1)) * 2 + (nj & 1)) * 64 + lp) * 8) + 4 * (fq >> 1))) = o;
      }
    }
  }
}
DI void phase_gdnprep(const Params& p, int bid, int nb, char* lds) {
  for (int U = bid; U < 2048; U += nb) gdn_prep_unit(p, U, lds);
}

DI bf16x8 packS(const f32x16& x, int s) { return pack8(x[8 * s], x[8 * s + 1], x[8 * s + 2], x[8 * s + 3], x[8 * s + 4], x[8 * s + 5], x[8 * s + 6], x[8 * s + 7]); }
DI void gdn_scan_seq(const Params& p, int bh16, char* lds) {
  const int tid = tidx(), lane = tid & 63, wv = tid >> 6;
  const float* glp = (const float*)(p.ws + WS_GL) + bh16 * 128;
  const char* wf = (const char*)(p.ws + WS_WF) + (size_t)bh16 * 128 * 16384 + tid * 16;
  const char* kf = (const char*)p.out + 32 * MiB + (size_t)bh16 * 128 * 16384 + tid * 16;
  const char* uf = (const char*)(p.ws + WS_UF) + (size_t)bh16 * 128 * 16384 + (size_t)(wv * 64 + lane) * 32;
  char* scp = p.ws + WS_SC + (size_t)bh16 * 128 * 32768 + (size_t)wv * 8192 + lane * 16;
#define SCAN_DMA(gsrc, ldsoff) __builtin_amdgcn_global_load_lds((const unsigned*)(gsrc), (LAS unsigned*)(lds + (ldsoff) + wv * 1024), 16, 0, 0)
#define SCAN_WK(c, slot) do { _Pragma("unroll") for (int i = 0; i < 4; ++i) { SCAN_DMA(wf + (size_t)(c) * 16384 + i * 4096, (slot) * 32768 + i * 4096); SCAN_DMA(kf + (size_t)(c) * 16384 + i * 4096, (slot) * 32768 + 16384 + i * 4096); } } while (0)
#define SCAN_U(c) do { _Pragma("unroll") for (int i2 = 0; i2 < 2; ++i2) { un[2 * i2] = *(const u32x4*)(uf + (size_t)(c) * 16384 + i2 * 8192); un[2 * i2 + 1] = *(const u32x4*)(uf + (size_t)(c) * 16384 + i2 * 8192 + 16); } gln = glp[c]; } while (0)
  f32x16 S[4];
#pragma unroll
  for (int m = 0; m < 4; ++m)
#pragma unroll
    for (int r = 0; r < 16; ++r) S[m][r] = 0.f;
  u32x4 un[4]; float gln;
  __syncthreads();
  SCAN_WK(0, 0); SCAN_U(0);
#pragma unroll 1
  for (int c = 0; c < 128; ++c) {
    __syncthreads();
    f32x16 vn[2];
#pragma unroll
    for (int i2 = 0; i2 < 2; ++i2) {
#pragma unroll
      for (int e = 0; e < 4; ++e) { vn[i2][2 * e] = bflo(un[2 * i2][e]); vn[i2][2 * e + 1] = bfhi(un[2 * i2][e]); vn[i2][8 + 2 * e] = bflo(un[2 * i2 + 1][e]); vn[i2][8 + 2 * e + 1] = bfhi(un[2 * i2 + 1][e]); }
    }
    const float gl = gln;
    asm volatile("" : "+v"(vn[0]), "+v"(vn[1]));
    __builtin_amdgcn_sched_barrier(0);
    if (c + 1 < 128) { SCAN_WK(c + 1, (c + 1) & 1); SCAN_U(c + 1); }
    const char* lw = lds + (c & 1) * 32768 + lane * 16; const char* lk = lw + 16384;
    char* sco = scp + (size_t)c * 32768;
    bf16x8 Sb[4][2];
#pragma unroll
    for (int m = 0; m < 4; ++m) { Sb[m][0] = packS(S[m], 0); Sb[m][1] = packS(S[m], 1); *(bf16x8*)(sco + (m * 2 + 0) * 1024) = Sb[m][0]; *(bf16x8*)(sco + (m * 2 + 1) * 1024) = Sb[m][1]; }
#pragma unroll
    for (int mh = 0; mh < 2; ++mh) {
      bf16x8 f[8];
#pragma unroll
      for (int k = 0; k < 8; ++k) { const int i2 = k >> 2, m = 2 * mh + ((k >> 1) & 1), sx = k & 1; f[k] = *(const bf16x8*)(lw + ((i2 * 4 + m) * 2 + sx) * 1024); }
      __builtin_amdgcn_sched_barrier(0);
#pragma unroll
      for (int q = 0; q < 4; ++q) { const int m = 2 * mh + (q >> 1), sx = q & 1;
        vn[0] = MFMA32(f[q], Sb[m][sx], vn[0]); vn[1] = MFMA32(f[4 + q], Sb[m][sx], vn[1]); }
    }
    bf16x8 Vb[2][2];
#pragma unroll
    for (int j2 = 0; j2 < 2; ++j2) { Vb[j2][0] = packS(vn[j2], 0); Vb[j2][1] = packS(vn[j2], 1); }
#pragma unroll
    for (int m = 0; m < 4; ++m)
#pragma unroll
      for (int r = 0; r < 16; ++r) S[m][r] *= gl;
#pragma unroll
    for (int mh = 0; mh < 2; ++mh) {
      bf16x8 f[8];
#pragma unroll
      for (int k = 0; k < 8; ++k) { const int m = 2 * mh + (k >> 2), j2 = (k >> 1) & 1, sx = k & 1; f[k] = *(const bf16x8*)(lk + ((m * 2 + j2) * 2 + sx) * 1024); }
      __builtin_amdgcn_sched_barrier(0);
#pragma unroll
      for (int q = 0; q < 4; ++q) { const int j2 = q >> 1, sx = q & 1;
        S[2 * mh] = MFMA32(f[q], Vb[j2][sx], S[2 * mh]); S[2 * mh + 1] = MFMA32(f[4 + q], Vb[j2][sx], S[2 * mh + 1]); }
    }
  }
#undef SCAN_DMA
#undef SCAN_WK
#undef SCAN_U
  __syncthreads();
}
DI void gdn_out_unit(const Params& p, int U, char* lds) {
  const int tid = tidx(), lane = tid & 63, wv = tid >> 6, r32 = lane & 31, hi = lane >> 5;
  const int b = U >> 9, h = (U >> 7) & 3, c = U & 127;
  bf16_t* proj = (bf16_t*)(p.ws + WS_P);
  const char* wfg = (const char*)(p.ws + WS_WF) + (size_t)U * 16384 + lane * 16;
  const char* qfg = (const char*)p.out + (size_t)U * 16384 + lane * 16;
  const char* afg = (const char*)p.out + 64 * MiB + (size_t)U * 8192 + lane * 16;
  const bf16_t* UF = (const bf16_t*)(p.ws + WS_UF) + (size_t)U * 8192;
  const bf16x8* SC = (const bf16x8*)(p.ws + WS_SC + (size_t)U * 32768 + (size_t)wv * 8192) + lane;
  bf16_t* ol = (bf16_t*)(lds + 40960);
  __syncthreads();
#pragma unroll
  for (int i = 0; i < 4; ++i) {
    __builtin_amdgcn_global_load_lds((const unsigned*)(wfg + (4 * wv + i) * 1024), (LAS unsigned*)(lds + (4 * wv + i) * 1024), 16, 0, 0);
    __builtin_amdgcn_global_load_lds((const unsigned*)(qfg + (4 * wv + i) * 1024), (LAS unsigned*)(lds + 16384 + (4 * wv + i) * 1024), 16, 0, 0);
  }
#pragma unroll
  for (int i = 0; i < 2; ++i) __builtin_amdgcn_global_load_lds((const unsigned*)(afg + (2 * wv + i) * 1024), (LAS unsigned*)(lds + 32768 + (2 * wv + i) * 1024), 16, 0, 0);
  bf16x8 Sb[4][2];
#pragma unroll
  for (int m = 0; m < 4; ++m) { Sb[m][0] = SC[(m * 2 + 0) * 64]; Sb[m][1] = SC[(m * 2 + 1) * 64]; }
  u32x4 uu[4];
#pragma unroll
  for (int i2 = 0; i2 < 2; ++i2) { uu[2 * i2] = *(const u32x4*)(UF + (size_t)((i2 * 4 + wv) * 64 + lane) * 16); uu[2 * i2 + 1] = *(const u32x4*)(UF + (size_t)((i2 * 4 + wv) * 64 + lane) * 16 + 8); }
  __syncthreads();
  const char* lw = lds + lane * 16; const char* lq = lds + 16384 + lane * 16; const char* la = lds + 32768 + lane * 16;
  f32x16 vn[2], o[2];
#pragma unroll
  for (int i2 = 0; i2 < 2; ++i2) {
#pragma unroll
    for (int e = 0; e < 4; ++e) { vn[i2][2 * e] = bflo(uu[2 * i2][e]); vn[i2][2 * e + 1] = bfhi(uu[2 * i2][e]); vn[i2][8 + 2 * e] = bflo(uu[2 * i2 + 1][e]); vn[i2][8 + 2 * e + 1] = bfhi(uu[2 * i2 + 1][e]); }
#pragma unroll
    for (int r = 0; r < 16; ++r) o[i2][r] = 0.f;
#pragma unroll
    for (int m = 0; m < 4; ++m)
#pragma unroll
      for (int s = 0; s < 2; ++s) {
        vn[i2] = MFMA32(*(const bf16x8*)(lw + ((i2 * 4 + m) * 2 + s) * 1024), Sb[m][s], vn[i2]);
        o[i2] = MFMA32(*(const bf16x8*)(lq + ((i2 * 4 + m) * 2 + s) * 1024), Sb[m][s], o[i2]);
      }
  }
  bf16x8 Vb[2][2];
#pragma unroll
  for (int j2 = 0; j2 < 2; ++j2) { Vb[j2][0] = packS(vn[j2], 0); Vb[j2][1] = packS(vn[j2], 1); }
#pragma unroll
  for (int i2 = 0; i2 < 2; ++i2)
#pragma unroll
    for (int j2 = 0; j2 <= i2; ++j2)
#pragma unroll
      for (int s = 0; s < 2; ++s) o[i2] = MFMA32(*(const bf16x8*)(la + ((i2 * 2 + j2) * 2 + s) * 1024), Vb[j2][s], o[i2]);
  __syncthreads();
#pragma unroll
  for (int i2 = 0; i2 < 2; ++i2)
#pragma unroll
    for (int r = 0; r < 16; ++r) ol[(32 * i2 + crow(r, hi)) * 136 + 32 * wv + r32] = f2bf(o[i2][r]);
  __syncthreads();
  {
    const size_t t0 = (size_t)b * S_ + c * 64;
    const int row = tid >> 2, q4 = tid & 3;
    const bf16_t* gzp = proj + (t0 + row) * PP + 3072 + h * 128 + 32 * q4;
    bf16_t* op = proj + (t0 + row) * PP + 1536 + h * 128 + 32 * q4;
    float ss = 0.f;
#pragma unroll
    for (int q = 0; q < 4; ++q) { const u32x4 w = *(const u32x4*)(ol + row * 136 + 32 * q4 + 8 * q);
#pragma unroll
      for (int e = 0; e < 4; ++e) { const float a0 = bflo(w[e]), a1 = bfhi(w[e]); ss += a0 * a0 + a1 * a1; } }
    ss += __uint_as_float((unsigned)__builtin_amdgcn_update_dpp(0, (int)__float_as_uint(ss), 0xB1, 0xF, 0xF, true));
    ss += __uint_as_float((unsigned)__builtin_amdgcn_update_dpp(0, (int)__float_as_uint(ss), 0x4E, 0xF, 0xF, true));
    const float rstd = rsqrtf(ss * (1.f / 128.f) + 1e-6f);
#pragma unroll
    for (int q = 0; q < 4; ++q) {
      const u32x4 w = *(const u32x4*)(ol + row * 136 + 32 * q4 + 8 * q), gz = *(const u32x4*)(gzp + 8 * q);
      const f32x4 n0 = *(const f32x4*)(p.gdn_norm_w + 32 * q4 + 8 * q), n1 = *(const f32x4*)(p.gdn_norm_w + 32 * q4 + 8 * q + 4);
      float y[8];
#pragma unroll
      for (int e = 0; e < 4; ++e) { const float z0 = bflo(gz[e]), z1 = bfhi(gz[e]);
        const float g0 = (2 * e < 4) ? n0[(2 * e) & 3] : n1[(2 * e) & 3], g1 = (2 * e + 1 < 4) ? n0[(2 * e + 1) & 3] : n1[(2 * e + 1) & 3];
        y[2 * e] = bflo(w[e]) * rstd * g0 * (z0 * sigmoidf_(z0));
        y[2 * e + 1] = bfhi(w[e]) * rstd * g1 * (z1 * sigmoidf_(z1)); }
      u32x4 wv4 = {pk2(y[0], y[1]), pk2(y[2], y[3]), pk2(y[4], y[5]), pk2(y[6], y[7])};
      *(u32x4*)(op + 8 * q) = wv4;
    }
  }
}
DI void phase_gdnout2(const Params& p, int bid, int nb, char* lds) {
  for (int U = bid; U < 2048; U += nb) gdn_out_unit(p, U, lds);
}
DI void phase_gdnout(const Params& p, int bid, int nb) {
  const int lane = tidx() & 63, gw = bid * 4 + (tidx() >> 6), nw = nb * 4;
  bf16_t* proj = (bf16_t*)(p.ws + WS_P);
  const f32x4 w0 = *(const f32x4*)(p.gdn_norm_w + (lane & 15) * 8), w1 = *(const f32x4*)(p.gdn_norm_w + (lane & 15) * 8 + 4);
  for (int row = gw; row < T_; row += nw) {
    bf16_t* op = proj + (size_t)row * PP + 1536 + lane * 8;
    const u32x4 ov = *(const u32x4*)op, zv = *(const u32x4*)(proj + (size_t)row * PP + 3072 + lane * 8);
    float o[8], z[8];
#pragma unroll
    for (int e = 0; e < 4; ++e) { o[2 * e] = bflo(ov[e]); o[2 * e + 1] = bfhi(ov[e]); z[2 * e] = bflo(zv[e]); z[2 * e + 1] = bfhi(zv[e]); }
    float ss = 0.f;
#pragma unroll
    for (int e = 0; e < 8; ++e) ss += o[e] * o[e];
    ss += __shfl_xor(ss, 1); ss += __shfl_xor(ss, 2); ss += __shfl_xor(ss, 4); ss += __shfl_xor(ss, 8);
    const float rstd = rsqrtf(ss * (1.f / 128.f) + 1e-6f);
    float y[8];
#pragma unroll
    for (int e = 0; e < 8; ++e) { const float w = e < 4 ? w0[e] : w1[e - 4]; y[e] = o[e] * rstd * w * (z[e] * sigmoidf_(z[e])); }
    u32x4 r = {pk2(y[0], y[1]), pk2(y[2], y[3]), pk2(y[4], y[5]), pk2(y[6], y[7])};
    *(u32x4*)op = r;
  }
}

struct EpiMergeA {
  const bf16_t* proj; bf16_t* mp;
  DI void operator()(int row, int col, f32x4 v, f32x4 w) const {
    const u32x4 g = *(const u32x4*)(proj + (size_t)row * PP + 3584 + col);
    u32x4 o = {pk2(v[0] * bflo(g[0]), v[1] * bfhi(g[0])), pk2(v[2] * bflo(g[1]), v[3] * bfhi(g[1])), pk2(w[0] * bflo(g[2]), w[1] * bfhi(g[2])), pk2(w[2] * bflo(g[3]), w[3] * bfhi(g[3]))};
    *(u32x4*)(mp + (size_t)row * 1024 + col) = o;
  }
};
struct EpiMergeB {
  const bf16_t* __restrict__ proj; const bf16_t* __restrict__ mpi; bf16_t* __restrict__ mpo;
  DI void operator()(int row, int col, f32x4 v, f32x4 w) const {
    const u32x4 g = *(const u32x4*)(proj + (size_t)row * PP + 4608 + col);
    const u32x4 q = *(const u32x4*)(mpi + (size_t)row * 1024 + col);
    u32x4 o = {pk2(bflo(q[0]) + v[0] * bflo(g[0]), bfhi(q[0]) + v[1] * bfhi(g[0])), pk2(bflo(q[1]) + v[2] * bflo(g[1]), bfhi(q[1]) + v[3] * bfhi(g[1])),
               pk2(bflo(q[2]) + w[0] * bflo(g[2]), bfhi(q[2]) + w[1] * bfhi(g[2])), pk2(bflo(q[3]) + w[2] * bflo(g[3]), bfhi(q[3]) + w[3] * bfhi(g[3]))};
    *(u32x4*)(mpo + (size_t)row * 1024 + col) = o;
  }
};
struct EpiF32 { float* out; int ld; DI void operator()(int row, int col, f32x4 v, f32x4 w) const { *(f32x4*)(out + (size_t)row * ld + col) = v; *(f32x4*)(out + (size_t)row * ld + col + 4) = w; } };
struct EpiBf16 { bf16_t* out; int ld; DI void operator()(int row, int col, f32x4 v, f32x4 w) const { u32x4 o = {pk2(v[0], v[1]), pk2(v[2], v[3]), pk2(w[0], w[1]), pk2(w[2], w[3])}; *(u32x4*)(out + (size_t)row * ld + col) = o; } };
DI void phase_merge(const Params& p, int bid, int nb, char* lds) {
  const bf16_t* proj = (const bf16_t*)(p.ws + WS_P);
  GemmArgs ga = {proj, PP, (const bf16_t*)(p.ws + WS_WFO), 512, 512};
  GemmArgs gb = {proj + 1536, PP, (const bf16_t*)(p.ws + WS_WGO), 512, 512};
  EpiMergeA ea = {proj, (bf16_t*)(p.ws + WS_H)};
  EpiMergeB eb = {proj, (const bf16_t*)(p.ws + WS_H), (bf16_t*)(p.ws + WS_H)};
  TileMap tm; tm.init(bid, nb, 8); int m, n; while (tm.next(m, n)) { gemm_tile(ga, m * 256, n * 128, lds, ea); gemm_tile(gb, m * 256, n * 128, lds, eb); }
}
DI void phase_wout(const Params& p, int bid, int nb, char* lds) {
  GemmArgs g = {(const bf16_t*)(p.ws + WS_H), 1024, (const bf16_t*)(p.ws + WS_WOUT), 1024, 1024};
  EpiF32 e = {p.out, 1024};
  TileMap tm; tm.init(bid, nb, 8); int m, n; while (tm.next(m, n)) gemm_tile(g, m * 256, n * 128, lds, e);
}
DI void phase_rows1(const Params& p, int bid, int nb) {
  const int lane = tidx() & 63, gw = bid * 4 + (tidx() >> 6), nw = nb * 4;
  const float* mod = (const float*)(p.ws + WS_MOD);
  bf16_t* h2 = (bf16_t*)(p.ws + WS_H);
  for (int row0 = gw * 2; row0 < T_; row0 += nw * 2) {
    const int b = row0 >> 13;
    f32x4 v[2][4], xv[2][4];
#pragma unroll
    for (int r = 0; r < 2; ++r)
#pragma unroll
      for (int i = 0; i < 4; ++i) { v[r][i] = ((const f32x4*)(p.out + (size_t)(row0 + r) * 1024))[lane + 64 * i]; xv[r][i] = ((const f32x4*)(p.x + (size_t)(row0 + r) * 1024))[lane + 64 * i]; }
#pragma unroll
    for (int r = 0; r < 2; ++r) {
      f32x4* mr = (f32x4*)(p.out + (size_t)(row0 + r) * 1024);
      float ss = 0.f;
#pragma unroll
      for (int i = 0; i < 4; ++i) ss += v[r][i][0] * v[r][i][0] + v[r][i][1] * v[r][i][1] + v[r][i][2] * v[r][i][2] + v[r][i][3] * v[r][i][3];
      ss = wave_sum(ss);
      const float rstd = rsqrtf(ss * (1.f / 1024.f) + 1e-6f);
      float s2 = 0.f;
#pragma unroll
      for (int i = 0; i < 4; ++i) {
        const int col = 4 * lane + 256 * i;
        const f32x4 g4 = *(const f32x4*)(p.g_post_mix + col), gt = *(const f32x4*)(mod + b * 6144 + 2048 + col);
        v[r][i] = xv[r][i] + gt * (v[r][i] * rstd * g4);
        mr[lane + 64 * i] = v[r][i];
        s2 += v[r][i][0] * v[r][i][0] + v[r][i][1] * v[r][i][1] + v[r][i][2] * v[r][i][2] + v[r][i][3] * v[r][i][3];
      }
      s2 = wave_sum(s2);
      const float rstd2 = rsqrtf(s2 * (1.f / 1024.f) + 1e-6f);
#pragma unroll
      for (int i = 0; i < 4; ++i) {
        const int col = 4 * lane + 256 * i;
        const f32x4 g4 = *(const f32x4*)(p.g_pre_ffn + col), sh = *(const f32x4*)(mod + b * 6144 + 3072 + col), sc = *(const f32x4*)(mod + b * 6144 + 4096 + col);
        const f32x4 y = (v[r][i] * rstd2 * g4) * (1.f + sc) + sh;
        u32x2 o = {pk2(y[0], y[1]), pk2(y[2], y[3])};
        *(u32x2*)(h2 + (size_t)(row0 + r) * 1024 + col) = o;
      }
    }
  }
}

DI void phase_peerq(const Params& p, int bid, int nb, char* lds) {
  GemmArgs g = {(const bf16_t*)(p.ws + WS_H), 1024, (const bf16_t*)(p.ws + WS_WQ), 1024, 1024};
  EpiBf16 e = {(bf16_t*)(p.ws + WS_QY), 2048};
  TileMap tm; tm.init(bid, nb, 16); int m, n; while (tm.next(m, n)) gemm_tile(g, m * 256, n * 128, lds, e);
}
DI unsigned ordkey(float f) { const unsigned u = __float_as_uint(f); return (u & 0x80000000u) ? ~u : (u | 0x80000000u); }
#define CE_DESC(x, y) do { const unsigned mx_ = (x) > (y) ? (x) : (y); const unsigned mn_ = (x) > (y) ? (y) : (x); (x) = mx_; (y) = mn_; } while (0)
DI void sort16_desc(unsigned (&a)[16]) {
#pragma unroll
  for (int k = 2; k <= 16; k <<= 1)
#pragma unroll
    for (int j = k >> 1; j > 0; j >>= 1)
#pragma unroll
      for (int i = 0; i < 16; ++i) {
        const int l = i ^ j;
        if (l > i) { if ((i & k) == 0) CE_DESC(a[i], a[l]); else CE_DESC(a[l], a[i]); }
      }
}
DI void merge16_desc(unsigned (&a)[16], const unsigned (&b)[16]) {
#pragma unroll
  for (int i = 0; i < 16; ++i) a[i] = a[i] > b[15 - i] ? a[i] : b[15 - i];
#pragma unroll
  for (int j = 8; j > 0; j >>= 1)
#pragma unroll
    for (int i = 0; i < 16; ++i) if ((i & j) == 0) CE_DESC(a[i], a[i + j]);
}
template <int CTRL> DI void dpp16(unsigned (&b)[16], const unsigned (&a)[16]) {
#pragma unroll
  for (int s = 0; s < 16; ++s) b[s] = (unsigned)__builtin_amdgcn_update_dpp(0, (int)a[s], CTRL, 0xF, 0xF, true);
}
__device__ const unsigned char PEER_CAND[64] = {
  0x00, 0x01, 0x02, 0x03, 0x04, 0x05, 0x06, 0x07, 0x08, 0x09, 0x0A, 0x0B, 0x0C, 0x0D, 0x0E, 0x0F,
  0x10, 0x11, 0x12, 0x13, 0x14, 0x15, 0x16, 0x17, 0x20, 0x21, 0x22, 0x23, 0x24, 0x80, 0x90, 0xA0,
  0x30, 0x31, 0x32, 0x33, 0x40, 0x41, 0x42, 0x50, 0x51, 0x60, 0x61, 0x70, 0x71, 0xB0, 0xC0, 0xD0,
  0xE0, 0xF0, 0xFF, 0xFF, 0xFF, 0xFF, 0xFF, 0xFF, 0xFF, 0xFF, 0xFF, 0xFF, 0xFF, 0xFF, 0xFF, 0xFF};
DI void peer_select_unit(const Params& p, int unit, char* lds, const bf16x8 (&kb)[4][4]) {
  const int tid = tidx(), lane = tid & 63, wid = tid >> 6, fr = lane & 15, fq = lane >> 4;
  const int h = unit & 7, t0 = (unit >> 3) * 32;
  float* sc = (float*)lds;
  float* topv = (float*)(lds + 64 * 132 * 4);
  int* topi = (int*)(lds + 64 * 132 * 4 + 64 * 16 * 4);
  const bf16_t* qy = (const bf16_t*)(p.ws + WS_QY);
  const bf16_t* keys = (const bf16_t*)(p.ws + WS_KEYS);
  __syncthreads();
  {
    const int set = wid >> 1, kh = wid & 1;
    bf16x8 qa[2][4];
#pragma unroll
    for (int mt = 0; mt < 2; ++mt)
#pragma unroll
      for (int kk = 0; kk < 4; ++kk) qa[mt][kk] = *(const bf16x8*)(qy + (size_t)(t0 + 16 * mt + fr) * 2048 + h * 256 + set * 128 + kk * 32 + fq * 8);
#pragma unroll
    for (int mt = 0; mt < 2; ++mt)
#pragma unroll
      for (int nj = 0; nj < 4; ++nj) {
        f32x4 d = {0.f, 0.f, 0.f, 0.f};
#pragma unroll
        for (int kk = 0; kk < 4; ++kk) d = MFMA16(qa[mt][kk], kb[nj][kk], d);
#pragma unroll
        for (int r = 0; r < 4; ++r) sc[(set * 32 + 16 * mt + 4 * fq + r) * 132 + 64 * kh + 16 * nj + fr] = d[r];
      }
  }
  __syncthreads();
#pragma unroll 1
  for (int pass = 0; pass < 2; ++pass) {
    const int rr = pass * 32 + (tid >> 3), part = tid & 7;
    unsigned a[16], bq[16];
    const float* srow = sc + rr * 132 + 16 * part;
#pragma unroll
    for (int j = 0; j < 4; ++j) {
      const f32x4 v = *(const f32x4*)(srow + 4 * j);
#pragma unroll
      for (int e = 0; e < 4; ++e) a[4 * j + e] = (ordkey(v[e]) & ~127u) | (unsigned)(127 - (16 * part + 4 * j + e));
    }
    sort16_desc(a);
    dpp16<0xB1>(bq, a); merge16_desc(a, bq);
    dpp16<0x4E>(bq, a); merge16_desc(a, bq);
    dpp16<0x141>(bq, a); merge16_desc(a, bq);
#pragma unroll
    for (int s = 0; s < 2; ++s) {
      unsigned k = 0u;
#pragma unroll
      for (int q = 0; q < 8; ++q) k = part == q ? a[2 * q + s] : k;
      const int idx = 127 - (int)(k & 127u);
      topv[rr * 16 + 2 * part + s] = sc[rr * 132 + idx]; topi[rr * 16 + 2 * part + s] = idx;
    }
  }
  __syncthreads();
  if (tid < 128) {
    const int tok = tid >> 2, q4 = tid & 3;
    unsigned c[16], bq[16];
#pragma unroll
    for (int i = 0; i < 16; ++i) {
      const unsigned code = PEER_CAND[16 * q4 + i];
      const float v = topv[tok * 16 + ((code >> 4) & 15)] + topv[(32 + tok) * 16 + (code & 15)];
      c[i] = code == 0xFFu ? 0u : ((ordkey(v) & ~255u) | (255u - code));
    }
    sort16_desc(c);
    dpp16<0xB1>(bq, c); merge16_desc(c, bq);
    dpp16<0x4E>(bq, c); merge16_desc(c, bq);
    float mx; { const int pos = 255 - (int)(c[0] & 255u); mx = topv[tok * 16 + (pos >> 4)] + topv[(32 + tok) * 16 + (pos & 15)]; }
    float val[4]; int ei[4]; float part = 0.f;
#pragma unroll
    for (int s = 0; s < 4; ++s) {
      unsigned k = 0u;
#pragma unroll
      for (int q = 0; q < 4; ++q) k = q4 == q ? c[4 * q + s] : k;
      const int pos = 255 - (int)(k & 255u); const int a = pos >> 4, b = pos & 15;
      const float v = topv[tok * 16 + a] + topv[(32 + tok) * 16 + b]; ei[s] = topi[tok * 16 + a] * 128 + topi[(32 + tok) * 16 + b];
      val[s] = __expf(v - mx); part += val[s];
    }
    part += __uint_as_float((unsigned)__builtin_amdgcn_update_dpp(0, (int)__float_as_uint(part), 0xB1, 0xF, 0xF, true));
    part += __uint_as_float((unsigned)__builtin_amdgcn_update_dpp(0, (int)__float_as_uint(part), 0x4E, 0xF, 0xF, true));
    const float rt = 1.f / part;
    int* eo = (int*)(p.ws + WS_EIDX) + ((size_t)(t0 + tok) * 8 + h) * 16 + 4 * q4; float* go = (float*)(p.ws + WS_GATE) + ((size_t)(t0 + tok) * 8 + h) * 16 + 4 * q4;
    *(f32x4*)go = (f32x4){val[0] * rt, val[1] * rt, val[2] * rt, val[3] * rt};
    typedef int i32x4 __attribute__((ext_vector_type(4)));
    *(i32x4*)eo = (i32x4){ei[0], ei[1], ei[2], ei[3]};
  }
}
DI void phase_peersel(const Params& p, int bid, int nb, char* lds) {
  const int lane = tidx() & 63, wid = tidx() >> 6, fr = lane & 15, fq = lane >> 4;
  const bf16_t* keys = (const bf16_t*)(p.ws + WS_KEYS) + (wid >> 1) * 16384 + (wid & 1) * 64 * 128;
  bf16x8 kb[4][4];
#pragma unroll
  for (int nj = 0; nj < 4; ++nj)
#pragma unroll
    for (int kk = 0; kk < 4; ++kk) kb[nj][kk] = *(const bf16x8*)(keys + (16 * nj + fr) * 128 + kk * 32 + fq * 8);
  for (int u = bid; u < 8192; u += nb) peer_select_unit(p, u, lds, kb);
}
DI float dpp_sum8(float d) {
  d += __uint_as_float((unsigned)__builtin_amdgcn_update_dpp(0, (int)__float_as_uint(d), 0xB1, 0xF, 0xF, true));
  d += __uint_as_float((unsigned)__builtin_amdgcn_update_dpp(0, (int)__float_as_uint(d), 0x4E, 0xF, 0xF, true));
  d += __uint_as_float((unsigned)__builtin_amdgcn_update_dpp(0, (int)__float_as_uint(d), 0x141, 0xF, 0xF, true));
  return d;
}
DI void unpack8x2_fp8(const u32x4 w, f32x2 (&f)[8]) {
#pragma unroll
  for (int i = 0; i < 4; ++i) { f[2 * i] = __builtin_amdgcn_cvt_pk_f32_fp8((int)w[i], false); f[2 * i + 1] = __builtin_amdgcn_cvt_pk_f32_fp8((int)w[i], true); }
}
DI void unpack16_fp8(const u32x4 w, float (&f)[16]) {
#pragma unroll
  for (int i = 0; i < 4; ++i) { const f32x2 lo = __builtin_amdgcn_cvt_pk_f32_fp8((int)w[i], false), hi = __builtin_amdgcn_cvt_pk_f32_fp8((int)w[i], true); f[4 * i] = lo[0]; f[4 * i + 1] = lo[1]; f[4 * i + 2] = hi[0]; f[4 * i + 3] = hi[1]; }
}
typedef int i32x4_t __attribute__((ext_vector_type(4)));
DI void phase_peerdown(const Params& p, int bid, int nb) {
  const int lane = tidx() & 63, wid = tidx() >> 6, e8 = lane >> 3, c = lane & 7;
  const int x = bid & 7, gw = (bid >> 3) * 4 + wid, nw = (nb >> 3) * 4;
  const bf16_t* h2 = (const bf16_t*)(p.ws + WS_H) + 128 * x + 16 * c;
  const char* tab = p.ws + WS_PU + (size_t)x * 16384 * 128 + 16 * c;
  const int* eidx = (const int*)(p.ws + WS_EIDX) + 16 * e8;
  float* pd = (float*)(p.ws + WS_PD) + (size_t)x * T_ * 128 + 16 * e8 + c;
#define PD_IDX(t, E, H) do { _Pragma("unroll") for (int q = 0; q < 4; ++q) E[q] = *(const i32x4_t*)(eidx + (size_t)(t) * 128 + 4 * q); \
    H[0] = *(const u32x4*)(h2 + (size_t)(t) * 1024); H[1] = *(const u32x4*)(h2 + (size_t)(t) * 1024 + 8); } while (0)
#define PD_TAB(E, W) do { _Pragma("unroll") for (int q = 0; q < 16; ++q) W[q] = *(const u32x4*)(tab + (size_t)E[q >> 2][q & 3] * 128); } while (0)
#define PD_MATH(t, W, H) do { f32x2 hx[8]; \
    _Pragma("unroll") for (int e = 0; e < 4; ++e) { hx[e] = (f32x2){bflo(H[0][e]), bfhi(H[0][e])}; hx[4 + e] = (f32x2){bflo(H[1][e]), bfhi(H[1][e])}; } \
    float k0 = 0.f, k1 = 0.f; \
    _Pragma("unroll") for (int q = 0; q < 16; ++q) { f32x2 f[8]; unpack8x2_fp8(W[q], f); f32x2 d2 = f[0] * hx[0]; \
      _Pragma("unroll") for (int i = 1; i < 8; ++i) d2 = __builtin_elementwise_fma(f[i], hx[i], d2); \
      const float d = dpp_sum8(d2[0] + d2[1]); if (c == (q & 7)) { if (q < 8) k0 = d; else k1 = d; } } \
    pd[(size_t)(t) * 128] = k0; pd[(size_t)(t) * 128 + 8] = k1; } while (0)
  i32x4_t eA[4], eB[4]; u32x4 hA[2], hB[2], w[16];
  int t = gw; if (t >= T_) return;
  PD_IDX(t, eA, hA);
  for (;;) {
    PD_TAB(eA, w);
    const int t1 = t + nw; if (t1 < T_) PD_IDX(t1, eB, hB);
    PD_MATH(t, w, hA);
    if (t1 >= T_) break;
    PD_TAB(eB, w);
    const int t2 = t1 + nw; if (t2 < T_) PD_IDX(t2, eA, hA);
    PD_MATH(t1, w, hB);
    if (t2 >= T_) break;
    t = t2;
  }
#undef PD_IDX
#undef PD_TAB
#undef PD_MATH
}
DI void phase_peercoef(const Params& p, int bid, int nb) {
  const float* pd = (const float*)(p.ws + WS_PD);
  const int* eidx = (const int*)(p.ws + WS_EIDX); const float* gate = (const float*)(p.ws + WS_GATE);
  const float* uinv = (const float*)(p.ws + WS_UINV); const float* vinv = (const float*)(p.ws + WS_VINV);
  float* coef = (float*)(p.ws + WS_COEF);
  for (size_t i4 = ((size_t)bid * NT + tidx()) * 4; i4 < (size_t)T_ * 128; i4 += (size_t)nb * NT * 4) {
    f32x4 d = {0.f, 0.f, 0.f, 0.f};
#pragma unroll
    for (int x = 0; x < 8; ++x) d += *(const f32x4*)(pd + (size_t)x * T_ * 128 + i4);
    typedef int i32x4 __attribute__((ext_vector_type(4)));
    const i32x4 e = *(const i32x4*)(eidx + i4); const f32x4 g = *(const f32x4*)(gate + i4);
    f32x4 o;
#pragma unroll
    for (int k = 0; k < 4; ++k) { const float dk = d[k] * uinv[e[k]]; o[k] = g[k] * 0.5f * dk * (1.f + erff(dk * 0.70710678118654752f)) * vinv[e[k]]; }
    *(f32x4*)(coef + i4) = o;
  }
}
DI void phase_peerup(const Params& p, int bid, int nb) {
  const int lane = tidx() & 63, wid = tidx() >> 6, e8 = lane >> 3, c = lane & 7;
  const int x = bid & 7, gw = (bid >> 3) * 4 + wid, nw = (nb >> 3) * 4;
  const char* tab = p.ws + WS_PV + (size_t)x * 16384 * 128 + 16 * c;
  const int* eidx = (const int*)(p.ws + WS_EIDX) + 16 * e8; const float* coef = (const float*)(p.ws + WS_COEF) + 16 * e8;
  float* y2 = (float*)(p.ws + WS_Y2) + 128 * x + 16 * c; float* ssq = (float*)(p.ws + WS_SSQ) + (size_t)x * T_;
#define PU_IDX(t, E, C) do { _Pragma("unroll") for (int q = 0; q < 4; ++q) { E[q] = *(const i32x4_t*)(eidx + (size_t)(t) * 128 + 4 * q); C[q] = *(const f32x4*)(coef + (size_t)(t) * 128 + 4 * q); } } while (0)
#define PU_TAB(E, W) do { _Pragma("unroll") for (int q = 0; q < 16; ++q) W[q] = *(const u32x4*)(tab + (size_t)E[q >> 2][q & 3] * 128); } while (0)
#define PU_MATH(t, W, C) do { f32x2 yp[8]; \
    _Pragma("unroll") for (int i = 0; i < 8; ++i) yp[i] = (f32x2){0.f, 0.f}; \
    _Pragma("unroll") for (int q = 0; q < 16; ++q) { f32x2 f[8]; unpack8x2_fp8(W[q], f); const float cq = C[q >> 2][q & 3]; const f32x2 cc = {cq, cq}; \
      _Pragma("unroll") for (int i = 0; i < 8; ++i) yp[i] = __builtin_elementwise_fma(f[i], cc, yp[i]); } \
    float y[16]; float ss = 0.f; \
    _Pragma("unroll") for (int i = 0; i < 8; ++i) { y[2 * i] = yp[i][0]; y[2 * i + 1] = yp[i][1]; } \
    _Pragma("unroll") for (int i = 0; i < 16; ++i) { y[i] += __shfl_xor(y[i], 8); y[i] += __shfl_xor(y[i], 16); y[i] += __shfl_xor(y[i], 32); ss += y[i] * y[i]; } \
    ss = dpp_sum8(ss); \
    if (e8 == 0) { float* yo = y2 + (size_t)(t) * 1024; \
      _Pragma("unroll") for (int q = 0; q < 4; ++q) *(f32x4*)(yo + 4 * q) = (f32x4){y[4 * q], y[4 * q + 1], y[4 * q + 2], y[4 * q + 3]}; \
      if (c == 0) ssq[t] = ss; } } while (0)
  i32x4_t eA[4], eB[4]; f32x4 cA[4], cB[4]; u32x4 w[16];
  int t = gw; if (t >= T_) return;
  PU_IDX(t, eA, cA);
  for (;;) {
    PU_TAB(eA, w);
    const int t1 = t + nw; if (t1 < T_) PU_IDX(t1, eB, cB);
    PU_MATH(t, w, cA);
    if (t1 >= T_) break;
    PU_TAB(eB, w);
    const int t2 = t1 + nw; if (t2 < T_) PU_IDX(t2, eA, cA);
    PU_MATH(t1, w, cB);
    if (t2 >= T_) break;
    t = t2;
  }
#undef PU_IDX
#undef PU_TAB
#undef PU_MATH
}
DI void phase_final(const Params& p, int bid, int nb) {
  const int lane = tidx() & 63, gw = bid * 4 + (tidx() >> 6), nw = nb * 4;
  const float* mod = (const float*)(p.ws + WS_MOD);
  const float* y2 = (const float*)(p.ws + WS_Y2); const float* ssq = (const float*)(p.ws + WS_SSQ);
  for (int row0 = gw * 2; row0 < T_; row0 += nw * 2) {
    const int b = row0 >> 13;
    f32x4 ov[2][4], yv[2][4]; float ss[2] = {0.f, 0.f};
#pragma unroll
    for (int r = 0; r < 2; ++r) {
#pragma unroll
      for (int i = 0; i < 4; ++i) { ov[r][i] = ((const f32x4*)(p.out + (size_t)(row0 + r) * 1024))[lane + 64 * i]; yv[r][i] = ((const f32x4*)(y2 + (size_t)(row0 + r) * 1024))[lane + 64 * i]; }
#pragma unroll
      for (int x = 0; x < 8; ++x) ss[r] += ssq[(size_t)x * T_ + row0 + r];
    }
#pragma unroll
    for (int r = 0; r < 2; ++r) {
      const float rstd = rsqrtf(ss[r] * (1.f / 1024.f) + 1e-6f);
      f32x4* orow = (f32x4*)(p.out + (size_t)(row0 + r) * 1024);
#pragma unroll
      for (int i = 0; i < 4; ++i) {
        const int col = 4 * lane + 256 * i;
        const f32x4 g4 = *(const f32x4*)(p.g_post_ffn + col), gt = *(const f32x4*)(mod + b * 6144 + 5120 + col);
        orow[lane + 64 * i] = ov[r][i] + gt * (yv[r][i] * rstd * g4);
      }
    }
  }
}

namespace cg = cooperative_groups;
constexpr int LDS_BYTES = 75776;
DI void phase_mixer(const Params& p, int bid, int nb, char* lds) {
  if (bid < 16) gdn_scan_seq(p, bid, lds);
  unsigned* ctr = (unsigned*)(p.ws + WS_CTL);
  int* slot = (int*)(lds + LDS_BYTES - 16);
  for (;;) {
    __syncthreads();
    if (tidx() == 0) *slot = (int)atomicAdd(ctr, 1u);
    __syncthreads();
    const int u = *slot;
    if (u >= 2048) break;
    attn_unit(p, u & 31, 63 - (u >> 5), lds);
  }
}
#define XB_TMO      128
#define XB_XCNT(j)  (256  + 64 * (j))
#define XB_XSUB(j)  (1280 + 64 * (j))
#define XB_XGEN(j)  (2304 + 64 * (j))
#define XB_TOP      3328
#define XB_TOPGEN   3392
#define XCD_BAR_WORDS 3456
#define XB_SPIN_CAP (1u << 22)
DI unsigned xb_ld(unsigned* p)              { return __hip_atomic_load(p, __ATOMIC_RELAXED, __HIP_MEMORY_SCOPE_AGENT); }
DI unsigned xb_add(unsigned* p, unsigned v) { return __hip_atomic_fetch_add(p, v, __ATOMIC_RELAXED, __HIP_MEMORY_SCOPE_AGENT); }
DI unsigned xb_xcc_id() { return (unsigned)__builtin_amdgcn_s_getreg((3 << 11) | 20) & 0xFu; }
#define XB_SPIN(cond, bar) do { unsigned _sp = 0; while (cond) { __builtin_amdgcn_s_sleep(1); \
    if ((++_sp & 255u) == 0u) { if (xb_ld(&(bar)[XB_TMO])) break; if (_sp > XB_SPIN_CAP) { atomicAdd(&(bar)[XB_TMO], 1u); break; } } } } while (0)
struct XcdBarrier { unsigned* bar; unsigned x; volatile LAS unsigned* st; };
DI XcdBarrier xcd_barrier_post(unsigned* bar, volatile LAS unsigned* st) {
  XcdBarrier b; b.bar = bar; b.x = xb_xcc_id(); b.st = st;
  if (threadIdx.x == 0) (void)xb_add(&bar[XB_XCNT(b.x)], 1u);
  return b;
}
DI void xcd_barrier_complete(unsigned* bar, unsigned x, unsigned& nloc, unsigned& nx) {
  const unsigned G = gridDim.x * gridDim.y * gridDim.z;
  unsigned sum, cnt, mine, sp = 0u;
  for (;;) {
    sum = 0u; cnt = 0u; mine = 0u;
#pragma unroll
    for (unsigned j = 0; j < 16; ++j) { const unsigned c = xb_ld(&bar[XB_XCNT(j)]); sum += c; cnt += (c > 0u) ? 1u : 0u; mine = (j == x) ? c : mine; }
    if (sum == G) break;
    __builtin_amdgcn_s_sleep(1);
    if ((++sp & 255u) == 0u) { if (xb_ld(&bar[XB_TMO])) break; if (sp > XB_SPIN_CAP) { atomicAdd(&bar[XB_TMO], 1u); break; } }
  }
  nloc = mine > 0u ? mine : 1u; nx = cnt > 0u ? cnt : 1u;
}
DI void xcd_barrier(const XcdBarrier& b) {
  asm volatile("s_waitcnt vmcnt(0)" ::: "memory");
  __syncthreads();
  if (threadIdx.x == 0) {
    unsigned* bar = b.bar;
    __builtin_amdgcn_s_waitcnt(0);
    unsigned nloc = b.st[0], nx = b.st[1];
    if (nloc == 0u) { xcd_barrier_complete(bar, b.x, nloc, nx); b.st[0] = nloc; b.st[1] = nx; }
    const unsigned old = xb_add(&bar[XB_XSUB(b.x)], 1u);
    const unsigned gen = old / nloc;
    if (old + 1u == (gen + 1u) * nloc) {
      __builtin_amdgcn_fence(__ATOMIC_RELEASE, "agent");
      asm volatile("s_waitcnt vmcnt(0)" ::: "memory");
      const unsigned og = xb_add(&bar[XB_TOP], 1u);
      const unsigned tg = og / nx;
      if (og + 1u == (tg + 1u) * nx) xb_add(&bar[XB_TOPGEN], 1u);
      else XB_SPIN(xb_ld(&bar[XB_TOPGEN]) == tg, bar);
      __builtin_amdgcn_fence(__ATOMIC_ACQUIRE, "agent");
      xb_add(&bar[XB_XGEN(b.x)], 1u);
      asm volatile("s_waitcnt vmcnt(0)" ::: "memory");
    } else {
      XB_SPIN(xb_ld(&bar[XB_XGEN(b.x)]) == gen, bar);
      __builtin_amdgcn_fence(__ATOMIC_ACQUIRE, "agent");
      asm volatile("s_waitcnt vmcnt(0)" ::: "memory");
    }
  }
  __syncthreads();
}

#ifndef PROBE_PHASE
#define PROBE_PHASE -1
#endif
__global__ void __launch_bounds__(NT, 2) fwd(Params p) {
  extern __shared__ __attribute__((aligned(16))) char lds[];
  cg::grid_group grid = cg::this_grid();
  const int bid = blockIdx.x, nb = gridDim.x;
  unsigned long long tprev = 0, tprobe = 0; int nph = 0;
  volatile LAS unsigned* xst = (volatile LAS unsigned*)(lds + LDS_BYTES - 12);
  if (threadIdx.x == 0) { xst[0] = 0u; xst[1] = 0u; }
  unsigned* xbar = (unsigned*)(p.ws + WS_CTL) + 1024;
  if (bid == 0) for (int i = threadIdx.x; i < XCD_BAR_WORDS; i += NT) xbar[i] = 0u;
  XcdBarrier xb; xb.bar = xbar; xb.x = 0u; xb.st = xst;
  bool first_seam = true;
#define SEAM() do { if (first_seam) { asm volatile("s_waitcnt vmcnt(0)" ::: "memory"); grid.sync(); xb = xcd_barrier_post(xbar, xst); first_seam = false; } else xcd_barrier(xb); \
    if (PROBE_PHASE >= 0) { const unsigned long long tn = __builtin_amdgcn_s_memrealtime(); if (nph == PROBE_PHASE) tprobe = tn - tprev; tprev = tn; ++nph; } } while (0)
  if (bid == 0 && tidx() < 192) ((unsigned*)(p.ws + WS_CTL))[tidx()] = 0u;
  if (PROBE_PHASE >= 0) tprev = __builtin_amdgcn_s_memrealtime();
  phase_mod(p, bid, nb, lds); phase_wconv(p, bid, nb, lds);
  SEAM();
  phase_xnorm(p, bid, nb);
  SEAM();
  phase_inproj(p, bid, nb, lds);
  SEAM();
  if (bid < 32) phase_foxcum(p, bid, 32, lds);
  phase_qknorm(p, bid, nb);
  phase_gdnprep(p, bid, nb, lds);
  SEAM();
  phase_mixer(p, bid, nb, lds);
  SEAM();
  phase_gdnout2(p, bid, nb, lds);
  SEAM();
  phase_merge(p, bid, nb, lds);
  SEAM();
  phase_wout(p, bid, nb, lds); phase_tabconv(p, bid, nb);
  SEAM();
  phase_rows1(p, bid, nb);
  SEAM();
  phase_peerq(p, bid, nb, lds);
  SEAM();
  phase_peersel(p, bid, nb, lds);
  SEAM();
  phase_peerdown(p, bid, nb);
  SEAM();
  phase_peercoef(p, bid, nb);
  SEAM();
  phase_peerup(p, bid, nb);
  SEAM();
  phase_final(p, bid, nb);
  if (PROBE_PHASE >= 0) {
    if (PROBE_PHASE == nph) { xcd_barrier(xb); tprobe = __builtin_amdgcn_s_memrealtime() - tprev; }
    if (bid == 0 && tidx() == 0) { const unsigned long long t0 = __builtin_amdgcn_s_memrealtime(); while (__builtin_amdgcn_s_memrealtime() - t0 < tprobe) __builtin_amdgcn_s_sleep(8); }
  }
}

extern "C" void kernel_launch(void* const* d_in, const int* in_sizes, int n_in, void* d_out, int out_size, void* d_ws, size_t ws_size, hipStream_t stream) {
  static int grid_blocks = 0;
  if (!grid_blocks) {
    int dev = 0, cus = 0, per_cu = 0;
    hipGetDevice(&dev);
    hipDeviceGetAttribute(&cus, hipDeviceAttributeMultiprocessorCount, dev);
    (void)hipFuncSetAttribute((const void*)fwd, hipFuncAttributeMaxDynamicSharedMemorySize, LDS_BYTES);
    hipOccupancyMaxActiveBlocksPerMultiprocessor(&per_cu, (const void*)fwd, NT, LDS_BYTES);
    if (per_cu < 1) per_cu = 1;
    if (per_cu > 2) per_cu = 2;
    grid_blocks = cus * per_cu;
  }
  Params p{};
  const float** f = (const float**)&p;
  for (int i = 0; i < 23; ++i) f[i] = (const float*)d_in[i];
  p.out = (float*)d_out; p.ws = (char*)d_ws;
  void* args[] = {&p};
  hipError_t e = hipLaunchCooperativeKernel((const void*)fwd, dim3(grid_blocks), dim3(NT), args, LDS_BYTES, stream);
  if (e != hipSuccess) fprintf(stderr, "cooperative launch failed: %s (grid %d)\n", hipGetErrorString(e), grid_blocks);
}
```

```cpp
#include <hip/hip_runtime.h>
#include <hip/hip_cooperative_groups.h>
#include <stdint.h>
#include <math.h>
#include <cstdio>

#define DI __device__ __forceinline__
#define LAS __attribute__((address_space(3)))
typedef unsigned short bf16_t;
typedef short bf16x8 __attribute__((ext_vector_type(8)));
typedef short s16x4 __attribute__((ext_vector_type(4)));
typedef float f32x4 __attribute__((ext_vector_type(4)));
typedef float f32x16 __attribute__((ext_vector_type(16)));
typedef float f32x2 __attribute__((ext_vector_type(2)));
typedef unsigned u32x4 __attribute__((ext_vector_type(4)));
typedef unsigned u32x2 __attribute__((ext_vector_type(2)));
typedef __bf16 bf16x2_t __attribute__((ext_vector_type(2)));

constexpr int NT = 256;
constexpr int T_ = 32768, S_ = 8192;
constexpr int PP = 5632;
constexpr int NPAD = 5760;
constexpr float LOG2E = 1.4426950408889634f;
constexpr size_t MiB = 1u << 20;

constexpr size_t WS_CTL = 0;
constexpr size_t WS_MOD = 1 * MiB;
constexpr size_t WS_WIN = 2 * MiB;
constexpr size_t WS_WFO = 14 * MiB;
constexpr size_t WS_WGO = 15 * MiB;
constexpr size_t WS_WOUT = 16 * MiB;
constexpr size_t WS_WQ = 18 * MiB;
constexpr size_t WS_KEYS = 22 * MiB;
constexpr size_t WS_SMALL = 23 * MiB;
constexpr size_t WS_FNEG = 25 * MiB;
constexpr size_t WS_KNPM = 26 * MiB + 65536;
constexpr size_t WS_GL = 26 * MiB;
constexpr size_t WS_SC = 32 * MiB;
constexpr size_t WS_H = 32 * MiB;
constexpr size_t WS_P = 96 * MiB;
constexpr size_t WS_UF = 448 * MiB;
constexpr size_t WS_WF = 480 * MiB;
constexpr size_t WS_QY = 96 * MiB;
constexpr size_t WS_PU = 224 * MiB;
constexpr size_t WS_PV = 240 * MiB;
constexpr size_t WS_UINV = 256 * MiB;
constexpr size_t WS_VINV = 256 * MiB + 65536;
constexpr size_t WS_EIDX = 288 * MiB;
constexpr size_t WS_GATE = 304 * MiB;
constexpr size_t WS_PD = 320 * MiB;
constexpr size_t WS_Y2 = 96 * MiB;
constexpr size_t WS_COEF = 32 * MiB;
constexpr size_t WS_SSQ = 48 * MiB;

DI int tidx() { int t = threadIdx.x; asm volatile("" : "+v"(t)); return t; }
DI unsigned pk2(float lo, float hi) { f32x2 v = {lo, hi}; bf16x2_t b = __builtin_convertvector(v, bf16x2_t); return __builtin_bit_cast(unsigned, b); }
DI bf16_t f2bf(float x) { return (bf16_t)(pk2(x, 0.f) & 0xffffu); }
DI float bf2f(bf16_t v) { return __uint_as_float(((unsigned)v) << 16); }
DI float bflo(unsigned u) { return __uint_as_float(u << 16); }
DI float bfhi(unsigned u) { return __uint_as_float(u & 0xffff0000u); }
DI float wave_sum(float v) {
#pragma unroll
  for (int d = 32; d >= 1; d >>= 1) v += __shfl_xor(v, d);
  return v;
}
DI unsigned wave_max_u(unsigned v) {
#pragma unroll
  for (int d = 32; d >= 1; d >>= 1) { unsigned o = (unsigned)__shfl_xor((int)v, d); v = o > v ? o : v; }
  return v;
}
DI float sigmoidf_(float x) { return __builtin_amdgcn_rcpf(1.f + __expf(-x)); }
DI float softplusf_(float x) { return fmaxf(x, 0.f) + log1pf(__expf(-fabsf(x))); }
DI int crow(int r, int hi) { return (r & 3) + 8 * (r >> 2) + 4 * hi; }
#define MFMA16(a, b, c) __builtin_amdgcn_mfma_f32_16x16x32_bf16((a), (b), (c), 0, 0, 0)
#define MFMA32(a, b, c) __builtin_amdgcn_mfma_f32_32x32x16_bf16((a), (b), (c), 0, 0, 0)
DI s16x4 tr16(const LAS char* p) { typedef short v4i16_t __attribute__((ext_vector_type(4))); return __builtin_bit_cast(s16x4, __builtin_amdgcn_ds_read_tr16_b64_v4i16((LAS v4i16_t*)p)); }
DI bf16x8 cat8(s16x4 lo, s16x4 hi) { return __builtin_shufflevector(lo, hi, 0, 1, 2, 3, 4, 5, 6, 7); }
DI bf16x8 pack8(float a0, float a1, float a2, float a3, float a4, float a5, float a6, float a7) {
  u32x4 p = {pk2(a0, a1), pk2(a2, a3), pk2(a4, a5), pk2(a6, a7)}; return __builtin_bit_cast(bf16x8, p);
}

struct Params {
  const float *x, *c, *w_ada, *b_ada, *g_pre_mix, *g_post_mix, *w_in, *b_fgate, *fox_w_o, *conv_w, *a_log, *dt_bias, *gdn_norm_w, *gdn_w_o,
      *b_branch_gate, *w_out, *g_pre_ffn, *g_post_ffn, *peer_w_query, *peer_keys1, *peer_keys2, *peer_u, *peer_v;
  float* out; char* ws;
};

DI void phase_mod(const Params& p, int bid, int nb, char* lds) {
  float* sc = (float*)lds;
  float* part = sc + 4096;
  const int tid = tidx();
  if (bid >= 192) return;
  for (int i = tid; i < 4096; i += NT) { float v = p.c[i]; sc[i] = v / (1.f + __expf(-v)); }
  __syncthreads();
  float* mod = (float*)(p.ws + WS_MOD);
  for (int g = bid; g < 192; g += nb) {
    const int cc = tid & 31, kg = tid >> 5, col = g * 32 + cc;
    float a0 = 0.f, a1 = 0.f, a2 = 0.f, a3 = 0.f;
#pragma unroll 32
    for (int k = kg; k < 1024; k += 8) { const float w = p.w_ada[(size_t)k * 6144 + col]; a0 += sc[k] * w; a1 += sc[1024 + k] * w; a2 += sc[2048 + k] * w; a3 += sc[3072 + k] * w; }
    part[(kg * 4 + 0) * 32 + cc] = a0; part[(kg * 4 + 1) * 32 + cc] = a1; part[(kg * 4 + 2) * 32 + cc] = a2; part[(kg * 4 + 3) * 32 + cc] = a3;
    __syncthreads();
    if (tid < 128) { const int b = tid >> 5; float s = 0.f;
#pragma unroll
      for (int q = 0; q < 8; ++q) s += part[(q * 4 + b) * 32 + cc];
      mod[b * 6144 + col] = s + p.b_ada[col]; }
    __syncthreads();
  }
}

DI int inproj_colmap(int n) {
  if (n < 1536) return n;
  if (n < 3584) return 1544 + (n - 1536);
  if (n < 5632) return 3600 + (n - 3584);
  if (n < 5640) return 1536 + (n - 5632);
  if (n < 5648) return 3592 + (n - 5640);
  return -1;
}
DI void transpose_tile(const float* src, int ldsrc, bf16_t* dst, int K, int n0, int k0, bool permute, float* tile) {
  const int tid = tidx(), tx = tid & 63, ty = tid >> 6;
  const int n = n0 + tx; const int oc = permute ? inproj_colmap(n) : n;
  const float* sp = src + (size_t)(k0 + ty) * ldsrc + (oc >= 0 ? oc : 0);
  float v[16];
#pragma unroll
  for (int i = 0; i < 16; ++i) v[i] = sp[(size_t)(4 * i) * ldsrc];
#pragma unroll
  for (int i = 0; i < 16; ++i) tile[(ty + 4 * i) * 65 + tx] = (oc >= 0) ? v[i] : 0.f;
  __syncthreads();
  const int kx = tid & 31, nyb = tid >> 5;
#pragma unroll
  for (int i = 0; i < 8; ++i) { const int ny = nyb + 8 * i; *(unsigned*)(dst + (size_t)(n0 + ny) * K + k0 + 2 * kx) = pk2(tile[(2 * kx) * 65 + ny], tile[(2 * kx + 1) * 65 + ny]); }
  __syncthreads();
}
DI void phase_wconv(const Params& p, int bid, int nb, char* lds) {
  float* tile = (float*)lds;
  for (int t = bid; t < 2464; t += nb) {
    if (t < 1440) transpose_tile(p.w_in, 5648, (bf16_t*)(p.ws + WS_WIN), 1024, (t / 16) * 64, (t % 16) * 64, true, tile);
    else if (t < 1568) { const int u = t - 1440; transpose_tile(p.fox_w_o, 1024, (bf16_t*)(p.ws + WS_WFO), 512, (u / 8) * 64, (u % 8) * 64, false, tile); }
    else if (t < 1696) { const int u = t - 1568; transpose_tile(p.gdn_w_o, 1024, (bf16_t*)(p.ws + WS_WGO), 512, (u / 8) * 64, (u % 8) * 64, false, tile); }
    else if (t < 1952) { const int u = t - 1696; transpose_tile(p.w_out, 1024, (bf16_t*)(p.ws + WS_WOUT), 1024, (u / 16) * 64, (u % 16) * 64, false, tile); }
    else { const int u = t - 1952; transpose_tile(p.peer_w_query, 2048, (bf16_t*)(p.ws + WS_WQ), 1024, (u / 16) * 64, (u % 16) * 64, false, tile); }
  }
  bf16_t* kd = (bf16_t*)(p.ws + WS_KEYS);
  for (int i = bid * NT + tidx(); i < 32768; i += nb * NT) kd[i] = f2bf(i < 16384 ? p.peer_keys1[i] : p.peer_keys2[i - 16384]);
}
DI unsigned pk4_fp8(float a, float b, float c, float d) { int w = 0; w = __builtin_amdgcn_cvt_pk_fp8_f32(a, b, w, false); w = __builtin_amdgcn_cvt_pk_fp8_f32(c, d, w, true); return (unsigned)w; }
DI void phase_tabconv(const Params& p, int bid, int nb) {
  const int lane = tidx() & 63, gw = bid * 4 + (tidx() >> 6), nw = nb * 4;
  for (int r0 = gw * 4; r0 < 32768; r0 += nw * 4) {
    f32x4 v[4][4];
#pragma unroll
    for (int k = 0; k < 4; ++k) { const int r = r0 + k; const float* src = ((r >= 16384) ? p.peer_v : p.peer_u) + (size_t)(r & 16383) * 1024 + 16 * lane;
#pragma unroll
      for (int i = 0; i < 4; ++i) v[k][i] = *(const f32x4*)(src + 4 * i); }
#pragma unroll
    for (int k = 0; k < 4; ++k) {
      const int r = r0 + k; const bool second = r >= 16384; const int e = r & 16383;
      float am = 0.f;
#pragma unroll
      for (int i = 0; i < 4; ++i) am = fmaxf(am, fmaxf(fmaxf(fabsf(v[k][i][0]), fabsf(v[k][i][1])), fmaxf(fabsf(v[k][i][2]), fabsf(v[k][i][3]))));
#pragma unroll
      for (int d = 32; d >= 1; d >>= 1) am = fmaxf(am, __shfl_xor(am, d));
      float sc = 1.f, inv = 1.f;
      if (am > 1e-30f) { const int ex = (int)floorf(log2f(448.f / am)); sc = exp2f((float)ex); inv = exp2f((float)-ex); }
      u32x4 o;
#pragma unroll
      for (int i = 0; i < 4; ++i) o[i] = pk4_fp8(v[k][i][0] * sc, v[k][i][1] * sc, v[k][i][2] * sc, v[k][i][3] * sc);
      *(u32x4*)(p.ws + (second ? WS_PV : WS_PU) + ((size_t)(lane >> 3) * 16384 + e) * 128 + 16 * (lane & 7)) = o;
      if (lane == 0) ((float*)(p.ws + (second ? WS_VINV : WS_UINV)))[e] = inv;
    }
  }
}

DI void phase_xnorm(const Params& p, int bid, int nb) {
  const int lane = tidx() & 63, gw = bid * 4 + (tidx() >> 6), nw = nb * 4;
  const float* mod = (const float*)(p.ws + WS_MOD);
  bf16_t* h = (bf16_t*)(p.ws + WS_H);
  for (int row0 = gw * 4; row0 < T_; row0 += nw * 4) {
    const int b = row0 >> 13;
    f32x4 v[4][4];
#pragma unroll
    for (int r = 0; r < 4; ++r)
#pragma unroll
      for (int i = 0; i < 4; ++i) v[r][i] = ((const f32x4*)(p.x + (size_t)(row0 + r) * 1024))[lane + 64 * i];
    f32x4 g4[4], sh[4], sc[4];
#pragma unroll
    for (int i = 0; i < 4; ++i) { const int col = 4 * lane + 256 * i; g4[i] = *(const f32x4*)(p.g_pre_mix + col); sh[i] = *(const f32x4*)(mod + b * 6144 + col); sc[i] = *(const f32x4*)(mod + b * 6144 + 1024 + col); }
#pragma unroll
    for (int r = 0; r < 4; ++r) {
      float ss = 0.f;
#pragma unroll
      for (int i = 0; i < 4; ++i) ss += v[r][i][0] * v[r][i][0] + v[r][i][1] * v[r][i][1] + v[r][i][2] * v[r][i][2] + v[r][i][3] * v[r][i][3];
      ss = wave_sum(ss);
      const float rstd = rsqrtf(ss * (1.f / 1024.f) + 1e-6f);
#pragma unroll
      for (int i = 0; i < 4; ++i) {
        const f32x4 y = (v[r][i] * rstd * g4[i]) * (1.f + sc[i]) + sh[i];
        u32x2 o = {pk2(y[0], y[1]), pk2(y[2], y[3])};
        *(u32x2*)(h + (size_t)(row0 + r) * 1024 + 4 * lane + 256 * i) = o;
      }
    }
  }
}

struct GemmArgs { const bf16_t* A; int lda; const bf16_t* Bt; int ldb; int K; };
DI int swz(int row, int c) { return row * 128 + ((c ^ ((row >> 1) & 7)) << 4); }
DI int gsw(int r) { return (0x78 >> (2 * ((r >> 2) & 3))) & 3; }
DI int gswz(int row, int c) { return row * 64 + ((c ^ gsw(row)) << 4); }
template <class Epi>
DI void gemm_tile(const GemmArgs& g, int m0, int n0, char* lds, const Epi& epi) {
  const int tid = tidx(), lane = tid & 63, wid = tid >> 6, wr = wid >> 1, wc = wid & 1, fr = lane & 15, fq = lane >> 4;
  f32x4 acc[8][4];
#pragma unroll
  for (int i = 0; i < 8; ++i)
#pragma unroll
    for (int j = 0; j < 4; ++j) acc[i][j] = (f32x4){0.f, 0.f, 0.f, 0.f};
  const int prow = lane >> 2, pch = (lane & 3) ^ gsw(lane >> 2);
  const bf16_t* ag = g.A + (size_t)(m0 + 64 * wid + prow) * g.lda + 8 * pch;
  const bf16_t* bgp[2];
#pragma unroll
  for (int i = 0; i < 2; ++i) { const int rho = 16 * i + prow; bgp[i] = g.Bt + (size_t)(n0 + 32 * wid + 8 * ((rho & 15) >> 2) + 4 * (rho >> 4) + (rho & 3)) * g.ldb + 8 * pch; }
  const size_t a16 = (size_t)16 * g.lda;
#define GT_ISSUE(kt, st) do { _Pragma("unroll") for (int i = 0; i < 4; ++i) \
      __builtin_amdgcn_global_load_lds((const unsigned*)(ag + i * a16 + (kt) * 32), (LAS unsigned*)(lds + (st) * 24576 + (4 * wid + i) * 1024), 16, 0, 0); \
    _Pragma("unroll") for (int i = 0; i < 2; ++i) \
      __builtin_amdgcn_global_load_lds((const unsigned*)(bgp[i] + (kt) * 32), (LAS unsigned*)(lds + (st) * 24576 + 16384 + (2 * wid + i) * 1024), 16, 0, 0); } while (0)
  const int nk = g.K / 32;
  __syncthreads();
  GT_ISSUE(0, 0); GT_ISSUE(1, 1);
  int st = 0;
#pragma unroll 1
  for (int kt = 0; kt < nk; ++kt) {
    if (kt + 1 < nk) asm volatile("s_waitcnt vmcnt(6)" ::: "memory"); else asm volatile("s_waitcnt vmcnt(0)" ::: "memory");
    __builtin_amdgcn_s_barrier();
    asm volatile("" ::: "memory");
    if (kt + 2 < nk) { const int s2 = st >= 1 ? st - 1 : 2; GT_ISSUE(kt + 2, s2); }
    const char* As = lds + st * 24576; const char* Bs = As + 16384;
    bf16x8 af[8], bfm[4];
#pragma unroll
    for (int i = 0; i < 8; ++i) af[i] = *(const bf16x8*)(As + gswz(wr * 128 + i * 16 + fr, fq));
#pragma unroll
    for (int j = 0; j < 4; ++j) bfm[j] = *(const bf16x8*)(Bs + gswz(wc * 64 + j * 16 + fr, fq));
#pragma unroll
    for (int i = 0; i < 8; ++i)
#pragma unroll
      for (int j = 0; j < 4; ++j) acc[i][j] = MFMA16(bfm[j], af[i], acc[i][j]);
    asm volatile("s_waitcnt lgkmcnt(0)" ::: "memory");
    st = st == 2 ? 0 : st + 1;
  }
#undef GT_ISSUE
#pragma unroll
  for (int i = 0; i < 8; ++i)
#pragma unroll
    for (int jj = 0; jj < 2; ++jj) epi(m0 + wr * 128 + i * 16 + fr, n0 + wc * 64 + jj * 32 + 8 * fq, acc[i][2 * jj], acc[i][2 * jj + 1]);
}

struct TileMap {
  int x, r, R, Nt, ngroups, L;
  DI void init(int bid, int nb, int Nt_) { x = bid & 7; r = bid >> 3; R = nb >> 3; Nt = Nt_; ngroups = (Nt_ + 7) >> 3; L = r; }
  DI bool next(int& m, int& n) {
    for (;;) {
      if (L >= 128 * ngroups) return false;
      const int ng = L >> 7, rem = L & 127, mg = rem >> 6, ni = (rem & 63) >> 3, mi = rem & 7;
      L += R;
      m = 16 * x + 8 * mg + mi; n = 8 * ng + ni;
      if (n < Nt) return true;
    }
  }
};
struct EpiInproj {
  bf16_t* proj; float* small; const float *bbg, *b_fgate, *a_log, *dt_bias;
  DI void operator()(int row, int col, f32x4 v, f32x4 w) const {
    if (col < 3584) { u32x4 o = {pk2(v[0], v[1]), pk2(v[2], v[3]), pk2(w[0], w[1]), pk2(w[2], w[3])}; *(u32x4*)(proj + (size_t)row * PP + col) = o; }
    else if (col < 5632) {
      const f32x4 b = *(const f32x4*)(bbg + (col - 3584)), c = *(const f32x4*)(bbg + (col - 3584) + 4);
      u32x4 o = {pk2(sigmoidf_(v[0] + b[0]), sigmoidf_(v[1] + b[1])), pk2(sigmoidf_(v[2] + b[2]), sigmoidf_(v[3] + b[3])),
                 pk2(sigmoidf_(w[0] + c[0]), sigmoidf_(w[1] + c[1])), pk2(sigmoidf_(w[2] + c[2]), sigmoidf_(w[3] + c[3]))};
      *(u32x4*)(proj + (size_t)row * PP + col) = o;
    } else if (col < 5648) {
      const int j0 = col - 5632;
#pragma unroll
      for (int e = 0; e < 8; ++e) { const int j = j0 + e; const float x = e < 4 ? v[e & 3] : w[e & 3]; float r;
        if (j < 8) r = -softplusf_(-(x + b_fgate[j]));
        else if (j < 12) r = sigmoidf_(x);
        else r = -__expf(a_log[j - 12]) * softplusf_(x + dt_bias[j - 12]);
        small[(size_t)row * 16 + j] = r; }
    }
  }
};
DI void phase_inproj(const Params& p, int bid, int nb, char* lds) {
  GemmArgs g = {(const bf16_t*)(p.ws + WS_H), 1024, (const bf16_t*)(p.ws + WS_WIN), 1024, 1024};
  EpiInproj e = {(bf16_t*)(p.ws + WS_P), (float*)(p.ws + WS_SMALL), p.b_branch_gate, p.b_fgate, p.a_log, p.dt_bias};
  TileMap tm; tm.init(bid, nb, 45); int m, n; while (tm.next(m, n)) gemm_tile(g, m * 256, n * 128, lds, e);
}

DI void phase_foxcum(const Params& p, int bid, int nb, char* lds) {
  float* tot = (float*)lds;
  const float* small = (const float*)(p.ws + WS_SMALL);
  float* fneg = (float*)(p.ws + WS_FNEG);
  const int tid = tidx();
  for (int bh = bid; bh < 32; bh += nb) {
    const int b = bh >> 3, h = bh & 7;
    float v[32]; float run = 0.f;
#pragma unroll
    for (int i = 0; i < 32; ++i) { run += small[((size_t)b * S_ + tid * 32 + i) * 16 + h]; v[i] = run; }
    tot[tid] = run; __syncthreads();
    float off = 0.f; for (int j = 0; j < tid; ++j) off += tot[j];
#pragma unroll
    for (int i = 0; i < 32; ++i) fneg[(size_t)bh * S_ + tid * 32 + i] = -(v[i] + off) * LOG2E;
    __syncthreads();
  }
}
DI void phase_qknorm(const Params& p, int bid, int nb) {
  const int lane = tidx() & 63, gw = bid * 4 + (tidx() >> 6), nw = nb * 4;
  const bf16_t* proj = (const bf16_t*)(p.ws + WS_P);
  unsigned* qk = (unsigned*)(p.ws + WS_CTL) + 64;
  for (int it = gw; it < 4096; it += nw) {
    const int bh = it >> 7, j = it & 127, b = bh >> 3, h = bh & 7;
    const bf16_t* rp = proj + ((size_t)b * S_ + j * 64 + lane) * PP + h * 64;
    float sq = 0.f, sk = 0.f;
#pragma unroll
    for (int q = 0; q < 8; ++q) { const u32x4 wq = *(const u32x4*)(rp + 8 * q), wk = *(const u32x4*)(rp + 512 + 8 * q);
#pragma unroll
      for (int e = 0; e < 4; ++e) { const float a0 = bflo(wq[e]), a1 = bfhi(wq[e]), c0 = bflo(wk[e]), c1 = bfhi(wk[e]); sq += a0 * a0 + a1 * a1; sk += c0 * c0 + c1 * c1; } }
#pragma unroll
    for (int d = 32; d >= 1; d >>= 1) { sq = fmaxf(sq, __shfl_xor(sq, d)); sk = fmaxf(sk, __shfl_xor(sk, d)); }
    if (lane == 0) { atomicMax(qk + 2 * bh, __float_as_uint(sq)); atomicMax(qk + 2 * bh + 1, __float_as_uint(sk)); }
  }
}

DI int swzv(int row, int c) { return row * 128 + ((c ^ (((row >> 1) & 7) ^ ((row & 2) << 1))) << 4); }
DI void attn_unit(const Params& p, int bh, int qb, char* lds) {
  const int tid = tidx(), lane = tid & 63, wid = tid >> 6, r32 = lane & 31, hi = lane >> 5;
  const int b = bh >> 3, h = bh & 7;
  bf16_t* proj = (bf16_t*)(p.ws + WS_P);
  const float* fneg = (const float*)(p.ws + WS_FNEG) + (size_t)bh * S_;
  const size_t rowbase = (size_t)b * S_;
  char* Ks = lds; char* Vs = lds + 8192; float* Fs = (float*)(lds + 16384);
  const LAS char* Vs3 = (const LAS char*)Vs;
  const int qrow = qb * 128 + wid * 32 + r32;
  bf16_t* qptr = proj + (rowbase + qrow) * PP + h * 64;
  bf16x8 qr[4];
  {
    const float c2 = 0.125f * LOG2E;
#pragma unroll
    for (int ks = 0; ks < 4; ++ks) { const u32x4 w = *(const u32x4*)(qptr + ks * 16 + hi * 8);
      qr[ks] = pack8(bflo(w[0]) * c2, bfhi(w[0]) * c2, bflo(w[1]) * c2, bfhi(w[1]) * c2, bflo(w[2]) * c2, bfhi(w[2]) * c2, bflo(w[3]) * c2, bfhi(w[3]) * c2); }
  }
  f32x16 o0, o1;
#pragma unroll
  for (int r = 0; r < 16; ++r) { o0[r] = 0.f; o1[r] = 0.f; }
  float m = -1e30f, l = 0.f;
  const float qkmax = sqrtf(__uint_as_float(((const unsigned*)(p.ws + WS_CTL))[64 + 2 * bh])) * sqrtf(__uint_as_float(((const unsigned*)(p.ws + WS_CTL))[64 + 2 * bh + 1])) * (0.125f * LOG2E * 1.02f);
  int* flags = (int*)(lds + 16384 + 256);
  const int ntiles = 2 * qb + 2;
  const int srow = tid >> 3, sc = tid & 7;
  const bf16_t* kg = proj + (rowbase + srow) * PP + 512 + h * 64 + sc * 8;
  const bf16_t* vg = proj + (rowbase + srow) * PP + 1024 + h * 64 + sc * 8;
  u32x4 rk[2], rv[2]; f32x4 rf = {0.f, 0.f, 0.f, 0.f};
  {
    const int j0 = ntiles - 1;
#pragma unroll
    for (int i = 0; i < 2; ++i) { rk[i] = *(const u32x4*)(kg + (size_t)(j0 * 64 + 32 * i) * PP); rv[i] = *(const u32x4*)(vg + (size_t)(j0 * 64 + 32 * i) * PP); }
    if (tid < 16) rf = *(const f32x4*)(fneg + j0 * 64 + tid * 4);
  }
  if (tid < 8) flags[tid] = 0;
  const int wave_maxrow = qb * 128 + wid * 32 + 31;
  for (int j = ntiles - 1; j >= 0; --j) {
    __syncthreads();
#pragma unroll
    for (int i = 0; i < 2; ++i) { *(u32x4*)(Ks + swz(srow + 32 * i, sc)) = rk[i]; *(u32x4*)(Vs + swzv(srow + 32 * i, sc)) = rv[i]; }
    if (tid < 16) *(f32x4*)(Fs + tid * 4) = rf;
    __syncthreads();
    { const int* fl = flags + 4 * ((j + 1) & 1); if ((fl[0] & fl[1] & fl[2] & fl[3]) != 0) break; }
    float ubf = 0.f;
    if (j > 0) { ubf = fneg[j * 64 - 1]; }
    if (j > 0) {
#pragma unroll
      for (int i = 0; i < 2; ++i) { rk[i] = *(const u32x4*)(kg + (size_t)((j - 1) * 64 + 32 * i) * PP); rv[i] = *(const u32x4*)(vg + (size_t)((j - 1) * 64 + 32 * i) * PP); }
      if (tid < 16) rf = *(const f32x4*)(fneg + (j - 1) * 64 + tid * 4);
    }
    if (j * 64 <= wave_maxrow) {
    f32x16 p0, p1;
#pragma unroll
    for (int g = 0; g < 4; ++g) { const f32x4 a = *(const f32x4*)(Fs + 8 * g + 4 * hi), c = *(const f32x4*)(Fs + 32 + 8 * g + 4 * hi);
#pragma unroll
      for (int e = 0; e < 4; ++e) { p0[4 * g + e] = a[e]; p1[4 * g + e] = c[e]; } }
#pragma unroll
    for (int ks = 0; ks < 4; ++ks) {
      const bf16x8 k0 = *(const bf16x8*)(Ks + swz(r32, 2 * ks + hi)), k1 = *(const bf16x8*)(Ks + swz(32 + r32, 2 * ks + hi));
      p0 = MFMA32(k0, qr[ks], p0); p1 = MFMA32(k1, qr[ks], p1);
    }
    if (j >= 2 * qb) {
      const int kb = j * 64;
#pragma unroll
      for (int r = 0; r < 16; ++r) { const int kv = kb + crow(r, hi); if (kv > qrow) p0[r] = -INFINITY; if (kv + 32 > qrow) p1[r] = -INFINITY; }
    }
    float mx = fmaxf(p0[0], p1[0]);
#pragma unroll
    for (int r = 1; r < 16; ++r) mx = fmaxf(mx, fmaxf(p0[r], p1[r]));
    mx = fmaxf(mx, __shfl_xor(mx, 32));
    const float mn = fmaxf(m, mx), alpha = exp2f(m - mn); m = mn;
    float ps = 0.f;
#pragma unroll
    for (int r = 0; r < 16; ++r) { p0[r] = exp2f(p0[r] - mn); p1[r] = exp2f(p1[r] - mn); ps += p0[r] + p1[r]; }
    l = l * alpha + ps;
#pragma unroll
    for (int r = 0; r < 16; ++r) { o0[r] *= alpha; o1[r] *= alpha; }
    bf16x8 pf[2][2];
    pf[0][0] = pack8(p0[0], p0[1], p0[2], p0[3], p0[4], p0[5], p0[6], p0[7]);
    pf[0][1] = pack8(p0[8], p0[9], p0[10], p0[11], p0[12], p0[13], p0[14], p0[15]);
    pf[1][0] = pack8(p1[0], p1[1], p1[2], p1[3], p1[4], p1[5], p1[6], p1[7]);
    pf[1][1] = pack8(p1[8], p1[9], p1[10], p1[11], p1[12], p1[13], p1[14], p1[15]);
#pragma unroll
    for (int pb = 0; pb < 2; ++pb)
#pragma unroll
      for (int s = 0; s < 2; ++s) {
        const int rowa = 32 * pb + 16 * s + 4 * hi + ((lane & 15) >> 2);
#pragma unroll
        for (int d0 = 0; d0 < 2; ++d0) {
          const int cl = 4 * d0 + 2 * ((lane >> 4) & 1) + ((lane & 3) >> 1), sub = 8 * (lane & 1);
          const s16x4 lo = tr16(Vs3 + swzv(rowa, cl) + sub), hi4 = tr16(Vs3 + swzv(rowa + 8, cl) + sub);
          const bf16x8 vf = cat8(lo, hi4);
          if (d0 == 0) o0 = MFMA32(vf, pf[pb][s], o0); else o1 = MFMA32(vf, pf[pb][s], o1);
        }
      }
    }
    if (j > 0) {
      const float ub = qkmax + ubf + log2f((float)(j * 64));
      const int ok = __all((ub - m) <= -30.f);
      if (lane == 0) flags[4 * (j & 1) + wid] = ok;
    }
  }
  l += __shfl_xor(l, 32);
  const float inv = 1.f / l;
#pragma unroll
  for (int g = 0; g < 4; ++g) {
    u32x2 a = {pk2(o0[4 * g] * inv, o0[4 * g + 1] * inv), pk2(o0[4 * g + 2] * inv, o0[4 * g + 3] * inv)};
    u32x2 c = {pk2(o1[4 * g] * inv, o1[4 * g + 1] * inv), pk2(o1[4 * g + 2] * inv, o1[4 * g + 3] * inv)};
    *(u32x2*)(qptr + 8 * g + 4 * hi) = a; *(u32x2*)(qptr + 32 + 8 * g + 4 * hi) = c;
  }
}
DI void phase_attn(const Params& p, int bid, int nb, char* lds) {
  for (int u = bid; u < 2048; u += nb) attn_unit(p, u & 31, 63 - (u >> 5), lds);
}

constexpr int QP = 136;
DI void gdn_prep_unit(const Params& p, int U, char* lds) {
  const int tid = tidx(), lane = tid & 63, wid = tid >> 6, fr = lane & 15, fq = lane >> 4;
  const int b = U >> 9, h = (U >> 7) & 3, c = U & 127;
  const size_t t0 = (size_t)b * S_ + c * 64;
  const int s0 = c * 64;
  const bf16_t* proj = (const bf16_t*)(p.ws + WS_P);
  const float* small = (const float*)(p.ws + WS_SMALL);
  bf16_t* q_s = (bf16_t*)lds; bf16_t* k_s = q_s + 64 * QP; bf16_t* v_s = k_s + 64 * QP;
  float* Lm = (float*)(lds + 3 * 17408);
  bf16_t* T1 = (bf16_t*)Lm; bf16_t* T2 = T1 + 64 * 72;
  float* gcs = (float*)(lds + 3 * 17408 + 18432);
  bf16_t* QF = (bf16_t*)((char*)p.out) + (size_t)U * 8192;
  bf16_t* KF = (bf16_t*)((char*)p.out + 32 * MiB) + (size_t)U * 8192;
  bf16_t* AF = (bf16_t*)((char*)p.out + 64 * MiB) + (size_t)U * 4096;
  bf16_t* UF = (bf16_t*)(p.ws + WS_UF) + (size_t)U * 8192;
  bf16_t* WF = (bf16_t*)(p.ws + WS_WF) + (size_t)U * 8192;
  __syncthreads();
  if (wid == 0) {
    const float g = small[(t0 + lane) * 16 + 12 + h], bt = small[(t0 + lane) * 16 + 8 + h];
    float cs = g;
#pragma unroll
    for (int d = 1; d < 64; d <<= 1) { const float n = __shfl_up(cs, d); if (lane >= d) cs += n; }
    const float gl = __shfl(cs, 63);
    gcs[lane] = cs; gcs[64 + lane] = bt; gcs[128 + lane] = __expf(cs); gcs[192 + lane] = __expf(gl - cs);
    if (lane == 0) { gcs[256] = __expf(gl); ((float*)(p.ws + WS_GL))[U] = __expf(gl); }
  }
  __syncthreads();
  {
#pragma unroll
    for (int X = 0; X < 3; ++X) {
      const int col = 1536 + 512 * X + h * 128 + 2 * lane, cb = 512 * X + h * 128 + 2 * lane;
      float w0[4], w1[4];
#pragma unroll
      for (int j = 0; j < 4; ++j) { w0[j] = p.conv_w[j * 1536 + cb]; w1[j] = p.conv_w[j * 1536 + cb + 1]; }
      bf16_t* dst = X == 0 ? q_s : (X == 1 ? k_s : v_s);
      const int i0 = 16 * wid;
      unsigned raw[19];
      {
        const bf16_t* sb = proj + ((long)t0 - 3) * PP;
        unsigned vo[19];
#pragma unroll
        for (int j = 0; j < 19; ++j) { const int rr = i0 - 3 + j; const int rc = (s0 + rr >= 0) ? rr : -s0; vo[j] = (unsigned)(((rc + 3) * PP + col) * 2); }
        asm volatile("global_load_dword %0, %10, %20\n\tglobal_load_dword %1, %11, %20\n\tglobal_load_dword %2, %12, %20\n\tglobal_load_dword %3, %13, %20\n\tglobal_load_dword %4, %14, %20\n\t"
                     "global_load_dword %5, %15, %20\n\tglobal_load_dword %6, %16, %20\n\tglobal_load_dword %7, %17, %20\n\tglobal_load_dword %8, %18, %20\n\tglobal_load_dword %9, %19, %20\n\ts_waitcnt vmcnt(0)"
                     : "=&v"(raw[0]), "=&v"(raw[1]), "=&v"(raw[2]), "=&v"(raw[3]), "=&v"(raw[4]), "=&v"(raw[5]), "=&v"(raw[6]), "=&v"(raw[7]), "=&v"(raw[8]), "=&v"(raw[9])
                     : "v"(vo[0]), "v"(vo[1]), "v"(vo[2]), "v"(vo[3]), "v"(vo[4]), "v"(vo[5]), "v"(vo[6]), "v"(vo[7]), "v"(vo[8]), "v"(vo[9]), "s"(sb) : "memory");
        asm volatile("global_load_dword %0, %9, %18\n\tglobal_load_dword %1, %10, %18\n\tglobal_load_dword %2, %11, %18\n\tglobal_load_dword %3, %12, %18\n\tglobal_load_dword %4, %13, %18\n\t"
                     "global_load_dword %5, %14, %18\n\tglobal_load_dword %6, %15, %18\n\tglobal_load_dword %7, %16, %18\n\tglobal_load_dword %8, %17, %18\n\ts_waitcnt vmcnt(0)"
                     : "=&v"(raw[10]), "=&v"(raw[11]), "=&v"(raw[12]), "=&v"(raw[13]), "=&v"(raw[14]), "=&v"(raw[15]), "=&v"(raw[16]), "=&v"(raw[17]), "=&v"(raw[18])
                     : "v"(vo[10]), "v"(vo[11]), "v"(vo[12]), "v"(vo[13]), "v"(vo[14]), "v"(vo[15]), "v"(vo[16]), "v"(vo[17]), "v"(vo[18]), "s"(sb) : "memory");
#pragma unroll
        for (int j = 0; j < 3; ++j) if (s0 + i0 - 3 + j < 0) raw[j] = 0u;
      }
      float y0[16], y1[16], ssr[16];
#pragma unroll
      for (int ii = 0; ii < 16; ++ii) {
        float a0 = w0[0] * bflo(raw[ii]) + w0[1] * bflo(raw[ii + 1]) + w0[2] * bflo(raw[ii + 2]) + w0[3] * bflo(raw[ii + 3]);
        float a1 = w1[0] * bfhi(raw[ii]) + w1[1] * bfhi(raw[ii + 1]) + w1[2] * bfhi(raw[ii + 2]) + w1[3] * bfhi(raw[ii + 3]);
        a0 = a0 * sigmoidf_(a0); a1 = a1 * sigmoidf_(a1);
        y0[ii] = a0; y1[ii] = a1; ssr[ii] = a0 * a0 + a1 * a1;
      }
      if (X < 2) {
#pragma unroll
        for (int d = 32; d >= 1; d >>= 1)
#pragma unroll
          for (int ii = 0; ii < 16; ++ii) ssr[ii] += __shfl_xor(ssr[ii], d);
      }
#pragma unroll
      for (int ii = 0; ii < 16; ++ii) {
        const int i = i0 + ii;
        float a0 = y0[ii], a1 = y1[ii];
        if (X < 2) { const float rn = rsqrtf(ssr[ii] + 1e-6f); a0 *= rn; a1 *= rn; }
        *(unsigned*)(dst + i * QP + 2 * lane) = pk2(a0, a1);
        if (X == 0) {
          const float f = 0.08838834764831845f * gcs[128 + i];
          const int d = 2 * lane, mm = d >> 5, ss2 = (d >> 4) & 1, aa = (d >> 3) & 1, hh = (d >> 2) & 1, bb = d & 3;
          const int lp = (i & 31) + 32 * hh;
          *(unsigned*)(QF + (size_t)(((((i >> 5) * 4 + mm) * 2 + ss2) * 64 + lp) * 8 + 4 * aa + bb)) = pk2(a0 * f, a1 * f);
        }
      }
    }
  }
  __syncthreads();
  {
    bf16x8 ka[4];
#pragma unroll
    for (int kk = 0; kk < 4; ++kk) ka[kk] = *(const bf16x8*)(k_s + (16 * wid + fr) * QP + kk * 32 + fq * 8);
#pragma unroll
    for (int ni = 0; ni < 4; ++ni) {
      f32x4 dkk = {0.f, 0.f, 0.f, 0.f}, dqk = {0.f, 0.f, 0.f, 0.f};
      const int i = 16 * ni + fr, jj0 = 16 * wid + 4 * fq;
      if (ni >= wid) {
#pragma unroll
        for (int kk = 0; kk < 4; ++kk) {
          const bf16x8 bk = *(const bf16x8*)(k_s + (16 * ni + fr) * QP + kk * 32 + fq * 8), bq = *(const bf16x8*)(q_s + (16 * ni + fr) * QP + kk * 32 + fq * 8);
          dkk = MFMA16(ka[kk], bk, dkk); dqk = MFMA16(ka[kk], bq, dqk);
        }
      }
      const float gi = gcs[i], bi = gcs[64 + i];
      f32x4 lv, av;
#pragma unroll
      for (int r = 0; r < 4; ++r) { const int jj = jj0 + r; const float dec = __expf(fminf(gi - gcs[jj], 0.f));
        lv[r] = (jj < i) ? bi * dkk[r] * dec : 0.f; av[r] = (jj <= i) ? dqk[r] * 0.08838834764831845f * dec : 0.f; }
      *(f32x4*)(Lm + i * 68 + jj0) = lv;
      const int lp = (i & 31) + 32 * (fq & 1);
      u32x2 o = {pk2(av[0], av[1]), pk2(av[2], av[3])};
      *(u32x2*)(AF + (size_t)((((((i >> 5) * 2 + (wid >> 1)) * 2 + (wid & 1)) * 64 + lp) * 8) + 4 * (fq >> 1))) = o;
    }
    for (int it = tid; it < 2048; it += NT) {
      const int d = it & 127, jg = it >> 7;
      float v4[4];
#pragma unroll
      for (int e = 0; e < 4; ++e) { const int jj = 4 * jg + e; v4[e] = bf2f(k_s[jj * QP + d]) * gcs[192 + jj]; }
      const int lp = (d & 31) + 32 * (jg & 1);
      u32x2 o = {pk2(v4[0], v4[1]), pk2(v4[2], v4[3])};
      *(u32x2*)(KF + (size_t)((((((d >> 5) * 2 + (jg >> 3)) * 2 + ((jg >> 2) & 1)) * 64 + lp) * 8) + 4 * ((jg >> 1) & 1))) = o;
    }
  }
  __syncthreads();
  {
    float* Ts = (float*)q_s;
    if (wid < 2 && lane < 32) {
      const int o = 32 * wid;
      for (int i = 0; i < 32; ++i) {
        float a0 = (lane == i) ? 1.f : 0.f, a1 = 0.f, a2 = 0.f, a3 = 0.f;
        const float* Li = Lm + (o + i) * 68 + o;
        int j = 0;
#pragma unroll 4
        for (; j + 4 <= i; j += 4) {
          const f32x4 Lv = *(const f32x4*)(Li + j);
          a0 -= Lv[0] * Ts[(o + j) * 64 + o + lane]; a1 -= Lv[1] * Ts[(o + j + 1) * 64 + o + lane]; a2 -= Lv[2] * Ts[(o + j + 2) * 64 + o + lane]; a3 -= Lv[3] * Ts[(o + j + 3) * 64 + o + lane];
        }
        for (; j < i; ++j) a0 -= Li[j] * Ts[(o + j) * 64 + o + lane];
        Ts[(o + i) * 64 + o + lane] = (a0 + a1) + (a2 + a3);
      }
    }
    __syncthreads();
    const int cc = tid & 31, ig = tid >> 5;
    {
      float x0 = 0.f, x1 = 0.f, x2 = 0.f, x3 = 0.f;
#pragma unroll 8
      for (int j = 0; j < 32; ++j) { const float tj = Ts[j * 64 + cc];
        x0 += Lm[(32 + 4 * ig) * 68 + j] * tj; x1 += Lm[(33 + 4 * ig) * 68 + j] * tj; x2 += Lm[(34 + 4 * ig) * 68 + j] * tj; x3 += Lm[(35 + 4 * ig) * 68 + j] * tj; }
      Ts[(4 * ig) * 64 + 32 + cc] = x0; Ts[(4 * ig + 1) * 64 + 32 + cc] = x1; Ts[(4 * ig + 2) * 64 + 32 + cc] = x2; Ts[(4 * ig + 3) * 64 + 32 + cc] = x3;
    }
    __syncthreads();
    {
      float x0 = 0.f, x1 = 0.f, x2 = 0.f, x3 = 0.f;
#pragma unroll 8
      for (int j = 0; j < 32; ++j) { const float xj = Ts[j * 64 + 32 + cc];
        x0 -= Ts[(32 + 4 * ig) * 64 + 32 + j] * xj; x1 -= Ts[(33 + 4 * ig) * 64 + 32 + j] * xj; x2 -= Ts[(34 + 4 * ig) * 64 + 32 + j] * xj; x3 -= Ts[(35 + 4 * ig) * 64 + 32 + j] * xj; }
      Ts[(32 + 4 * ig) * 64 + cc] = x0; Ts[(33 + 4 * ig) * 64 + cc] = x1; Ts[(34 + 4 * ig) * 64 + cc] = x2; Ts[(35 + 4 * ig) * 64 + cc] = x3;
    }
    __syncthreads();
    {
      const int c = tid & 63, rg = tid >> 6;
      const float f1 = gcs[64 + c], f2 = f1 * gcs[128 + c];
      asm volatile("" ::: "memory");
      for (int i = 16 * rg; i < 16 * rg + 16; ++i) { const float t = (i < 32 && c >= 32) ? 0.f : Ts[i * 64 + c]; T1[i * 72 + c] = f2bf(t * f1); T2[i * 72 + c] = f2bf(t * f2); }
    }
  }
  __syncthreads();
  {
    const LAS char* v3 = (const LAS char*)v_s; const LAS char* k3 = (const LAS char*)k_s;
    bf16x8 ta[2], tb[2];
#pragma unroll
    for (int kk = 0; kk < 2; ++kk) { ta[kk] = *(const bf16x8*)(T1 + (16 * wid + fr) * 72 + kk * 32 + fq * 8); tb[kk] = *(const bf16x8*)(T2 + (16 * wid + fr) * 72 + kk * 32 + fq * 8); }
#pragma unroll
    for (int nj = 0; nj < 8; ++nj) {
      f32x4 du = {0.f, 0.f, 0.f, 0.f}, dw = {0.f, 0.f, 0.f, 0.f};
#pragma unroll
      for (int kk = 0; kk < 2; ++kk) {
        const int jr = 32 * kk + 8 * fq + ((lane & 15) >> 2), cc = 16 * nj + 4 * (lane & 3);
        const bf16x8 vb = cat8(tr16(v3 + (jr * QP + cc) * 2), tr16(v3 + ((jr + 4) * QP + cc) * 2));
        const bf16x8 kb = cat8(tr16(k3 + (jr * QP + cc) * 2), tr16(k3 + ((jr + 4) * QP + cc) * 2));
        du = MFMA16(ta[kk], vb, du);
        dw = MFMA16(kb, tb[kk], dw);
      }
      {
        const int lp = 16 * (nj & 1) + fr + 32 * (fq & 1);
        u32x2 o = {pk2(du[0], du[1]), pk2(du[2], du[3])};
        *(u32x2*)(UF + (size_t)(((((wid >> 1) * 4 + (nj >> 1)) * 64 + lp) * 16) + 4 * (2 * (wid & 1) + (fq >> 1)))) = o;
      }
      {
        const int lp = 16 * (wid & 1) + fr + 32 * (fq & 1);
        u32x2 o = {pk2(-dw[0], -dw[1]), pk2(-dw[2], -dw[3])};
        *(u32x2*)(WF + (size_t)((((((wid >> 1) * 4 + (nj >> 1)) * 2 + (nj & 1)) * 64 + lp) * 8) + 4 * (fq >> 1))) = o;
      }
    }
  }
}
DI void phase_gdnprep(const Params& p, int bid, int nb, char* lds) {
  for (int U = bid; U < 2048; U += nb) gdn_prep_unit(p, U, lds);
}

DI bf16x8 packS(const f32x16& x, int s) { return pack8(x[8 * s], x[8 * s + 1], x[8 * s + 2], x[8 * s + 3], x[8 * s + 4], x[8 * s + 5], x[8 * s + 6], x[8 * s + 7]); }
DI void gdn_scan_seq(const Params& p, int bh16, char* lds) {
  const int tid = tidx(), lane = tid & 63, wv = tid >> 6;
  const float* glp = (const float*)(p.ws + WS_GL) + bh16 * 128;
  const char* wf = (const char*)(p.ws + WS_WF) + (size_t)bh16 * 128 * 16384 + tid * 16;
  const char* kf = (const char*)p.out + 32 * MiB + (size_t)bh16 * 128 * 16384 + tid * 16;
  const char* uf = (const char*)(p.ws + WS_UF) + (size_t)bh16 * 128 * 16384 + (size_t)(wv * 64 + lane) * 32;
  char* scp = p.ws + WS_SC + (size_t)bh16 * 128 * 32768 + (size_t)wv * 8192 + lane * 16;
#define SCAN_DMA(gsrc, ldsoff) __builtin_amdgcn_global_load_lds((const unsigned*)(gsrc), (LAS unsigned*)(lds + (ldsoff) + wv * 1024), 16, 0, 0)
#define SCAN_WK(c, slot) do { _Pragma("unroll") for (int i = 0; i < 4; ++i) { SCAN_DMA(wf + (size_t)(c) * 16384 + i * 4096, (slot) * 32768 + i * 4096); SCAN_DMA(kf + (size_t)(c) * 16384 + i * 4096, (slot) * 32768 + 16384 + i * 4096); } } while (0)
#define SCAN_U(c) do { _Pragma("unroll") for (int i2 = 0; i2 < 2; ++i2) { un[2 * i2] = *(const u32x4*)(uf + (size_t)(c) * 16384 + i2 * 8192); un[2 * i2 + 1] = *(const u32x4*)(uf + (size_t)(c) * 16384 + i2 * 8192 + 16); } gln = glp[c]; } while (0)
  f32x16 S[4];
#pragma unroll
  for (int m = 0; m < 4; ++m)
#pragma unroll
    for (int r = 0; r < 16; ++r) S[m][r] = 0.f;
  u32x4 un[4]; float gln;
  __syncthreads();
  SCAN_WK(0, 0); SCAN_U(0);
#pragma unroll 1
  for (int c = 0; c < 128; ++c) {
    __syncthreads();
    f32x16 vn[2];
#pragma unroll
    for (int i2 = 0; i2 < 2; ++i2) {
#pragma unroll
      for (int e = 0; e < 4; ++e) { vn[i2][2 * e] = bflo(un[2 * i2][e]); vn[i2][2 * e + 1] = bfhi(un[2 * i2][e]); vn[i2][8 + 2 * e] = bflo(un[2 * i2 + 1][e]); vn[i2][8 + 2 * e + 1] = bfhi(un[2 * i2 + 1][e]); }
    }
    const float gl = gln;
    asm volatile("" : "+v"(vn[0]), "+v"(vn[1]));
    __builtin_amdgcn_sched_barrier(0);
    if (c + 1 < 128) { SCAN_WK(c + 1, (c + 1) & 1); SCAN_U(c + 1); }
    const char* lw = lds + (c & 1) * 32768 + lane * 16; const char* lk = lw + 16384;
    char* sco = scp + (size_t)c * 32768;
    bf16x8 Sb[4][2];
#pragma unroll
    for (int m = 0; m < 4; ++m) { Sb[m][0] = packS(S[m], 0); Sb[m][1] = packS(S[m], 1); *(bf16x8*)(sco + (m * 2 + 0) * 1024) = Sb[m][0]; *(bf16x8*)(sco + (m * 2 + 1) * 1024) = Sb[m][1]; }
#pragma unroll
    for (int mh = 0; mh < 2; ++mh) {
      bf16x8 f[8];
#pragma unroll
      for (int k = 0; k < 8; ++k) { const int i2 = k >> 2, m = 2 * mh + ((k >> 1) & 1), sx = k & 1; f[k] = *(const bf16x8*)(lw + ((i2 * 4 + m) * 2 + sx) * 1024); }
      __builtin_amdgcn_sched_barrier(0);
#pragma unroll
      for (int q = 0; q < 4; ++q) { const int m = 2 * mh + (q >> 1), sx = q & 1;
        vn[0] = MFMA32(f[q], Sb[m][sx], vn[0]); vn[1] = MFMA32(f[4 + q], Sb[m][sx], vn[1]); }
    }
    bf16x8 Vb[2][2];
#pragma unroll
    for (int j2 = 0; j2 < 2; ++j2) { Vb[j2][0] = packS(vn[j2], 0); Vb[j2][1] = packS(vn[j2], 1); }
#pragma unroll
    for (int m = 0; m < 4; ++m)
#pragma unroll
      for (int r = 0; r < 16; ++r) S[m][r] *= gl;
#pragma unroll
    for (int mh = 0; mh < 2; ++mh) {
      bf16x8 f[8];
#pragma unroll
      for (int k = 0; k < 8; ++k) { const int m = 2 * mh + (k >> 2), j2 = (k >> 1) & 1, sx = k & 1; f[k] = *(const bf16x8*)(lk + ((m * 2 + j2) * 2 + sx) * 1024); }
      __builtin_amdgcn_sched_barrier(0);
#pragma unroll
      for (int q = 0; q < 4; ++q) { const int j2 = q >> 1, sx = q & 1;
        S[2 * mh] = MFMA32(f[q], Vb[j2][sx], S[2 * mh]); S[2 * mh + 1] = MFMA32(f[4 + q], Vb[j2][sx], S[2 * mh + 1]); }
    }
  }
#undef SCAN_DMA
#undef SCAN_WK
#undef SCAN_U
  __syncthreads();
}
DI void gdn_out_unit(const Params& p, int U, char* lds) {
  const int tid = tidx(), lane = tid & 63, wv = tid >> 6, r32 = lane & 31, hi = lane >> 5;
  const int b = U >> 9, h = (U >> 7) & 3, c = U & 127;
  bf16_t* proj = (bf16_t*)(p.ws + WS_P);
  const char* wfg = (const char*)(p.ws + WS_WF) + (size_t)U * 16384 + lane * 16;
  const char* qfg = (const char*)p.out + (size_t)U * 16384 + lane * 16;
  const char* afg = (const char*)p.out + 64 * MiB + (size_t)U * 8192 + lane * 16;
  const bf16_t* UF = (const bf16_t*)(p.ws + WS_UF) + (size_t)U * 8192;
  const bf16x8* SC = (const bf16x8*)(p.ws + WS_SC + (size_t)U * 32768 + (size_t)wv * 8192) + lane;
  bf16_t* ol = (bf16_t*)(lds + 40960);
  __syncthreads();
#pragma unroll
  for (int i = 0; i < 4; ++i) {
    __builtin_amdgcn_global_load_lds((const unsigned*)(wfg + (4 * wv + i) * 1024), (LAS unsigned*)(lds + (4 * wv + i) * 1024), 16, 0, 0);
    __builtin_amdgcn_global_load_lds((const unsigned*)(qfg + (4 * wv + i) * 1024), (LAS unsigned*)(lds + 16384 + (4 * wv + i) * 1024), 16, 0, 0);
  }
#pragma unroll
  for (int i = 0; i < 2; ++i) __builtin_amdgcn_global_load_lds((const unsigned*)(afg + (2 * wv + i) * 1024), (LAS unsigned*)(lds + 32768 + (2 * wv + i) * 1024), 16, 0, 0);
  bf16x8 Sb[4][2];
#pragma unroll
  for (int m = 0; m < 4; ++m) { Sb[m][0] = SC[(m * 2 + 0) * 64]; Sb[m][1] = SC[(m * 2 + 1) * 64]; }
  u32x4 uu[4];
#pragma unroll
  for (int i2 = 0; i2 < 2; ++i2) { uu[2 * i2] = *(const u32x4*)(UF + (size_t)((i2 * 4 + wv) * 64 + lane) * 16); uu[2 * i2 + 1] = *(const u32x4*)(UF + (size_t)((i2 * 4 + wv) * 64 + lane) * 16 + 8); }
  __syncthreads();
  const char* lw = lds + lane * 16; const char* lq = lds + 16384 + lane * 16; const char* la = lds + 32768 + lane * 16;
  f32x16 vn[2], o[2];
#pragma unroll
  for (int i2 = 0; i2 < 2; ++i2) {
#pragma unroll
    for (int e = 0; e < 4; ++e) { vn[i2][2 * e] = bflo(uu[2 * i2][e]); vn[i2][2 * e + 1] = bfhi(uu[2 * i2][e]); vn[i2][8 + 2 * e] = bflo(uu[2 * i2 + 1][e]); vn[i2][8 + 2 * e + 1] = bfhi(uu[2 * i2 + 1][e]); }
#pragma unroll
    for (int r = 0; r < 16; ++r) o[i2][r] = 0.f;
#pragma unroll
    for (int m = 0; m < 4; ++m)
#pragma unroll
      for (int s = 0; s < 2; ++s) {
        vn[i2] = MFMA32(*(const bf16x8*)(lw + ((i2 * 4 + m) * 2 + s) * 1024), Sb[m][s], vn[i2]);
        o[i2] = MFMA32(*(const bf16x8*)(lq + ((i2 * 4 + m) * 2 + s) * 1024), Sb[m][s], o[i2]);
      }
  }
  bf16x8 Vb[2][2];
#pragma unroll
  for (int j2 = 0; j2 < 2; ++j2) { Vb[j2][0] = packS(vn[j2], 0); Vb[j2][1] = packS(vn[j2], 1); }
#pragma unroll
  for (int i2 = 0; i2 < 2; ++i2)
#pragma unroll
    for (int j2 = 0; j2 <= i2; ++j2)
#pragma unroll
      for (int s = 0; s < 2; ++s) o[i2] = MFMA32(*(const bf16x8*)(la + ((i2 * 2 + j2) * 2 + s) * 1024), Vb[j2][s], o[i2]);
  __syncthreads();
#pragma unroll
  for (int i2 = 0; i2 < 2; ++i2)
#pragma unroll
    for (int r = 0; r < 16; ++r) ol[(32 * i2 + crow(r, hi)) * 136 + 32 * wv + r32] = f2bf(o[i2][r]);
  __syncthreads();
  {
    const size_t t0 = (size_t)b * S_ + c * 64;
    const int row = tid >> 2, q4 = tid & 3;
    const bf16_t* gzp = proj + (t0 + row) * PP + 3072 + h * 128 + 32 * q4;
    bf16_t* op = proj + (t0 + row) * PP + 1536 + h * 128 + 32 * q4;
    float ss = 0.f;
#pragma unroll
    for (int q = 0; q < 4; ++q) { const u32x4 w = *(const u32x4*)(ol + row * 136 + 32 * q4 + 8 * q);
#pragma unroll
      for (int e = 0; e < 4; ++e) { const float a0 = bflo(w[e]), a1 = bfhi(w[e]); ss += a0 * a0 + a1 * a1; } }
    ss += __uint_as_float((unsigned)__builtin_amdgcn_update_dpp(0, (int)__float_as_uint(ss), 0xB1, 0xF, 0xF, true));
    ss += __uint_as_float((unsigned)__builtin_amdgcn_update_dpp(0, (int)__float_as_uint(ss), 0x4E, 0xF, 0xF, true));
    const float rstd = rsqrtf(ss * (1.f / 128.f) + 1e-6f);
#pragma unroll
    for (int q = 0; q < 4; ++q) {
      const u32x4 w = *(const u32x4*)(ol + row * 136 + 32 * q4 + 8 * q), gz = *(const u32x4*)(gzp + 8 * q);
      const f32x4 n0 = *(const f32x4*)(p.gdn_norm_w + 32 * q4 + 8 * q), n1 = *(const f32x4*)(p.gdn_norm_w + 32 * q4 + 8 * q + 4);
      float y[8];
#pragma unroll
      for (int e = 0; e < 4; ++e) { const float z0 = bflo(gz[e]), z1 = bfhi(gz[e]);
        const float g0 = (2 * e < 4) ? n0[(2 * e) & 3] : n1[(2 * e) & 3], g1 = (2 * e + 1 < 4) ? n0[(2 * e + 1) & 3] : n1[(2 * e + 1) & 3];
        y[2 * e] = bflo(w[e]) * rstd * g0 * (z0 * sigmoidf_(z0));
        y[2 * e + 1] = bfhi(w[e]) * rstd * g1 * (z1 * sigmoidf_(z1)); }
      u32x4 wv4 = {pk2(y[0], y[1]), pk2(y[2], y[3]), pk2(y[4], y[5]), pk2(y[6], y[7])};
      *(u32x4*)(op + 8 * q) = wv4;
    }
  }
}
DI void phase_gdnout2(const Params& p, int bid, int nb, char* lds) {
  for (int U = bid; U < 2048; U += nb) gdn_out_unit(p, U, lds);
}
DI void phase_gdnout(const Params& p, int bid, int nb) {
  const int lane = tidx() & 63, gw = bid * 4 + (tidx() >> 6), nw = nb * 4;
  bf16_t* proj = (bf16_t*)(p.ws + WS_P);
  const f32x4 w0 = *(const f32x4*)(p.gdn_norm_w + (lane & 15) * 8), w1 = *(const f32x4*)(p.gdn_norm_w + (lane & 15) * 8 + 4);
  for (int row = gw; row < T_; row += nw) {
    bf16_t* op = proj + (size_t)row * PP + 1536 + lane * 8;
    const u32x4 ov = *(const u32x4*)op, zv = *(const u32x4*)(proj + (size_t)row * PP + 3072 + lane * 8);
    float o[8], z[8];
#pragma unroll
    for (int e = 0; e < 4; ++e) { o[2 * e] = bflo(ov[e]); o[2 * e + 1] = bfhi(ov[e]); z[2 * e] = bflo(zv[e]); z[2 * e + 1] = bfhi(zv[e]); }
    float ss = 0.f;
#pragma unroll
    for (int e = 0; e < 8; ++e) ss += o[e] * o[e];
    ss += __shfl_xor(ss, 1); ss += __shfl_xor(ss, 2); ss += __shfl_xor(ss, 4); ss += __shfl_xor(ss, 8);
    const float rstd = rsqrtf(ss * (1.f / 128.f) + 1e-6f);
    float y[8];
#pragma unroll
    for (int e = 0; e < 8; ++e) { const float w = e < 4 ? w0[e] : w1[e - 4]; y[e] = o[e] * rstd * w * (z[e] * sigmoidf_(z[e])); }
    u32x4 r = {pk2(y[0], y[1]), pk2(y[2], y[3]), pk2(y[4], y[5]), pk2(y[6], y[7])};
    *(u32x4*)op = r;
  }
}

struct EpiMergeA {
  const bf16_t* proj; bf16_t* mp;
  DI void operator()(int row, int col, f32x4 v, f32x4 w) const {
    const u32x4 g = *(const u32x4*)(proj + (size_t)row * PP + 3584 + col);
    u32x4 o = {pk2(v[0] * bflo(g[0]), v[1] * bfhi(g[0])), pk2(v[2] * bflo(g[1]), v[3] * bfhi(g[1])), pk2(w[0] * bflo(g[2]), w[1] * bfhi(g[2])), pk2(w[2] * bflo(g[3]), w[3] * bfhi(g[3]))};
    *(u32x4*)(mp + (size_t)row * 1024 + col) = o;
  }
};
struct EpiMergeB {
  const bf16_t* __restrict__ proj; const bf16_t* __restrict__ mpi; bf16_t* __restrict__ mpo;
  DI void operator()(int row, int col, f32x4 v, f32x4 w) const {
    const u32x4 g = *(const u32x4*)(proj + (size_t)row * PP + 4608 + col);
    const u32x4 q = *(const u32x4*)(mpi + (size_t)row * 1024 + col);
    u32x4 o = {pk2(bflo(q[0]) + v[0] * bflo(g[0]), bfhi(q[0]) + v[1] * bfhi(g[0])), pk2(bflo(q[1]) + v[2] * bflo(g[1]), bfhi(q[1]) + v[3] * bfhi(g[1])),
               pk2(bflo(q[2]) + w[0] * bflo(g[2]), bfhi(q[2]) + w[1] * bfhi(g[2])), pk2(bflo(q[3]) + w[2] * bflo(g[3]), bfhi(q[3]) + w[3] * bfhi(g[3]))};
    *(u32x4*)(mpo + (size_t)row * 1024 + col) = o;
  }
};
struct EpiF32 { float* out; int ld; DI void operator()(int row, int col, f32x4 v, f32x4 w) const { *(f32x4*)(out + (size_t)row * ld + col) = v; *(f32x4*)(out + (size_t)row * ld + col + 4) = w; } };
struct EpiBf16 { bf16_t* out; int ld; DI void operator()(int row, int col, f32x4 v, f32x4 w) const { u32x4 o = {pk2(v[0], v[1]), pk2(v[2], v[3]), pk2(w[0], w[1]), pk2(w[2], w[3])}; *(u32x4*)(out + (size_t)row * ld + col) = o; } };
DI void phase_merge(const Params& p, int bid, int nb, char* lds) {
  const bf16_t* proj = (const bf16_t*)(p.ws + WS_P);
  GemmArgs ga = {proj, PP, (const bf16_t*)(p.ws + WS_WFO), 512, 512};
  GemmArgs gb = {proj + 1536, PP, (const bf16_t*)(p.ws + WS_WGO), 512, 512};
  EpiMergeA ea = {proj, (bf16_t*)(p.ws + WS_H)};
  EpiMergeB eb = {proj, (const bf16_t*)(p.ws + WS_H), (bf16_t*)(p.ws + WS_H)};
  TileMap tm; tm.init(bid, nb, 8); int m, n; while (tm.next(m, n)) { gemm_tile(ga, m * 256, n * 128, lds, ea); gemm_tile(gb, m * 256, n * 128, lds, eb); }
}
DI void phase_wout(const Params& p, int bid, int nb, char* lds) {
  GemmArgs g = {(const bf16_t*)(p.ws + WS_H), 1024, (const bf16_t*)(p.ws + WS_WOUT), 1024, 1024};
  EpiF32 e = {p.out, 1024};
  TileMap tm; tm.init(bid, nb, 8); int m, n; while (tm.next(m, n)) gemm_tile(g, m * 256, n * 128, lds, e);
}
DI void phase_rows1(const Params& p, int bid, int nb) {
  const int lane = tidx() & 63, gw = bid * 4 + (tidx() >> 6), nw = nb * 4;
  const float* mod = (const float*)(p.ws + WS_MOD);
  bf16_t* h2 = (bf16_t*)(p.ws + WS_H);
  for (int row0 = gw * 2; row0 < T_; row0 += nw * 2) {
    const int b = row0 >> 13;
    f32x4 v[2][4], xv[2][4];
#pragma unroll
    for (int r = 0; r < 2; ++r)
#pragma unroll
      for (int i = 0; i < 4; ++i) { v[r][i] = ((const f32x4*)(p.out + (size_t)(row0 + r) * 1024))[lane + 64 * i]; xv[r][i] = ((const f32x4*)(p.x + (size_t)(row0 + r) * 1024))[lane + 64 * i]; }
#pragma unroll
    for (int r = 0; r < 2; ++r) {
      f32x4* mr = (f32x4*)(p.out + (size_t)(row0 + r) * 1024);
      float ss = 0.f;
#pragma unroll
      for (int i = 0; i < 4; ++i) ss += v[r][i][0] * v[r][i][0] + v[r][i][1] * v[r][i][1] + v[r][i][2] * v[r][i][2] + v[r][i][3] * v[r][i][3];
      ss = wave_sum(ss);
      const float rstd = rsqrtf(ss * (1.f / 1024.f) + 1e-6f);
      float s2 = 0.f;
#pragma unroll
      for (int i = 0; i < 4; ++i) {
        const int col = 4 * lane + 256 * i;
        const f32x4 g4 = *(const f32x4*)(p.g_post_mix + col), gt = *(const f32x4*)(mod + b * 6144 + 2048 + col);
        v[r][i] = xv[r][i] + gt * (v[r][i] * rstd * g4);
        mr[lane + 64 * i] = v[r][i];
        s2 += v[r][i][0] * v[r][i][0] + v[r][i][1] * v[r][i][1] + v[r][i][2] * v[r][i][2] + v[r][i][3] * v[r][i][3];
      }
      s2 = wave_sum(s2);
      const float rstd2 = rsqrtf(s2 * (1.f / 1024.f) + 1e-6f);
#pragma unroll
      for (int i = 0; i < 4; ++i) {
        const int col = 4 * lane + 256 * i;
        const f32x4 g4 = *(const f32x4*)(p.g_pre_ffn + col), sh = *(const f32x4*)(mod + b * 6144 + 3072 + col), sc = *(const f32x4*)(mod + b * 6144 + 4096 + col);
        const f32x4 y = (v[r][i] * rstd2 * g4) * (1.f + sc) + sh;
        u32x2 o = {pk2(y[0], y[1]), pk2(y[2], y[3])};
        *(u32x2*)(h2 + (size_t)(row0 + r) * 1024 + col) = o;
      }
    }
  }
}

DI void phase_peerq(const Params& p, int bid, int nb, char* lds) {
  GemmArgs g = {(const bf16_t*)(p.ws + WS_H), 1024, (const bf16_t*)(p.ws + WS_WQ), 1024, 1024};
  EpiBf16 e = {(bf16_t*)(p.ws + WS_QY), 2048};
  TileMap tm; tm.init(bid, nb, 16); int m, n; while (tm.next(m, n)) gemm_tile(g, m * 256, n * 128, lds, e);
}
DI unsigned ordkey(float f) { const unsigned u = __float_as_uint(f); return (u & 0x80000000u) ? ~u : (u | 0x80000000u); }
#define CE_DESC(x, y) do { const unsigned mx_ = (x) > (y) ? (x) : (y); const unsigned mn_ = (x) > (y) ? (y) : (x); (x) = mx_; (y) = mn_; } while (0)
DI void sort16_desc(unsigned (&a)[16]) {
#pragma unroll
  for (int k = 2; k <= 16; k <<= 1)
#pragma unroll
    for (int j = k >> 1; j > 0; j >>= 1)
#pragma unroll
      for (int i = 0; i < 16; ++i) {
        const int l = i ^ j;
        if (l > i) { if ((i & k) == 0) CE_DESC(a[i], a[l]); else CE_DESC(a[l], a[i]); }
      }
}
DI void merge16_desc(unsigned (&a)[16], const unsigned (&b)[16]) {
#pragma unroll
  for (int i = 0; i < 16; ++i) a[i] = a[i] > b[15 - i] ? a[i] : b[15 - i];
#pragma unroll
  for (int j = 8; j > 0; j >>= 1)
#pragma unroll
    for (int i = 0; i < 16; ++i) if ((i & j) == 0) CE_DESC(a[i], a[i + j]);
}
template <int CTRL> DI void dpp16(unsigned (&b)[16], const unsigned (&a)[16]) {
#pragma unroll
  for (int s = 0; s < 16; ++s) b[s] = (unsigned)__builtin_amdgcn_update_dpp(0, (int)a[s], CTRL, 0xF, 0xF, true);
}
__device__ const unsigned char PEER_CAND[64] = {
  0x00, 0x01, 0x02, 0x03, 0x04, 0x05, 0x06, 0x07, 0x08, 0x09, 0x0A, 0x0B, 0x0C, 0x0D, 0x0E, 0x0F,
  0x10, 0x11, 0x12, 0x13, 0x14, 0x15, 0x16, 0x17, 0x20, 0x21, 0x22, 0x23, 0x24, 0x80, 0x90, 0xA0,
  0x30, 0x31, 0x32, 0x33, 0x40, 0x41, 0x42, 0x50, 0x51, 0x60, 0x61, 0x70, 0x71, 0xB0, 0xC0, 0xD0,
  0xE0, 0xF0, 0xFF, 0xFF, 0xFF, 0xFF, 0xFF, 0xFF, 0xFF, 0xFF, 0xFF, 0xFF, 0xFF, 0xFF, 0xFF, 0xFF};
DI void peer_select_unit(const Params& p, int unit, char* lds, const bf16x8 (&kb)[4][4]) {
  const int tid = tidx(), lane = tid & 63, wid = tid >> 6, fr = lane & 15, fq = lane >> 4;
  const int h = unit & 7, t0 = (unit >> 3) * 32;
  float* sc = (float*)lds;
  float* topv = (float*)(lds + 64 * 132 * 4);
  int* topi = (int*)(lds + 64 * 132 * 4 + 64 * 16 * 4);
  const bf16_t* qy = (const bf16_t*)(p.ws + WS_QY);
  const bf16_t* keys = (const bf16_t*)(p.ws + WS_KEYS);
  __syncthreads();
  {
    const int set = wid >> 1, kh = wid & 1;
    bf16x8 qa[2][4];
#pragma unroll
    for (int mt = 0; mt < 2; ++mt)
#pragma unroll
      for (int kk = 0; kk < 4; ++kk) qa[mt][kk] = *(const bf16x8*)(qy + (size_t)(t0 + 16 * mt + fr) * 2048 + h * 256 + set * 128 + kk * 32 + fq * 8);
#pragma unroll
    for (int mt = 0; mt < 2; ++mt)
#pragma unroll
      for (int nj = 0; nj < 4; ++nj) {
        f32x4 d = {0.f, 0.f, 0.f, 0.f};
#pragma unroll
        for (int kk = 0; kk < 4; ++kk) d = MFMA16(qa[mt][kk], kb[nj][kk], d);
#pragma unroll
        for (int r = 0; r < 4; ++r) sc[(set * 32 + 16 * mt + 4 * fq + r) * 132 + 64 * kh + 16 * nj + fr] = d[r];
      }
  }
  __syncthreads();
#pragma unroll 1
  for (int pass = 0; pass < 2; ++pass) {
    const int rr = pass * 32 + (tid >> 3), part = tid & 7;
    unsigned a[16], bq[16];
    const float* srow = sc + rr * 132 + 16 * part;
#pragma unroll
    for (int j = 0; j < 4; ++j) {
      const f32x4 v = *(const f32x4*)(srow + 4 * j);
#pragma unroll
      for (int e = 0; e < 4; ++e) a[4 * j + e] = (ordkey(v[e]) & ~127u) | (unsigned)(127 - (16 * part + 4 * j + e));
    }
    sort16_desc(a);
    dpp16<0xB1>(bq, a); merge16_desc(a, bq);
    dpp16<0x4E>(bq, a); merge16_desc(a, bq);
    dpp16<0x141>(bq, a); merge16_desc(a, bq);
#pragma unroll
    for (int s = 0; s < 2; ++s) {
      unsigned k = 0u;
#pragma unroll
      for (int q = 0; q < 8; ++q) k = part == q ? a[2 * q + s] : k;
      const int idx = 127 - (int)(k & 127u);
      topv[rr * 16 + 2 * part + s] = sc[rr * 132 + idx]; topi[rr * 16 + 2 * part + s] = idx;
    }
  }
  __syncthreads();
  if (tid < 128) {
    const int tok = tid >> 2, q4 = tid & 3;
    unsigned c[16], bq[16];
#pragma unroll
    for (int i = 0; i < 16; ++i) {
      const unsigned code = PEER_CAND[16 * q4 + i];
      const float v = topv[tok * 16 + ((code >> 4) & 15)] + topv[(32 + tok) * 16 + (code & 15)];
      c[i] = code == 0xFFu ? 0u : ((ordkey(v) & ~255u) | (255u - code));
    }
    sort16_desc(c);
    dpp16<0xB1>(bq, c); merge16_desc(c, bq);
    dpp16<0x4E>(bq, c); merge16_desc(c, bq);
    float mx; { const int pos = 255 - (int)(c[0] & 255u); mx = topv[tok * 16 + (pos >> 4)] + topv[(32 + tok) * 16 + (pos & 15)]; }
    float val[4]; int ei[4]; float part = 0.f;
#pragma unroll
    for (int s = 0; s < 4; ++s) {
      unsigned k = 0u;
#pragma unroll
      for (int q = 0; q < 4; ++q) k = q4 == q ? c[4 * q + s] : k;
      const int pos = 255 - (int)(k & 255u); const int a = pos >> 4, b = pos & 15;
      const float v = topv[tok * 16 + a] + topv[(32 + tok) * 16 + b]; ei[s] = topi[tok * 16 + a] * 128 + topi[(32 + tok) * 16 + b];
      val[s] = __expf(v - mx); part += val[s];
    }
    part += __uint_as_float((unsigned)__builtin_amdgcn_update_dpp(0, (int)__float_as_uint(part), 0xB1, 0xF, 0xF, true));
    part += __uint_as_float((unsigned)__builtin_amdgcn_update_dpp(0, (int)__float_as_uint(part), 0x4E, 0xF, 0xF, true));
    const float rt = 1.f / part;
    int* eo = (int*)(p.ws + WS_EIDX) + ((size_t)(t0 + tok) * 8 + h) * 16 + 4 * q4; float* go = (float*)(p.ws + WS_GATE) + ((size_t)(t0 + tok) * 8 + h) * 16 + 4 * q4;
    *(f32x4*)go = (f32x4){val[0] * rt, val[1] * rt, val[2] * rt, val[3] * rt};
    typedef int i32x4 __attribute__((ext_vector_type(4)));
    *(i32x4*)eo = (i32x4){ei[0], ei[1], ei[2], ei[3]};
  }
}
DI void phase_peersel(const Params& p, int bid, int nb, char* lds) {
  const int lane = tidx() & 63, wid = tidx() >> 6, fr = lane & 15, fq = lane >> 4;
  const bf16_t* keys = (const bf16_t*)(p.ws + WS_KEYS) + (wid >> 1) * 16384 + (wid & 1) * 64 * 128;
  bf16x8 kb[4][4];
#pragma unroll
  for (int nj = 0; nj < 4; ++nj)
#pragma unroll
    for (int kk = 0; kk < 4; ++kk) kb[nj][kk] = *(const bf16x8*)(keys + (16 * nj + fr) * 128 + kk * 32 + fq * 8);
  for (int u = bid; u < 8192; u += nb) peer_select_unit(p, u, lds, kb);
}
DI float dpp_sum8(float d) {
  d += __uint_as_float((unsigned)__builtin_amdgcn_update_dpp(0, (int)__float_as_uint(d), 0xB1, 0xF, 0xF, true));
  d += __uint_as_float((unsigned)__builtin_amdgcn_update_dpp(0, (int)__float_as_uint(d), 0x4E, 0xF, 0xF, true));
  d += __uint_as_float((unsigned)__builtin_amdgcn_update_dpp(0, (int)__float_as_uint(d), 0x141, 0xF, 0xF, true));
  return d;
}
DI void unpack8x2_fp8(const u32x4 w, f32x2 (&f)[8]) {
#pragma unroll
  for (int i = 0; i < 4; ++i) { f[2 * i] = __builtin_amdgcn_cvt_pk_f32_fp8((int)w[i], false); f[2 * i + 1] = __builtin_amdgcn_cvt_pk_f32_fp8((int)w[i], true); }
}
DI void unpack16_fp8(const u32x4 w, float (&f)[16]) {
#pragma unroll
  for (int i = 0; i < 4; ++i) { const f32x2 lo = __builtin_amdgcn_cvt_pk_f32_fp8((int)w[i], false), hi = __builtin_amdgcn_cvt_pk_f32_fp8((int)w[i], true); f[4 * i] = lo[0]; f[4 * i + 1] = lo[1]; f[4 * i + 2] = hi[0]; f[4 * i + 3] = hi[1]; }
}
typedef int i32x4_t __attribute__((ext_vector_type(4)));
DI void phase_peerdown(const Params& p, int bid, int nb) {
  const int lane = tidx() & 63, wid = tidx() >> 6, e8 = lane >> 3, c = lane & 7;
  const int x = bid & 7, gw = (bid >> 3) * 4 + wid, nw = (nb >> 3) * 4;
  const bf16_t* h2 = (const bf16_t*)(p.ws + WS_H) + 128 * x + 16 * c;
  const char* tab = p.ws + WS_PU + (size_t)x * 16384 * 128 + 16 * c;
  const int* eidx = (const int*)(p.ws + WS_EIDX) + 16 * e8;
  float* pd = (float*)(p.ws + WS_PD) + (size_t)x * T_ * 128 + 16 * e8 + c;
#define PD_IDX(t, E, H) do { _Pragma("unroll") for (int q = 0; q < 4; ++q) E[q] = *(const i32x4_t*)(eidx + (size_t)(t) * 128 + 4 * q); \
    H[0] = *(const u32x4*)(h2 + (size_t)(t) * 1024); H[1] = *(const u32x4*)(h2 + (size_t)(t) * 1024 + 8); } while (0)
#define PD_TAB(E, W) do { _Pragma("unroll") for (int q = 0; q < 16; ++q) W[q] = *(const u32x4*)(tab + (size_t)E[q >> 2][q & 3] * 128); } while (0)
#define PD_MATH(t, W, H) do { f32x2 hx[8]; \
    _Pragma("unroll") for (int e = 0; e < 4; ++e) { hx[e] = (f32x2){bflo(H[0][e]), bfhi(H[0][e])}; hx[4 + e] = (f32x2){bflo(H[1][e]), bfhi(H[1][e])}; } \
    float k0 = 0.f, k1 = 0.f; \
    _Pragma("unroll") for (int q = 0; q < 16; ++q) { f32x2 f[8]; unpack8x2_fp8(W[q], f); f32x2 d2 = f[0] * hx[0]; \
      _Pragma("unroll") for (int i = 1; i < 8; ++i) d2 = __builtin_elementwise_fma(f[i], hx[i], d2); \
      const float d = dpp_sum8(d2[0] + d2[1]); if (c == (q & 7)) { if (q < 8) k0 = d; else k1 = d; } } \
    pd[(size_t)(t) * 128] = k0; pd[(size_t)(t) * 128 + 8] = k1; } while (0)
  i32x4_t eA[4], eB[4]; u32x4 hA[2], hB[2], w[16];
  int t = gw; if (t >= T_) return;
  PD_IDX(t, eA, hA);
  for (;;) {
    PD_TAB(eA, w);
    const int t1 = t + nw; if (t1 < T_) PD_IDX(t1, eB, hB);
    PD_MATH(t, w, hA);
    if (t1 >= T_) break;
    PD_TAB(eB, w);
    const int t2 = t1 + nw; if (t2 < T_) PD_IDX(t2, eA, hA);
    PD_MATH(t1, w, hB);
    if (t2 >= T_) break;
    t = t2;
  }
#undef PD_IDX
#undef PD_TAB
#undef PD_MATH
}
DI void phase_peercoef(const Params& p, int bid, int nb) {
  const float* pd = (const float*)(p.ws + WS_PD);
  const int* eidx = (const int*)(p.ws + WS_EIDX); const float* gate = (const float*)(p.ws + WS_GATE);
  const float* uinv = (const float*)(p.ws + WS_UINV); const float* vinv = (const float*)(p.ws + WS_VINV);
  float* coef = (float*)(p.ws + WS_COEF);
  for (size_t i4 = ((size_t)bid * NT + tidx()) * 4; i4 < (size_t)T_ * 128; i4 += (size_t)nb * NT * 4) {
    f32x4 d = {0.f, 0.f, 0.f, 0.f};
#pragma unroll
    for (int x = 0; x < 8; ++x) d += *(const f32x4*)(pd + (size_t)x * T_ * 128 + i4);
    typedef int i32x4 __attribute__((ext_vector_type(4)));
    const i32x4 e = *(const i32x4*)(eidx + i4); const f32x4 g = *(const f32x4*)(gate + i4);
    f32x4 o;
#pragma unroll
    for (int k = 0; k < 4; ++k) { const float dk = d[k] * uinv[e[k]]; o[k] = g[k] * 0.5f * dk * (1.f + erff(dk * 0.70710678118654752f)) * vinv[e[k]]; }
    *(f32x4*)(coef + i4) = o;
  }
}
DI void phase_peerup(const Params& p, int bid, int nb) {
  const int lane = tidx() & 63, wid = tidx() >> 6, e8 = lane >> 3, c = lane & 7;
  const int x = bid & 7, gw = (bid >> 3) * 4 + wid, nw = (nb >> 3) * 4;
  const char* tab = p.ws + WS_PV + (size_t)x * 16384 * 128 + 16 * c;
  const int* eidx = (const int*)(p.ws + WS_EIDX) + 16 * e8; const float* coef = (const float*)(p.ws + WS_COEF) + 16 * e8;
  float* y2 = (float*)(p.ws + WS_Y2) + 128 * x + 16 * c; float* ssq = (float*)(p.ws + WS_SSQ) + (size_t)x * T_;
#define PU_IDX(t, E, C) do { _Pragma("unroll") for (int q = 0; q < 4; ++q) { E[q] = *(const i32x4_t*)(eidx + (size_t)(t) * 128 + 4 * q); C[q] = *(const f32x4*)(coef + (size_t)(t) * 128 + 4 * q); } } while (0)
#define PU_TAB(E, W) do { _Pragma("unroll") for (int q = 0; q < 16; ++q) W[q] = *(const u32x4*)(tab + (size_t)E[q >> 2][q & 3] * 128); } while (0)
#define PU_MATH(t, W, C) do { f32x2 yp[8]; \
    _Pragma("unroll") for (int i = 0; i < 8; ++i) yp[i] = (f32x2){0.f, 0.f}; \
    _Pragma("unroll") for (int q = 0; q < 16; ++q) { f32x2 f[8]; unpack8x2_fp8(W[q], f); const float cq = C[q >> 2][q & 3]; const f32x2 cc = {cq, cq}; \
      _Pragma("unroll") for (int i = 0; i < 8; ++i) yp[i] = __builtin_elementwise_fma(f[i], cc, yp[i]); } \
    float y[16]; float ss = 0.f; \
    _Pragma("unroll") for (int i = 0; i < 8; ++i) { y[2 * i] = yp[i][0]; y[2 * i + 1] = yp[i][1]; } \
    _Pragma("unroll") for (int i = 0; i < 16; ++i) { y[i] += __shfl_xor(y[i], 8); y[i] += __shfl_xor(y[i], 16); y[i] += __shfl_xor(y[i], 32); ss += y[i] * y[i]; } \
    ss = dpp_sum8(ss); \
    if (e8 == 0) { float* yo = y2 + (size_t)(t) * 1024; \
      _Pragma("unroll") for (int q = 0; q < 4; ++q) *(f32x4*)(yo + 4 * q) = (f32x4){y[4 * q], y[4 * q + 1], y[4 * q + 2], y[4 * q + 3]}; \
      if (c == 0) ssq[t] = ss; } } while (0)
  i32x4_t eA[4], eB[4]; f32x4 cA[4], cB[4]; u32x4 w[16];
  int t = gw; if (t >= T_) return;
  PU_IDX(t, eA, cA);
  for (;;) {
    PU_TAB(eA, w);
    const int t1 = t + nw; if (t1 < T_) PU_IDX(t1, eB, cB);
    PU_MATH(t, w, cA);
    if (t1 >= T_) break;
    PU_TAB(eB, w);
    const int t2 = t1 + nw; if (t2 < T_) PU_IDX(t2, eA, cA);
    PU_MATH(t1, w, cB);
    if (t2 >= T_) break;
    t = t2;
  }
#undef PU_IDX
#undef PU_TAB
#undef PU_MATH
}
DI void phase_final(const Params& p, int bid, int nb) {
  const int lane = tidx() & 63, gw = bid * 4 + (tidx() >> 6), nw = nb * 4;
  const float* mod = (const float*)(p.ws + WS_MOD);
  const float* y2 = (const float*)(p.ws + WS_Y2); const float* ssq = (const float*)(p.ws + WS_SSQ);
  for (int row0 = gw * 2; row0 < T_; row0 += nw * 2) {
    const int b = row0 >> 13;
    f32x4 ov[2][4], yv[2][4]; float ss[2] = {0.f, 0.f};
#pragma unroll
    for (int r = 0; r < 2; ++r) {
#pragma unroll
      for (int i = 0; i < 4; ++i) { ov[r][i] = ((const f32x4*)(p.out + (size_t)(row0 + r) * 1024))[lane + 64 * i]; yv[r][i] = ((const f32x4*)(y2 + (size_t)(row0 + r) * 1024))[lane + 64 * i]; }
#pragma unroll
      for (int x = 0; x < 8; ++x) ss[r] += ssq[(size_t)x * T_ + row0 + r];
    }
#pragma unroll
    for (int r = 0; r < 2; ++r) {
      const float rstd = rsqrtf(ss[r] * (1.f / 1024.f) + 1e-6f);
      f32x4* orow = (f32x4*)(p.out + (size_t)(row0 + r) * 1024);
#pragma unroll
      for (int i = 0; i < 4; ++i) {
        const int col = 4 * lane + 256 * i;
        const f32x4 g4 = *(const f32x4*)(p.g_post_ffn + col), gt = *(const f32x4*)(mod + b * 6144 + 5120 + col);
        orow[lane + 64 * i] = ov[r][i] + gt * (yv[r][i] * rstd * g4);
      }
    }
  }
}

namespace cg = cooperative_groups;
constexpr int LDS_BYTES = 75776;
DI void phase_mixer(const Params& p, int bid, int nb, char* lds) {
  if (bid < 16) gdn_scan_seq(p, bid, lds);
  unsigned* ctr = (unsigned*)(p.ws + WS_CTL);
  int* slot = (int*)(lds + LDS_BYTES - 16);
  for (;;) {
    __syncthreads();
    if (tidx() == 0) *slot = (int)atomicAdd(ctr, 1u);
    __syncthreads();
    const int u = *slot;
    if (u >= 2048) break;
    attn_unit(p, u & 31, 63 - (u >> 5), lds);
  }
}
#define XB_TMO      128
#define XB_XCNT(j)  (256  + 64 * (j))
#define XB_XSUB(j)  (1280 + 64 * (j))
#define XB_XGEN(j)  (2304 + 64 * (j))
#define XB_TOP      3328
#define XB_TOPGEN   3392
#define XCD_BAR_WORDS 3456
#define XB_SPIN_CAP (1u << 22)
DI unsigned xb_ld(unsigned* p)              { return __hip_atomic_load(p, __ATOMIC_RELAXED, __HIP_MEMORY_SCOPE_AGENT); }
DI unsigned xb_add(unsigned* p, unsigned v) { return __hip_atomic_fetch_add(p, v, __ATOMIC_RELAXED, __HIP_MEMORY_SCOPE_AGENT); }
DI unsigned xb_xcc_id() { return (unsigned)__builtin_amdgcn_s_getreg((3 << 11) | 20) & 0xFu; }
#define XB_SPIN(cond, bar) do { unsigned _sp = 0; while (cond) { __builtin_amdgcn_s_sleep(1); \
    if ((++_sp & 255u) == 0u) { if (xb_ld(&(bar)[XB_TMO])) break; if (_sp > XB_SPIN_CAP) { atomicAdd(&(bar)[XB_TMO], 1u); break; } } } } while (0)
struct XcdBarrier { unsigned* bar; unsigned x; volatile LAS unsigned* st; };
DI XcdBarrier xcd_barrier_post(unsigned* bar, volatile LAS unsigned* st) {
  XcdBarrier b; b.bar = bar; b.x = xb_xcc_id(); b.st = st;
  if (threadIdx.x == 0) (void)xb_add(&bar[XB_XCNT(b.x)], 1u);
  return b;
}
DI void xcd_barrier_complete(unsigned* bar, unsigned x, unsigned& nloc, unsigned& nx) {
  const unsigned G = gridDim.x * gridDim.y * gridDim.z;
  unsigned sum, cnt, mine, sp = 0u;
  for (;;) {
    sum = 0u; cnt = 0u; mine = 0u;
#pragma unroll
    for (unsigned j = 0; j < 16; ++j) { const unsigned c = xb_ld(&bar[XB_XCNT(j)]); sum += c; cnt += (c > 0u) ? 1u : 0u; mine = (j == x) ? c : mine; }
    if (sum == G) break;
    __builtin_amdgcn_s_sleep(1);
    if ((++sp & 255u) == 0u) { if (xb_ld(&bar[XB_TMO])) break; if (sp > XB_SPIN_CAP) { atomicAdd(&bar[XB_TMO], 1u); break; } }
  }
  nloc = mine > 0u ? mine : 1u; nx = cnt > 0u ? cnt : 1u;
}
DI void xcd_barrier(const XcdBarrier& b) {
  asm volatile("s_waitcnt vmcnt(0)" ::: "memory");
  __syncthreads();
  if (threadIdx.x == 0) {
    unsigned* bar = b.bar;
    __builtin_amdgcn_s_waitcnt(0);
    unsigned nloc = b.st[0], nx = b.st[1];
    if (nloc == 0u) { xcd_barrier_complete(bar, b.x, nloc, nx); b.st[0] = nloc; b.st[1] = nx; }
    const unsigned old = xb_add(&bar[XB_XSUB(b.x)], 1u);
    const unsigned gen = old / nloc;
    if (old + 1u == (gen + 1u) * nloc) {
      __builtin_amdgcn_fence(__ATOMIC_RELEASE, "agent");
      asm volatile("s_waitcnt vmcnt(0)" ::: "memory");
      const unsigned og = xb_add(&bar[XB_TOP], 1u);
      const unsigned tg = og / nx;
      if (og + 1u == (tg + 1u) * nx) xb_add(&bar[XB_TOPGEN], 1u);
      else XB_SPIN(xb_ld(&bar[XB_TOPGEN]) == tg, bar);
      __builtin_amdgcn_fence(__ATOMIC_ACQUIRE, "agent");
      xb_add(&bar[XB_XGEN(b.x)], 1u);
      asm volatile("s_waitcnt vmcnt(0)" ::: "memory");
    } else {
      XB_SPIN(xb_ld(&bar[XB_XGEN(b.x)]) == gen, bar);
      __builtin_amdgcn_fence(__ATOMIC_ACQUIRE, "agent");
      asm volatile("s_waitcnt vmcnt(0)" ::: "memory");
    }
  }
  __syncthreads();
}

#ifndef PROBE_PHASE
#define PROBE_PHASE -1
#endif
__global__ void __launch_bounds__(NT, 2) fwd(Params p) {
  extern __shared__ __attribute__((aligned(16))) char lds[];
  cg::grid_group grid = cg::this_grid();
  const int bid = blockIdx.x, nb = gridDim.x;
  unsigned long long tprev = 0, tprobe = 0; int nph = 0;
  volatile LAS unsigned* xst = (volatile LAS unsigned*)(lds + LDS_BYTES - 12);
  if (threadIdx.x == 0) { xst[0] = 0u; xst[1] = 0u; }
  unsigned* xbar = (unsigned*)(p.ws + WS_CTL) + 1024;
  if (p.ws == nullptr) grid.sync();
  XcdBarrier xb = xcd_barrier_post(xbar, xst);
#define SEAM() do { xcd_barrier(xb); \
    if (PROBE_PHASE >= 0) { const unsigned long long tn = __builtin_amdgcn_s_memrealtime(); if (nph == PROBE_PHASE) tprobe = tn - tprev; tprev = tn; ++nph; } } while (0)
  if (PROBE_PHASE >= 0) tprev = __builtin_amdgcn_s_memrealtime();
  phase_mod(p, bid, nb, lds); phase_wconv(p, bid, nb, lds);
  SEAM();
  phase_xnorm(p, bid, nb);
  SEAM();
  phase_inproj(p, bid, nb, lds);
  SEAM();
  if (bid < 32) phase_foxcum(p, bid, 32, lds);
  phase_qknorm(p, bid, nb);
  phase_gdnprep(p, bid, nb, lds);
  SEAM();
  phase_mixer(p, bid, nb, lds);
  SEAM();
  phase_gdnout2(p, bid, nb, lds);
  SEAM();
  phase_merge(p, bid, nb, lds);
  SEAM();
  phase_wout(p, bid, nb, lds); phase_tabconv(p, bid, nb);
  SEAM();
  phase_rows1(p, bid, nb);
  SEAM();
  phase_peerq(p, bid, nb, lds);
  SEAM();
  phase_peersel(p, bid, nb, lds);
  SEAM();
  phase_peerdown(p, bid, nb);
  SEAM();
  phase_peercoef(p, bid, nb);
  SEAM();
  phase_peerup(p, bid, nb);
  SEAM();
  phase_final(p, bid, nb);
  if (PROBE_PHASE >= 0) {
    if (PROBE_PHASE == nph) { xcd_barrier(xb); tprobe = __builtin_amdgcn_s_memrealtime() - tprev; }
    if (bid == 0 && tidx() == 0) { const unsigned long long t0 = __builtin_amdgcn_s_memrealtime(); while (__builtin_amdgcn_s_memrealtime() - t0 < tprobe) __builtin_amdgcn_s_sleep(8); }
  }
}

extern "C" void kernel_launch(void* const* d_in, const int* in_sizes, int n_in, void* d_out, int out_size, void* d_ws, size_t ws_size, hipStream_t stream) {
  static int grid_blocks = 0;
  if (!grid_blocks) {
    int dev = 0, cus = 0, per_cu = 0;
    hipGetDevice(&dev);
    hipDeviceGetAttribute(&cus, hipDeviceAttributeMultiprocessorCount, dev);
    (void)hipFuncSetAttribute((const void*)fwd, hipFuncAttributeMaxDynamicSharedMemorySize, LDS_BYTES);
    hipOccupancyMaxActiveBlocksPerMultiprocessor(&per_cu, (const void*)fwd, NT, LDS_BYTES);
    if (per_cu < 1) per_cu = 1;
    if (per_cu > 2) per_cu = 2;
    grid_blocks = cus * per_cu;
  }
  Params p{};
  const float** f = (const float**)&p;
  for (int i = 0; i < 23; ++i) f[i] = (const float*)d_in[i];
  p.out = (float*)d_out; p.ws = (char*)d_ws;
  (void)hipMemsetAsync((char*)d_ws + WS_CTL, 0, 65536, stream);
  void* args[] = {&p};
  hipError_t e = hipLaunchCooperativeKernel((const void*)fwd, dim3(grid_blocks), dim3(NT), args, LDS_BYTES, stream);
  if (e != hipSuccess) fprintf(stderr, "cooperative launch failed: %s (grid %d)\n", hipGetErrorString(e), grid_blocks);
}
```

```cpp
#include <hip/hip_runtime.h>
#include <hip/hip_cooperative_groups.h>
#include <stdint.h>
#include <math.h>
#include <cstdio>

#define DI __device__ __forceinline__
#define LAS __attribute__((address_space(3)))
typedef unsigned short bf16_t;
typedef short bf16x8 __attribute__((ext_vector_type(8)));
typedef short s16x4 __attribute__((ext_vector_type(4)));
typedef float f32x4 __attribute__((ext_vector_type(4)));
typedef float f32x16 __attribute__((ext_vector_type(16)));
typedef float f32x2 __attribute__((ext_vector_type(2)));
typedef unsigned u32x4 __attribute__((ext_vector_type(4)));
typedef unsigned u32x2 __attribute__((ext_vector_type(2)));
typedef __bf16 bf16x2_t __attribute__((ext_vector_type(2)));

constexpr int NT = 256;
constexpr int T_ = 32768, S_ = 8192;
constexpr int PP = 5632;
constexpr int NPAD = 5760;
constexpr float LOG2E = 1.4426950408889634f;
constexpr size_t MiB = 1u << 20;

constexpr size_t WS_CTL = 0;
constexpr size_t WS_MOD = 1 * MiB;
constexpr size_t WS_WIN = 2 * MiB;
constexpr size_t WS_WFO = 14 * MiB;
constexpr size_t WS_WGO = 15 * MiB;
constexpr size_t WS_WOUT = 16 * MiB;
constexpr size_t WS_WQ = 18 * MiB;
constexpr size_t WS_KEYS = 22 * MiB;
constexpr size_t WS_SMALL = 23 * MiB;
constexpr size_t WS_FNEG = 25 * MiB;
constexpr size_t WS_KNPM = 26 * MiB + 65536;
constexpr size_t WS_GL = 26 * MiB;
constexpr size_t WS_SC = 32 * MiB;
constexpr size_t WS_H = 32 * MiB;
constexpr size_t WS_P = 96 * MiB;
constexpr size_t WS_UF = 448 * MiB;
constexpr size_t WS_WF = 480 * MiB;
constexpr size_t WS_QY = 96 * MiB;
constexpr size_t WS_PU = 224 * MiB;
constexpr size_t WS_PV = 240 * MiB;
constexpr size_t WS_UINV = 256 * MiB;
constexpr size_t WS_VINV = 256 * MiB + 65536;
constexpr size_t WS_EIDX = 288 * MiB;
constexpr size_t WS_GATE = 304 * MiB;
constexpr size_t WS_PD = 320 * MiB;
constexpr size_t WS_Y2 = 96 * MiB;
constexpr size_t WS_COEF = 32 * MiB;
constexpr size_t WS_SSQ = 48 * MiB;

DI int tidx() { int t = threadIdx.x; asm volatile("" : "+v"(t)); return t; }
DI unsigned pk2(float lo, float hi) { f32x2 v = {lo, hi}; bf16x2_t b = __builtin_convertvector(v, bf16x2_t); return __builtin_bit_cast(unsigned, b); }
DI bf16_t f2bf(float x) { return (bf16_t)(pk2(x, 0.f) & 0xffffu); }
DI float bf2f(bf16_t v) { return __uint_as_float(((unsigned)v) << 16); }
DI float bflo(unsigned u) { return __uint_as_float(u << 16); }
DI float bfhi(unsigned u) { return __uint_as_float(u & 0xffff0000u); }
DI float wave_sum(float v) {
#pragma unroll
  for (int d = 32; d >= 1; d >>= 1) v += __shfl_xor(v, d);
  return v;
}
DI unsigned wave_max_u(unsigned v) {
#pragma unroll
  for (int d = 32; d >= 1; d >>= 1) { unsigned o = (unsigned)__shfl_xor((int)v, d); v = o > v ? o : v; }
  return v;
}
DI float sigmoidf_(float x) { return __builtin_amdgcn_rcpf(1.f + __expf(-x)); }
DI float softplusf_(float x) { return fmaxf(x, 0.f) + log1pf(__expf(-fabsf(x))); }
DI int crow(int r, int hi) { return (r & 3) + 8 * (r >> 2) + 4 * hi; }
#define MFMA16(a, b, c) __builtin_amdgcn_mfma_f32_16x16x32_bf16((a), (b), (c), 0, 0, 0)
#define MFMA32(a, b, c) __builtin_amdgcn_mfma_f32_32x32x16_bf16((a), (b), (c), 0, 0, 0)
DI s16x4 tr16(const LAS char* p) { typedef short v4i16_t __attribute__((ext_vector_type(4))); return __builtin_bit_cast(s16x4, __builtin_amdgcn_ds_read_tr16_b64_v4i16((LAS v4i16_t*)p)); }
DI bf16x8 cat8(s16x4 lo, s16x4 hi) { return __builtin_shufflevector(lo, hi, 0, 1, 2, 3, 4, 5, 6, 7); }
DI bf16x8 pack8(float a0, float a1, float a2, float a3, float a4, float a5, float a6, float a7) {
  u32x4 p = {pk2(a0, a1), pk2(a2, a3), pk2(a4, a5), pk2(a6, a7)}; return __builtin_bit_cast(bf16x8, p);
}

struct Params {
  const float *x, *c, *w_ada, *b_ada, *g_pre_mix, *g_post_mix, *w_in, *b_fgate, *fox_w_o, *conv_w, *a_log, *dt_bias, *gdn_norm_w, *gdn_w_o,
      *b_branch_gate, *w_out, *g_pre_ffn, *g_post_ffn, *peer_w_query, *peer_keys1, *peer_keys2, *peer_u, *peer_v;
  float* out; char* ws;
};

DI void phase_mod(const Params& p, int bid, int nb, char* lds) {
  float* sc = (float*)lds;
  float* part = sc + 4096;
  const int tid = tidx();
  if (bid >= 192) return;
  for (int i = tid; i < 4096; i += NT) { float v = p.c[i]; sc[i] = v / (1.f + __expf(-v)); }
  __syncthreads();
  float* mod = (float*)(p.ws + WS_MOD);
  for (int g = bid; g < 192; g += nb) {
    const int cc = tid & 31, kg = tid >> 5, col = g * 32 + cc;
    float a0 = 0.f, a1 = 0.f, a2 = 0.f, a3 = 0.f;
#pragma unroll 32
    for (int k = kg; k < 1024; k += 8) { const float w = p.w_ada[(size_t)k * 6144 + col]; a0 += sc[k] * w; a1 += sc[1024 + k] * w; a2 += sc[2048 + k] * w; a3 += sc[3072 + k] * w; }
    part[(kg * 4 + 0) * 32 + cc] = a0; part[(kg * 4 + 1) * 32 + cc] = a1; part[(kg * 4 + 2) * 32 + cc] = a2; part[(kg * 4 + 3) * 32 + cc] = a3;
    __syncthreads();
    if (tid < 128) { const int b = tid >> 5; float s = 0.f;
#pragma unroll
      for (int q = 0; q < 8; ++q) s += part[(q * 4 + b) * 32 + cc];
      mod[b * 6144 + col] = s + p.b_ada[col]; }
    __syncthreads();
  }
}

DI int inproj_colmap(int n) {
  if (n < 1536) return n;
  if (n < 3584) return 1544 + (n - 1536);
  if (n < 5632) return 3600 + (n - 3584);
  if (n < 5640) return 1536 + (n - 5632);
  if (n < 5648) return 3592 + (n - 5640);
  return -1;
}
DI void transpose_tile(const float* src, int ldsrc, bf16_t* dst, int K, int n0, int k0, bool permute, float* tile) {
  const int tid = tidx(), tx = tid & 63, ty = tid >> 6;
  const int n = n0 + tx; const int oc = permute ? inproj_colmap(n) : n;
  const float* sp = src + (size_t)(k0 + ty) * ldsrc + (oc >= 0 ? oc : 0);
  float v[16];
#pragma unroll
  for (int i = 0; i < 16; ++i) v[i] = sp[(size_t)(4 * i) * ldsrc];
#pragma unroll
  for (int i = 0; i < 16; ++i) tile[(ty + 4 * i) * 65 + tx] = (oc >= 0) ? v[i] : 0.f;
  __syncthreads();
  const int kx = tid & 31, nyb = tid >> 5;
#pragma unroll
  for (int i = 0; i < 8; ++i) { const int ny = nyb + 8 * i; *(unsigned*)(dst + (size_t)(n0 + ny) * K + k0 + 2 * kx) = pk2(tile[(2 * kx) * 65 + ny], tile[(2 * kx + 1) * 65 + ny]); }
  __syncthreads();
}
DI void phase_wconv(const Params& p, int bid, int nb, char* lds) {
  float* tile = (float*)lds;
  for (int t = bid; t < 2464; t += nb) {
    if (t < 1440) transpose_tile(p.w_in, 5648, (bf16_t*)(p.ws + WS_WIN), 1024, (t / 16) * 64, (t % 16) * 64, true, tile);
    else if (t < 1568) { const int u = t - 1440; transpose_tile(p.fox_w_o, 1024, (bf16_t*)(p.ws + WS_WFO), 512, (u / 8) * 64, (u % 8) * 64, false, tile); }
    else if (t < 1696) { const int u = t - 1568; transpose_tile(p.gdn_w_o, 1024, (bf16_t*)(p.ws + WS_WGO), 512, (u / 8) * 64, (u % 8) * 64, false, tile); }
    else if (t < 1952) { const int u = t - 1696; transpose_tile(p.w_out, 1024, (bf16_t*)(p.ws + WS_WOUT), 1024, (u / 16) * 64, (u % 16) * 64, false, tile); }
    else { const int u = t - 1952; transpose_tile(p.peer_w_query, 2048, (bf16_t*)(p.ws + WS_WQ), 1024, (u / 16) * 64, (u % 16) * 64, false, tile); }
  }
  bf16_t* kd = (bf16_t*)(p.ws + WS_KEYS);
  for (int i = bid * NT + tidx(); i < 32768; i += nb * NT) kd[i] = f2bf(i < 16384 ? p.peer_keys1[i] : p.peer_keys2[i - 16384]);
}
DI unsigned pk4_fp8(float a, float b, float c, float d) { int w = 0; w = __builtin_amdgcn_cvt_pk_fp8_f32(a, b, w, false); w = __builtin_amdgcn_cvt_pk_fp8_f32(c, d, w, true); return (unsigned)w; }
DI void phase_tabconv(const Params& p, int bid, int nb) {
  const int lane = tidx() & 63, gw = bid * 4 + (tidx() >> 6), nw = nb * 4;
  for (int r0 = gw * 4; r0 < 32768; r0 += nw * 4) {
    f32x4 v[4][4];
#pragma unroll
    for (int k = 0; k < 4; ++k) { const int r = r0 + k; const float* src = ((r >= 16384) ? p.peer_v : p.peer_u) + (size_t)(r & 16383) * 1024 + 16 * lane;
#pragma unroll
      for (int i = 0; i < 4; ++i) v[k][i] = *(const f32x4*)(src + 4 * i); }
#pragma unroll
    for (int k = 0; k < 4; ++k) {
      const int r = r0 + k; const bool second = r >= 16384; const int e = r & 16383;
      float am = 0.f;
#pragma unroll
      for (int i = 0; i < 4; ++i) am = fmaxf(am, fmaxf(fmaxf(fabsf(v[k][i][0]), fabsf(v[k][i][1])), fmaxf(fabsf(v[k][i][2]), fabsf(v[k][i][3]))));
#pragma unroll
      for (int d = 32; d >= 1; d >>= 1) am = fmaxf(am, __shfl_xor(am, d));
      float sc = 1.f, inv = 1.f;
      if (am > 1e-30f) { const int ex = (int)floorf(log2f(448.f / am)); sc = exp2f((float)ex); inv = exp2f((float)-ex); }
      u32x4 o;
#pragma unroll
      for (int i = 0; i < 4; ++i) o[i] = pk4_fp8(v[k][i][0] * sc, v[k][i][1] * sc, v[k][i][2] * sc, v[k][i][3] * sc);
      *(u32x4*)(p.ws + (second ? WS_PV : WS_PU) + ((size_t)(lane >> 3) * 16384 + e) * 128 + 16 * (lane & 7)) = o;
      if (lane == 0) ((float*)(p.ws + (second ? WS_VINV : WS_UINV)))[e] = inv;
    }
  }
}

DI void phase_xnorm(const Params& p, int bid, int nb) {
  const int lane = tidx() & 63, gw = bid * 4 + (tidx() >> 6), nw = nb * 4;
  const float* mod = (const float*)(p.ws + WS_MOD);
  bf16_t* h = (bf16_t*)(p.ws + WS_H);
  for (int row0 = gw * 4; row0 < T_; row0 += nw * 4) {
    const int b = row0 >> 13;
    f32x4 v[4][4];
#pragma unroll
    for (int r = 0; r < 4; ++r)
#pragma unroll
      for (int i = 0; i < 4; ++i) v[r][i] = ((const f32x4*)(p.x + (size_t)(row0 + r) * 1024))[lane + 64 * i];
    f32x4 g4[4], sh[4], sc[4];
#pragma unroll
    for (int i = 0; i < 4; ++i) { const int col = 4 * lane + 256 * i; g4[i] = *(const f32x4*)(p.g_pre_mix + col); sh[i] = *(const f32x4*)(mod + b * 6144 + col); sc[i] = *(const f32x4*)(mod + b * 6144 + 1024 + col); }
#pragma unroll
    for (int r = 0; r < 4; ++r) {
      float ss = 0.f;
#pragma unroll
      for (int i = 0; i < 4; ++i) ss += v[r][i][0] * v[r][i][0] + v[r][i][1] * v[r][i][1] + v[r][i][2] * v[r][i][2] + v[r][i][3] * v[r][i][3];
      ss = wave_sum(ss);
      const float rstd = rsqrtf(ss * (1.f / 1024.f) + 1e-6f);
#pragma unroll
      for (int i = 0; i < 4; ++i) {
        const f32x4 y = (v[r][i] * rstd * g4[i]) * (1.f + sc[i]) + sh[i];
        u32x2 o = {pk2(y[0], y[1]), pk2(y[2], y[3])};
        *(u32x2*)(h + (size_t)(row0 + r) * 1024 + 4 * lane + 256 * i) = o;
      }
    }
  }
}

struct GemmArgs { const bf16_t* A; int lda; const bf16_t* Bt; int ldb; int K; };
DI int swz(int row, int c) { return row * 128 + ((c ^ ((row >> 1) & 7)) << 4); }
DI int gsw(int r) { return (0x78 >> (2 * ((r >> 2) & 3))) & 3; }
DI int gswz(int row, int c) { return row * 64 + ((c ^ gsw(row)) << 4); }
template <class Epi>
DI void gemm_tile(const GemmArgs& g, int m0, int n0, char* lds, const Epi& epi) {
  const int tid = tidx(), lane = tid & 63, wid = tid >> 6, wr = wid >> 1, wc = wid & 1, fr = lane & 15, fq = lane >> 4;
  f32x4 acc[8][4];
#pragma unroll
  for (int i = 0; i < 8; ++i)
#pragma unroll
    for (int j = 0; j < 4; ++j) acc[i][j] = (f32x4){0.f, 0.f, 0.f, 0.f};
  const int prow = lane >> 2, pch = (lane & 3) ^ gsw(lane >> 2);
  const bf16_t* ag = g.A + (size_t)(m0 + 64 * wid + prow) * g.lda + 8 * pch;
  const bf16_t* bgp[2];
#pragma unroll
  for (int i = 0; i < 2; ++i) { const int rho = 16 * i + prow; bgp[i] = g.Bt + (size_t)(n0 + 32 * wid + 8 * ((rho & 15) >> 2) + 4 * (rho >> 4) + (rho & 3)) * g.ldb + 8 * pch; }
  const size_t a16 = (size_t)16 * g.lda;
#define GT_ISSUE(kt, st) do { _Pragma("unroll") for (int i = 0; i < 4; ++i) \
      __builtin_amdgcn_global_load_lds((const unsigned*)(ag + i * a16 + (kt) * 32), (LAS unsigned*)(lds + (st) * 24576 + (4 * wid + i) * 1024), 16, 0, 0); \
    _Pragma("unroll") for (int i = 0; i < 2; ++i) \
      __builtin_amdgcn_global_load_lds((const unsigned*)(bgp[i] + (kt) * 32), (LAS unsigned*)(lds + (st) * 24576 + 16384 + (2 * wid + i) * 1024), 16, 0, 0); } while (0)
  const int nk = g.K / 32;
  __syncthreads();
  GT_ISSUE(0, 0); GT_ISSUE(1, 1);
  int st = 0;
#pragma unroll 1
  for (int kt = 0; kt < nk; ++kt) {
    if (kt + 1 < nk) asm volatile("s_waitcnt vmcnt(6)" ::: "memory"); else asm volatile("s_waitcnt vmcnt(0)" ::: "memory");
    __builtin_amdgcn_s_barrier();
    asm volatile("" ::: "memory");
    const char* As = lds + st * 24576; const char* Bs = As + 16384;
    bf16x8 af[8], bfm[4];
#pragma unroll
    for (int i = 0; i < 8; ++i) af[i] = *(const bf16x8*)(As + gswz(wr * 128 + i * 16 + fr, fq));
#pragma unroll
    for (int j = 0; j < 4; ++j) bfm[j] = *(const bf16x8*)(Bs + gswz(wc * 64 + j * 16 + fr, fq));
    if (kt + 2 < nk) { const int s2 = st >= 1 ? st - 1 : 2; GT_ISSUE(kt + 2, s2); }
    __builtin_amdgcn_s_setprio(1);
#pragma unroll
    for (int i = 0; i < 8; ++i)
#pragma unroll
      for (int j = 0; j < 4; ++j) acc[i][j] = MFMA16(bfm[j], af[i], acc[i][j]);
    __builtin_amdgcn_s_setprio(0);
    asm volatile("s_waitcnt lgkmcnt(0)" ::: "memory");
    st = st == 2 ? 0 : st + 1;
  }
#undef GT_ISSUE
#pragma unroll
  for (int i = 0; i < 8; ++i)
#pragma unroll
    for (int jj = 0; jj < 2; ++jj) epi(m0 + wr * 128 + i * 16 + fr, n0 + wc * 64 + jj * 32 + 8 * fq, acc[i][2 * jj], acc[i][2 * jj + 1]);
}

struct TileMap {
  int x, r, R, Nt, ngroups, L;
  DI void init(int bid, int nb, int Nt_) { x = bid & 7; r = bid >> 3; R = nb >> 3; Nt = Nt_; ngroups = (Nt_ + 7) >> 3; L = r; }
  DI bool next(int& m, int& n) {
    for (;;) {
      if (L >= 128 * ngroups) return false;
      const int ng = L >> 7, rem = L & 127, mg = rem >> 6, ni = (rem & 63) >> 3, mi = rem & 7;
      L += R;
      m = 16 * x + 8 * mg + mi; n = 8 * ng + ni;
      if (n < Nt) return true;
    }
  }
};
struct EpiInproj {
  bf16_t* proj; float* small; const float *bbg, *b_fgate, *a_log, *dt_bias;
  DI void operator()(int row, int col, f32x4 v, f32x4 w) const {
    if (col < 3584) { u32x4 o = {pk2(v[0], v[1]), pk2(v[2], v[3]), pk2(w[0], w[1]), pk2(w[2], w[3])}; *(u32x4*)(proj + (size_t)row * PP + col) = o; }
    else if (col < 5632) {
      const f32x4 b = *(const f32x4*)(bbg + (col - 3584)), c = *(const f32x4*)(bbg + (col - 3584) + 4);
      u32x4 o = {pk2(sigmoidf_(v[0] + b[0]), sigmoidf_(v[1] + b[1])), pk2(sigmoidf_(v[2] + b[2]), sigmoidf_(v[3] + b[3])),
                 pk2(sigmoidf_(w[0] + c[0]), sigmoidf_(w[1] + c[1])), pk2(sigmoidf_(w[2] + c[2]), sigmoidf_(w[3] + c[3]))};
      *(u32x4*)(proj + (size_t)row * PP + col) = o;
    } else if (col < 5648) {
      const int j0 = col - 5632;
#pragma unroll
      for (int e = 0; e < 8; ++e) { const int j = j0 + e; const float x = e < 4 ? v[e & 3] : w[e & 3]; float r;
        if (j < 8) r = -softplusf_(-(x + b_fgate[j]));
        else if (j < 12) r = sigmoidf_(x);
        else r = -__expf(a_log[j - 12]) * softplusf_(x + dt_bias[j - 12]);
        small[(size_t)row * 16 + j] = r; }
    }
  }
};
DI void phase_inproj(const Params& p, int bid, int nb, char* lds) {
  GemmArgs g = {(const bf16_t*)(p.ws + WS_H), 1024, (const bf16_t*)(p.ws + WS_WIN), 1024, 1024};
  EpiInproj e = {(bf16_t*)(p.ws + WS_P), (float*)(p.ws + WS_SMALL), p.b_branch_gate, p.b_fgate, p.a_log, p.dt_bias};
  TileMap tm; tm.init(bid, nb, 45); int m, n; while (tm.next(m, n)) gemm_tile(g, m * 256, n * 128, lds, e);
}

DI void phase_foxcum(const Params& p, int bid, int nb, char* lds) {
  float* tot = (float*)lds;
  const float* small = (const float*)(p.ws + WS_SMALL);
  float* fneg = (float*)(p.ws + WS_FNEG);
  const int tid = tidx();
  for (int bh = bid; bh < 32; bh += nb) {
    const int b = bh >> 3, h = bh & 7;
    float v[32]; float run = 0.f;
#pragma unroll
    for (int i = 0; i < 32; ++i) { run += small[((size_t)b * S_ + tid * 32 + i) * 16 + h]; v[i] = run; }
    tot[tid] = run; __syncthreads();
    float off = 0.f; for (int j = 0; j < tid; ++j) off += tot[j];
#pragma unroll
    for (int i = 0; i < 32; ++i) fneg[(size_t)bh * S_ + tid * 32 + i] = -(v[i] + off) * LOG2E;
    __syncthreads();
  }
}
DI void phase_qknorm(const Params& p, int bid, int nb) {
  const int lane = tidx() & 63, gw = bid * 4 + (tidx() >> 6), nw = nb * 4;
  const bf16_t* proj = (const bf16_t*)(p.ws + WS_P);
  unsigned* qk = (unsigned*)(p.ws + WS_CTL) + 64;
  for (int it = gw; it < 4096; it += nw) {
    const int bh = it >> 7, j = it & 127, b = bh >> 3, h = bh & 7;
    const bf16_t* rp = proj + ((size_t)b * S_ + j * 64 + lane) * PP + h * 64;
    float sq = 0.f, sk = 0.f;
#pragma unroll
    for (int q = 0; q < 8; ++q) { const u32x4 wq = *(const u32x4*)(rp + 8 * q), wk = *(const u32x4*)(rp + 512 + 8 * q);
#pragma unroll
      for (int e = 0; e < 4; ++e) { const float a0 = bflo(wq[e]), a1 = bfhi(wq[e]), c0 = bflo(wk[e]), c1 = bfhi(wk[e]); sq += a0 * a0 + a1 * a1; sk += c0 * c0 + c1 * c1; } }
#pragma unroll
    for (int d = 32; d >= 1; d >>= 1) { sq = fmaxf(sq, __shfl_xor(sq, d)); sk = fmaxf(sk, __shfl_xor(sk, d)); }
    if (lane == 0) { atomicMax(qk + 2 * bh, __float_as_uint(sq)); atomicMax(qk + 2 * bh + 1, __float_as_uint(sk)); }
  }
}

DI int swzv(int row, int c) { return row * 128 + ((c ^ (((row >> 1) & 7) ^ ((row & 2) << 1))) << 4); }
DI void attn_unit(const Params& p, int bh, int qb, char* lds) {
  const int tid = tidx(), lane = tid & 63, wid = tid >> 6, r32 = lane & 31, hi = lane >> 5;
  const int b = bh >> 3, h = bh & 7;
  bf16_t* proj = (bf16_t*)(p.ws + WS_P);
  const float* fneg = (const float*)(p.ws + WS_FNEG) + (size_t)bh * S_;
  const size_t rowbase = (size_t)b * S_;
  char* Ks = lds; char* Vs = lds + 8192; float* Fs = (float*)(lds + 16384);
  const LAS char* Vs3 = (const LAS char*)Vs;
  const int qrow = qb * 128 + wid * 32 + r32;
  bf16_t* qptr = proj + (rowbase + qrow) * PP + h * 64;
  bf16x8 qr[4];
  {
    const float c2 = 0.125f * LOG2E;
#pragma unroll
    for (int ks = 0; ks < 4; ++ks) { const u32x4 w = *(const u32x4*)(qptr + ks * 16 + hi * 8);
      qr[ks] = pack8(bflo(w[0]) * c2, bfhi(w[0]) * c2, bflo(w[1]) * c2, bfhi(w[1]) * c2, bflo(w[2]) * c2, bfhi(w[2]) * c2, bflo(w[3]) * c2, bfhi(w[3]) * c2); }
  }
  f32x16 o0, o1;
#pragma unroll
  for (int r = 0; r < 16; ++r) { o0[r] = 0.f; o1[r] = 0.f; }
  float m = -1e30f, l = 0.f;
  const float qkmax = sqrtf(__uint_as_float(((const unsigned*)(p.ws + WS_CTL))[64 + 2 * bh])) * sqrtf(__uint_as_float(((const unsigned*)(p.ws + WS_CTL))[64 + 2 * bh + 1])) * (0.125f * LOG2E * 1.02f);
  int* flags = (int*)(lds + 16384 + 256);
  const int ntiles = 2 * qb + 2;
  const int srow = tid >> 3, sc = tid & 7;
  const bf16_t* kg = proj + (rowbase + srow) * PP + 512 + h * 64 + sc * 8;
  const bf16_t* vg = proj + (rowbase + srow) * PP + 1024 + h * 64 + sc * 8;
  u32x4 rk[2], rv[2]; f32x4 rf = {0.f, 0.f, 0.f, 0.f};
  {
    const int j0 = ntiles - 1;
#pragma unroll
    for (int i = 0; i < 2; ++i) { rk[i] = *(const u32x4*)(kg + (size_t)(j0 * 64 + 32 * i) * PP); rv[i] = *(const u32x4*)(vg + (size_t)(j0 * 64 + 32 * i) * PP); }
    if (tid < 16) rf = *(const f32x4*)(fneg + j0 * 64 + tid * 4);
  }
  if (tid < 8) flags[tid] = 0;
  const int wave_maxrow = qb * 128 + wid * 32 + 31;
  for (int j = ntiles - 1; j >= 0; --j) {
    __syncthreads();
#pragma unroll
    for (int i = 0; i < 2; ++i) { *(u32x4*)(Ks + swz(srow + 32 * i, sc)) = rk[i]; *(u32x4*)(Vs + swzv(srow + 32 * i, sc)) = rv[i]; }
    if (tid < 16) *(f32x4*)(Fs + tid * 4) = rf;
    __syncthreads();
    { const int* fl = flags + 4 * ((j + 1) & 1); if ((fl[0] & fl[1] & fl[2] & fl[3]) != 0) break; }
    float ubf = 0.f;
    if (j > 0) { ubf = fneg[j * 64 - 1]; }
    if (j > 0) {
#pragma unroll
      for (int i = 0; i < 2; ++i) { rk[i] = *(const u32x4*)(kg + (size_t)((j - 1) * 64 + 32 * i) * PP); rv[i] = *(const u32x4*)(vg + (size_t)((j - 1) * 64 + 32 * i) * PP); }
      if (tid < 16) rf = *(const f32x4*)(fneg + (j - 1) * 64 + tid * 4);
    }
    if (j * 64 <= wave_maxrow) {
    f32x16 p0, p1;
#pragma unroll
    for (int g = 0; g < 4; ++g) { const f32x4 a = *(const f32x4*)(Fs + 8 * g + 4 * hi), c = *(const f32x4*)(Fs + 32 + 8 * g + 4 * hi);
#pragma unroll
      for (int e = 0; e < 4; ++e) { p0[4 * g + e] = a[e]; p1[4 * g + e] = c[e]; } }
#pragma unroll
    for (int ks = 0; ks < 4; ++ks) {
      const bf16x8 k0 = *(const bf16x8*)(Ks + swz(r32, 2 * ks + hi)), k1 = *(const bf16x8*)(Ks + swz(32 + r32, 2 * ks + hi));
      p0 = MFMA32(k0, qr[ks], p0); p1 = MFMA32(k1, qr[ks], p1);
    }
    if (j >= 2 * qb) {
      const int kb = j * 64;
#pragma unroll
      for (int r = 0; r < 16; ++r) { const int kv = kb + crow(r, hi); if (kv > qrow) p0[r] = -INFINITY; if (kv + 32 > qrow) p1[r] = -INFINITY; }
    }
    float mx = fmaxf(p0[0], p1[0]);
#pragma unroll
    for (int r = 1; r < 16; ++r) mx = fmaxf(mx, fmaxf(p0[r], p1[r]));
    mx = fmaxf(mx, __shfl_xor(mx, 32));
    const float mn = fmaxf(m, mx), alpha = exp2f(m - mn); m = mn;
    float ps = 0.f;
#pragma unroll
    for (int r = 0; r < 16; ++r) { p0[r] = exp2f(p0[r] - mn); p1[r] = exp2f(p1[r] - mn); ps += p0[r] + p1[r]; }
    l = l * alpha + ps;
#pragma unroll
    for (int r = 0; r < 16; ++r) { o0[r] *= alpha; o1[r] *= alpha; }
    bf16x8 pf[2][2];
    pf[0][0] = pack8(p0[0], p0[1], p0[2], p0[3], p0[4], p0[5], p0[6], p0[7]);
    pf[0][1] = pack8(p0[8], p0[9], p0[10], p0[11], p0[12], p0[13], p0[14], p0[15]);
    pf[1][0] = pack8(p1[0], p1[1], p1[2], p1[3], p1[4], p1[5], p1[6], p1[7]);
    pf[1][1] = pack8(p1[8], p1[9], p1[10], p1[11], p1[12], p1[13], p1[14], p1[15]);
#pragma unroll
    for (int pb = 0; pb < 2; ++pb)
#pragma unroll
      for (int s = 0; s < 2; ++s) {
        const int rowa = 32 * pb + 16 * s + 4 * hi + ((lane & 15) >> 2);
#pragma unroll
        for (int d0 = 0; d0 < 2; ++d0) {
          const int cl = 4 * d0 + 2 * ((lane >> 4) & 1) + ((lane & 3) >> 1), sub = 8 * (lane & 1);
          const s16x4 lo = tr16(Vs3 + swzv(rowa, cl) + sub), hi4 = tr16(Vs3 + swzv(rowa + 8, cl) + sub);
          const bf16x8 vf = cat8(lo, hi4);
          if (d0 == 0) o0 = MFMA32(vf, pf[pb][s], o0); else o1 = MFMA32(vf, pf[pb][s], o1);
        }
      }
    }
    if (j > 0) {
      const float ub = qkmax + ubf + log2f((float)(j * 64));
      const int ok = __all((ub - m) <= -30.f);
      if (lane == 0) flags[4 * (j & 1) + wid] = ok;
    }
  }
  l += __shfl_xor(l, 32);
  const float inv = 1.f / l;
#pragma unroll
  for (int g = 0; g < 4; ++g) {
    u32x2 a = {pk2(o0[4 * g] * inv, o0[4 * g + 1] * inv), pk2(o0[4 * g + 2] * inv, o0[4 * g + 3] * inv)};
    u32x2 c = {pk2(o1[4 * g] * inv, o1[4 * g + 1] * inv), pk2(o1[4 * g + 2] * inv, o1[4 * g + 3] * inv)};
    *(u32x2*)(qptr + 8 * g + 4 * hi) = a; *(u32x2*)(qptr + 32 + 8 * g + 4 * hi) = c;
  }
}
DI void phase_attn(const Params& p, int bid, int nb, char* lds) {
  for (int u = bid; u < 2048; u += nb) attn_unit(p, u & 31, 63 - (u >> 5), lds);
}

constexpr int QP = 136;
DI void gdn_prep_unit(const Params& p, int U, char* lds) {
  const int tid = tidx(), lane = tid & 63, wid = tid >> 6, fr = lane & 15, fq = lane >> 4;
  const int b = U >> 9, h = (U >> 7) & 3, c = U & 127;
  const size_t t0 = (size_t)b * S_ + c * 64;
  const int s0 = c * 64;
  const bf16_t* proj = (const bf16_t*)(p.ws + WS_P);
  const float* small = (const float*)(p.ws + WS_SMALL);
  bf16_t* q_s = (bf16_t*)lds; bf16_t* k_s = q_s + 64 * QP; bf16_t* v_s = k_s + 64 * QP;
  float* Lm = (float*)(lds + 3 * 17408);
  bf16_t* T1 = (bf16_t*)Lm; bf16_t* T2 = T1 + 64 * 72;
  float* gcs = (float*)(lds + 3 * 17408 + 18432);
  bf16_t* QF = (bf16_t*)((char*)p.out) + (size_t)U * 8192;
  bf16_t* KF = (bf16_t*)((char*)p.out + 32 * MiB) + (size_t)U * 8192;
  bf16_t* AF = (bf16_t*)((char*)p.out + 64 * MiB) + (size_t)U * 4096;
  bf16_t* UF = (bf16_t*)(p.ws + WS_UF) + (size_t)U * 8192;
  bf16_t* WF = (bf16_t*)(p.ws + WS_WF) + (size_t)U * 8192;
  __syncthreads();
  if (wid == 0) {
    const float g = small[(t0 + lane) * 16 + 12 + h], bt = small[(t0 + lane) * 16 + 8 + h];
    float cs = g;
#pragma unroll
    for (int d = 1; d < 64; d <<= 1) { const float n = __shfl_up(cs, d); if (lane >= d) cs += n; }
    const float gl = __shfl(cs, 63);
    gcs[lane] = cs; gcs[64 + lane] = bt; gcs[128 + lane] = __expf(cs); gcs[192 + lane] = __expf(gl - cs);
    if (lane == 0) { gcs[256] = __expf(gl); ((float*)(p.ws + WS_GL))[U] = __expf(gl); }
  }
  __syncthreads();
  {
#pragma unroll
    for (int X = 0; X < 3; ++X) {
      const int col = 1536 + 512 * X + h * 128 + 2 * lane, cb = 512 * X + h * 128 + 2 * lane;
      float w0[4], w1[4];
#pragma unroll
      for (int j = 0; j < 4; ++j) { w0[j] = p.conv_w[j * 1536 + cb]; w1[j] = p.conv_w[j * 1536 + cb + 1]; }
      bf16_t* dst = X == 0 ? q_s : (X == 1 ? k_s : v_s);
      const int i0 = 16 * wid;
      unsigned raw[19];
      {
        const bf16_t* sb = proj + ((long)t0 - 3) * PP;
        unsigned vo[19];
#pragma unroll
        for (int j = 0; j < 19; ++j) { const int rr = i0 - 3 + j; const int rc = (s0 + rr >= 0) ? rr : -s0; vo[j] = (unsigned)(((rc + 3) * PP + col) * 2); }
        asm volatile("global_load_dword %0, %10, %20\n\tglobal_load_dword %1, %11, %20\n\tglobal_load_dword %2, %12, %20\n\tglobal_load_dword %3, %13, %20\n\tglobal_load_dword %4, %14, %20\n\t"
                     "global_load_dword %5, %15, %20\n\tglobal_load_dword %6, %16, %20\n\tglobal_load_dword %7, %17, %20\n\tglobal_load_dword %8, %18, %20\n\tglobal_load_dword %9, %19, %20\n\ts_waitcnt vmcnt(0)"
                     : "=&v"(raw[0]), "=&v"(raw[1]), "=&v"(raw[2]), "=&v"(raw[3]), "=&v"(raw[4]), "=&v"(raw[5]), "=&v"(raw[6]), "=&v"(raw[7]), "=&v"(raw[8]), "=&v"(raw[9])
                     : "v"(vo[0]), "v"(vo[1]), "v"(vo[2]), "v"(vo[3]), "v"(vo[4]), "v"(vo[5]), "v"(vo[6]), "v"(vo[7]), "v"(vo[8]), "v"(vo[9]), "s"(sb) : "memory");
        asm volatile("global_load_dword %0, %9, %18\n\tglobal_load_dword %1, %10, %18\n\tglobal_load_dword %2, %11, %18\n\tglobal_load_dword %3, %12, %18\n\tglobal_load_dword %4, %13, %18\n\t"
                     "global_load_dword %5, %14, %18\n\tglobal_load_dword %6, %15, %18\n\tglobal_load_dword %7, %16, %18\n\tglobal_load_dword %8, %17, %18\n\ts_waitcnt vmcnt(0)"
                     : "=&v"(raw[10]), "=&v"(raw[11]), "=&v"(raw[12]), "=&v"(raw[13]), "=&v"(raw[14]), "=&v"(raw[15]), "=&v"(raw[16]), "=&v"(raw[17]), "=&v"(raw[18])
                     : "v"(vo[10]), "v"(vo[11]), "v"(vo[12]), "v"(vo[13]), "v"(vo[14]), "v"(vo[15]), "v"(vo[16]), "v"(vo[17]), "v"(vo[18]), "s"(sb) : "memory");
#pragma unroll
        for (int j = 0; j < 3; ++j) if (s0 + i0 - 3 + j < 0) raw[j] = 0u;
      }
      float y0[16], y1[16], ssr[16];
#pragma unroll
      for (int ii = 0; ii < 16; ++ii) {
        float a0 = w0[0] * bflo(raw[ii]) + w0[1] * bflo(raw[ii + 1]) + w0[2] * bflo(raw[ii + 2]) + w0[3] * bflo(raw[ii + 3]);
        float a1 = w1[0] * bfhi(raw[ii]) + w1[1] * bfhi(raw[ii + 1]) + w1[2] * bfhi(raw[ii + 2]) + w1[3] * bfhi(raw[ii + 3]);
        a0 = a0 * sigmoidf_(a0); a1 = a1 * sigmoidf_(a1);
        y0[ii] = a0; y1[ii] = a1; ssr[ii] = a0 * a0 + a1 * a1;
      }
      if (X < 2) {
#pragma unroll
        for (int d = 32; d >= 1; d >>= 1)
#pragma unroll
          for (int ii = 0; ii < 16; ++ii) ssr[ii] += __shfl_xor(ssr[ii], d);
      }
#pragma unroll
      for (int ii = 0; ii < 16; ++ii) {
        const int i = i0 + ii;
        float a0 = y0[ii], a1 = y1[ii];
        if (X < 2) { const float rn = rsqrtf(ssr[ii] + 1e-6f); a0 *= rn; a1 *= rn; }
        *(unsigned*)(dst + i * QP + 2 * lane) = pk2(a0, a1);
        if (X == 0) {
          const float f = 0.08838834764831845f * gcs[128 + i];
          const int d = 2 * lane, mm = d >> 5, ss2 = (d >> 4) & 1, aa = (d >> 3) & 1, hh = (d >> 2) & 1, bb = d & 3;
          const int lp = (i & 31) + 32 * hh;
          *(unsigned*)(QF + (size_t)(((((i >> 5) * 4 + mm) * 2 + ss2) * 64 + lp) * 8 + 4 * aa + bb)) = pk2(a0 * f, a1 * f);
        }
      }
    }
  }
  __syncthreads();
  {
    bf16x8 ka[4];
#pragma unroll
    for (int kk = 0; kk < 4; ++kk) ka[kk] = *(const bf16x8*)(k_s + (16 * wid + fr) * QP + kk * 32 + fq * 8);
#pragma unroll
    for (int ni = 0; ni < 4; ++ni) {
      f32x4 dkk = {0.f, 0.f, 0.f, 0.f}, dqk = {0.f, 0.f, 0.f, 0.f};
      const int i = 16 * ni + fr, jj0 = 16 * wid + 4 * fq;
      if (ni >= wid) {
#pragma unroll
        for (int kk = 0; kk < 4; ++kk) {
          const bf16x8 bk = *(const bf16x8*)(k_s + (16 * ni + fr) * QP + kk * 32 + fq * 8), bq = *(const bf16x8*)(q_s + (16 * ni + fr) * QP + kk * 32 + fq * 8);
          dkk = MFMA16(ka[kk], bk, dkk); dqk = MFMA16(ka[kk], bq, dqk);
        }
      }
      const float gi = gcs[i], bi = gcs[64 + i];
      f32x4 lv, av;
#pragma unroll
      for (int r = 0; r < 4; ++r) { const int jj = jj0 + r; const float dec = __expf(fminf(gi - gcs[jj], 0.f));
        lv[r] = (jj < i) ? bi * dkk[r] * dec : 0.f; av[r] = (jj <= i) ? dqk[r] * 0.08838834764831845f * dec : 0.f; }
      *(f32x4*)(Lm + i * 68 + jj0) = lv;
      const int lp = (i & 31) + 32 * (fq & 1);
      u32x2 o = {pk2(av[0], av[1]), pk2(av[2], av[3])};
      *(u32x2*)(AF + (size_t)((((((i >> 5) * 2 + (wid >> 1)) * 2 + (wid & 1)) * 64 + lp) * 8) + 4 * (fq >> 1))) = o;
    }
    for (int it = tid; it < 2048; it += NT) {
      const int d = it & 127, jg = it >> 7;
      float v4[4];
#pragma unroll
      for (int e = 0; e < 4; ++e) { const int jj = 4 * jg + e; v4[e] = bf2f(k_s[jj * QP + d]) * gcs[192 + jj]; }
      const int lp = (d & 31) + 32 * (jg & 1);
      u32x2 o = {pk2(v4[0], v4[1]), pk2(v4[2], v4[3])};
      *(u32x2*)(KF + (size_t)((((((d >> 5) * 2 + (jg >> 3)) * 2 + ((jg >> 2) & 1)) * 64 + lp) * 8) + 4 * ((jg >> 1) & 1))) = o;
    }
  }
  __syncthreads();
  {
    float* Ts = (float*)q_s;
    if (wid < 2 && lane < 32) {
      const int o = 32 * wid;
      for (int i = 0; i < 32; ++i) {
        float a0 = (lane == i) ? 1.f : 0.f, a1 = 0.f, a2 = 0.f, a3 = 0.f;
        const float* Li = Lm + (o + i) * 68 + o;
        int j = 0;
#pragma unroll 4
        for (; j + 4 <= i; j += 4) {
          const f32x4 Lv = *(const f32x4*)(Li + j);
          a0 -= Lv[0] * Ts[(o + j) * 64 + o + lane]; a1 -= Lv[1] * Ts[(o + j + 1) * 64 + o + lane]; a2 -= Lv[2] * Ts[(o + j + 2) * 64 + o + lane]; a3 -= Lv[3] * Ts[(o + j + 3) * 64 + o + lane];
        }
        for (; j < i; ++j) a0 -= Li[j] * Ts[(o + j) * 64 + o + lane];
        Ts[(o + i) * 64 + o + lane] = (a0 + a1) + (a2 + a3);
      }
    }
    __syncthreads();
    const int cc = tid & 31, ig = tid >> 5;
    {
      float x0 = 0.f, x1 = 0.f, x2 = 0.f, x3 = 0.f;
#pragma unroll 8
      for (int j = 0; j < 32; ++j) { const float tj = Ts[j * 64 + cc];
        x0 += Lm[(32 + 4 * ig) * 68 + j] * tj; x1 += Lm[(33 + 4 * ig) * 68 + j] * tj; x2 += Lm[(34 + 4 * ig) * 68 + j] * tj; x3 += Lm[(35 + 4 * ig) * 68 + j] * tj; }
      Ts[(4 * ig) * 64 + 32 + cc] = x0; Ts[(4 * ig + 1) * 64 + 32 + cc] = x1; Ts[(4 * ig + 2) * 64 + 32 + cc] = x2; Ts[(4 * ig + 3) * 64 + 32 + cc] = x3;
    }
    __syncthreads();
    {
      float x0 = 0.f, x1 = 0.f, x2 = 0.f, x3 = 0.f;
#pragma unroll 8
      for (int j = 0; j < 32; ++j) { const float xj = Ts[j * 64 + 32 + cc];
        x0 -= Ts[(32 + 4 * ig) * 64 + 32 + j] * xj; x1 -= Ts[(33 + 4 * ig) * 64 + 32 + j] * xj; x2 -= Ts[(34 + 4 * ig) * 64 + 32 + j] * xj; x3 -= Ts[(35 + 4 * ig) * 64 + 32 + j] * xj; }
      Ts[(32 + 4 * ig) * 64 + cc] = x0; Ts[(33 + 4 * ig) * 64 + cc] = x1; Ts[(34 + 4 * ig) * 64 + cc] = x2; Ts[(35 + 4 * ig) * 64 + cc] = x3;
    }
    __syncthreads();
    {
      const int c = tid & 63, rg = tid >> 6;
      const float f1 = gcs[64 + c], f2 = f1 * gcs[128 + c];
      asm volatile("" ::: "memory");
      for (int i = 16 * rg; i < 16 * rg + 16; ++i) { const float t = (i < 32 && c >= 32) ? 0.f : Ts[i * 64 + c]; T1[i * 72 + c] = f2bf(t * f1); T2[i * 72 + c] = f2bf(t * f2); }
    }
  }
  __syncthreads();
  {
    const LAS char* v3 = (const LAS char*)v_s; const LAS char* k3 = (const LAS char*)k_s;
    bf16x8 ta[2], tb[2];
#pragma unroll
    for (int kk = 0; kk < 2; ++kk) { ta[kk] = *(const bf16x8*)(T1 + (16 * wid + fr) * 72 + kk * 32 + fq * 8); tb[kk] = *(const bf16x8*)(T2 + (16 * wid + fr) * 72 + kk * 32 + fq * 8); }
#pragma unroll
    for (int nj = 0; nj < 8; ++nj) {
      f32x4 du = {0.f, 0.f, 0.f, 0.f}, dw = {0.f, 0.f, 0.f, 0.f};
#pragma unroll
      for (int kk = 0; kk < 2; ++kk) {
        const int jr = 32 * kk + 8 * fq + ((lane & 15) >> 2), cc = 16 * nj + 4 * (lane & 3);
        const bf16x8 vb = cat8(tr16(v3 + (jr * QP + cc) * 2), tr16(v3 + ((jr + 4) * QP + cc) * 2));
        const bf16x8 kb = cat8(tr16(k3 + (jr * QP + cc) * 2), tr16(k3 + ((jr + 4) * QP + cc) * 2));
        du = MFMA16(ta[kk], vb, du);
        dw = MFMA16(kb, tb[kk], dw);
      }
      {
        const int lp = 16 * (nj & 1) + fr + 32 * (fq & 1);
        u32x2 o = {pk2(du[0], du[1]), pk2(du[2], du[3])};
        *(u32x2*)(UF + (size_t)(((((wid >> 1) * 4 + (nj >> 1)) * 64 + lp) * 16) + 4 * (2 * (wid & 1) + (fq >> 1)))) = o;
      }
      {
        const int lp = 16 * (wid & 1) + fr + 32 * (fq & 1);
        u32x2 o = {pk2(-dw[0], -dw[1]), pk2(-dw[2], -dw[3])};
        *(u32x2*)(WF + (size_t)((((((wid >> 1) * 4 + (nj >> 1)) * 2 + (nj & 1)) * 64 + lp) * 8) + 4 * (fq >> 1))) = o;
      }
    }
  }
}
DI void phase_gdnprep(const Params& p, int bid, int nb, char* lds) {
  for (int U = bid; U < 2048; U += nb) gdn_prep_unit(p, U, lds);
}

DI bf16x8 packS(const f32x16& x, int s) { return pack8(x[8 * s], x[8 * s + 1], x[8 * s + 2], x[8 * s + 3], x[8 * s + 4], x[8 * s + 5], x[8 * s + 6], x[8 * s + 7]); }
DI void gdn_scan_seq(const Params& p, int bh16, char* lds) {
  const int tid = tidx(), lane = tid & 63, wv = tid >> 6;
  const float* glp = (const float*)(p.ws + WS_GL) + bh16 * 128;
  const char* wf = (const char*)(p.ws + WS_WF) + (size_t)bh16 * 128 * 16384 + tid * 16;
  const char* kf = (const char*)p.out + 32 * MiB + (size_t)bh16 * 128 * 16384 + tid * 16;
  const char* uf = (const char*)(p.ws + WS_UF) + (size_t)bh16 * 128 * 16384 + (size_t)(wv * 64 + lane) * 32;
  char* scp = p.ws + WS_SC + (size_t)bh16 * 128 * 32768 + (size_t)wv * 8192 + lane * 16;
#define SCAN_DMA(gsrc, ldsoff) __builtin_amdgcn_global_load_lds((const unsigned*)(gsrc), (LAS unsigned*)(lds + (ldsoff) + wv * 1024), 16, 0, 0)
#define SCAN_WK(c, slot) do { _Pragma("unroll") for (int i = 0; i < 4; ++i) { SCAN_DMA(wf + (size_t)(c) * 16384 + i * 4096, (slot) * 32768 + i * 4096); SCAN_DMA(kf + (size_t)(c) * 16384 + i * 4096, (slot) * 32768 + 16384 + i * 4096); } } while (0)
#define SCAN_U(c) do { _Pragma("unroll") for (int i2 = 0; i2 < 2; ++i2) { un[2 * i2] = *(const u32x4*)(uf + (size_t)(c) * 16384 + i2 * 8192); un[2 * i2 + 1] = *(const u32x4*)(uf + (size_t)(c) * 16384 + i2 * 8192 + 16); } gln = glp[c]; } while (0)
  f32x16 S[4];
#pragma unroll
  for (int m = 0; m < 4; ++m)
#pragma unroll
    for (int r = 0; r < 16; ++r) S[m][r] = 0.f;
  u32x4 un[4]; float gln;
  __syncthreads();
  SCAN_WK(0, 0); SCAN_U(0);
#pragma unroll 1
  for (int c = 0; c < 128; ++c) {
    __syncthreads();
    f32x16 vn[2];
#pragma unroll
    for (int i2 = 0; i2 < 2; ++i2) {
#pragma unroll
      for (int e = 0; e < 4; ++e) { vn[i2][2 * e] = bflo(un[2 * i2][e]); vn[i2][2 * e + 1] = bfhi(un[2 * i2][e]); vn[i2][8 + 2 * e] = bflo(un[2 * i2 + 1][e]); vn[i2][8 + 2 * e + 1] = bfhi(un[2 * i2 + 1][e]); }
    }
    const float gl = gln;
    asm volatile("" : "+v"(vn[0]), "+v"(vn[1]));
    __builtin_amdgcn_sched_barrier(0);
    if (c + 1 < 128) { SCAN_WK(c + 1, (c + 1) & 1); SCAN_U(c + 1); }
    const char* lw = lds + (c & 1) * 32768 + lane * 16; const char* lk = lw + 16384;
    char* sco = scp + (size_t)c * 32768;
    bf16x8 Sb[4][2];
#pragma unroll
    for (int m = 0; m < 4; ++m) { Sb[m][0] = packS(S[m], 0); Sb[m][1] = packS(S[m], 1); *(bf16x8*)(sco + (m * 2 + 0) * 1024) = Sb[m][0]; *(bf16x8*)(sco + (m * 2 + 1) * 1024) = Sb[m][1]; }
#pragma unroll
    for (int mh = 0; mh < 2; ++mh) {
      bf16x8 f[8];
#pragma unroll
      for (int k = 0; k < 8; ++k) { const int i2 = k >> 2, m = 2 * mh + ((k >> 1) & 1), sx = k & 1; f[k] = *(const bf16x8*)(lw + ((i2 * 4 + m) * 2 + sx) * 1024); }
      __builtin_amdgcn_sched_barrier(0);
#pragma unroll
      for (int q = 0; q < 4; ++q) { const int m = 2 * mh + (q >> 1), sx = q & 1;
        vn[0] = MFMA32(f[q], Sb[m][sx], vn[0]); vn[1] = MFMA32(f[4 + q], Sb[m][sx], vn[1]); }
    }
    bf16x8 Vb[2][2];
#pragma unroll
    for (int j2 = 0; j2 < 2; ++j2) { Vb[j2][0] = packS(vn[j2], 0); Vb[j2][1] = packS(vn[j2], 1); }
#pragma unroll
    for (int m = 0; m < 4; ++m)
#pragma unroll
      for (int r = 0; r < 16; ++r) S[m][r] *= gl;
#pragma unroll
    for (int mh = 0; mh < 2; ++mh) {
      bf16x8 f[8];
#pragma unroll
      for (int k = 0; k < 8; ++k) { const int m = 2 * mh + (k >> 2), j2 = (k >> 1) & 1, sx = k & 1; f[k] = *(const bf16x8*)(lk + ((m * 2 + j2) * 2 + sx) * 1024); }
      __builtin_amdgcn_sched_barrier(0);
#pragma unroll
      for (int q = 0; q < 4; ++q) { const int j2 = q >> 1, sx = q & 1;
        S[2 * mh] = MFMA32(f[q], Vb[j2][sx], S[2 * mh]); S[2 * mh + 1] = MFMA32(f[4 + q], Vb[j2][sx], S[2 * mh + 1]); }
    }
  }
#undef SCAN_DMA
#undef SCAN_WK
#undef SCAN_U
  __syncthreads();
}
DI void gdn_out_unit(const Params& p, int U, char* lds) {
  const int tid = tidx(), lane = tid & 63, wv = tid >> 6, r32 = lane & 31, hi = lane >> 5;
  const int b = U >> 9, h = (U >> 7) & 3, c = U & 127;
  bf16_t* proj = (bf16_t*)(p.ws + WS_P);
  const char* wfg = (const char*)(p.ws + WS_WF) + (size_t)U * 16384 + lane * 16;
  const char* qfg = (const char*)p.out + (size_t)U * 16384 + lane * 16;
  const char* afg = (const char*)p.out + 64 * MiB + (size_t)U * 8192 + lane * 16;
  const bf16_t* UF = (const bf16_t*)(p.ws + WS_UF) + (size_t)U * 8192;
  const bf16x8* SC = (const bf16x8*)(p.ws + WS_SC + (size_t)U * 32768 + (size_t)wv * 8192) + lane;
  bf16_t* ol = (bf16_t*)(lds + 40960);
  __syncthreads();
#pragma unroll
  for (int i = 0; i < 4; ++i) {
    __builtin_amdgcn_global_load_lds((const unsigned*)(wfg + (4 * wv + i) * 1024), (LAS unsigned*)(lds + (4 * wv + i) * 1024), 16, 0, 0);
    __builtin_amdgcn_global_load_lds((const unsigned*)(qfg + (4 * wv + i) * 1024), (LAS unsigned*)(lds + 16384 + (4 * wv + i) * 1024), 16, 0, 0);
  }
#pragma unroll
  for (int i = 0; i < 2; ++i) __builtin_amdgcn_global_load_lds((const unsigned*)(afg + (2 * wv + i) * 1024), (LAS unsigned*)(lds + 32768 + (2 * wv + i) * 1024), 16, 0, 0);
  bf16x8 Sb[4][2];
#pragma unroll
  for (int m = 0; m < 4; ++m) { Sb[m][0] = SC[(m * 2 + 0) * 64]; Sb[m][1] = SC[(m * 2 + 1) * 64]; }
  u32x4 uu[4];
#pragma unroll
  for (int i2 = 0; i2 < 2; ++i2) { uu[2 * i2] = *(const u32x4*)(UF + (size_t)((i2 * 4 + wv) * 64 + lane) * 16); uu[2 * i2 + 1] = *(const u32x4*)(UF + (size_t)((i2 * 4 + wv) * 64 + lane) * 16 + 8); }
  __syncthreads();
  const char* lw = lds + lane * 16; const char* lq = lds + 16384 + lane * 16; const char* la = lds + 32768 + lane * 16;
  f32x16 vn[2], o[2];
#pragma unroll
  for (int i2 = 0; i2 < 2; ++i2) {
#pragma unroll
    for (int e = 0; e < 4; ++e) { vn[i2][2 * e] = bflo(uu[2 * i2][e]); vn[i2][2 * e + 1] = bfhi(uu[2 * i2][e]); vn[i2][8 + 2 * e] = bflo(uu[2 * i2 + 1][e]); vn[i2][8 + 2 * e + 1] = bfhi(uu[2 * i2 + 1][e]); }
#pragma unroll
    for (int r = 0; r < 16; ++r) o[i2][r] = 0.f;
#pragma unroll
    for (int m = 0; m < 4; ++m)
#pragma unroll
      for (int s = 0; s < 2; ++s) {
        vn[i2] = MFMA32(*(const bf16x8*)(lw + ((i2 * 4 + m) * 2 + s) * 1024), Sb[m][s], vn[i2]);
        o[i2] = MFMA32(*(const bf16x8*)(lq + ((i2 * 4 + m) * 2 + s) * 1024), Sb[m][s], o[i2]);
      }
  }
  bf16x8 Vb[2][2];
#pragma unroll
  for (int j2 = 0; j2 < 2; ++j2) { Vb[j2][0] = packS(vn[j2], 0); Vb[j2][1] = packS(vn[j2], 1); }
#pragma unroll
  for (int i2 = 0; i2 < 2; ++i2)
#pragma unroll
    for (int j2 = 0; j2 <= i2; ++j2)
#pragma unroll
      for (int s = 0; s < 2; ++s) o[i2] = MFMA32(*(const bf16x8*)(la + ((i2 * 2 + j2) * 2 + s) * 1024), Vb[j2][s], o[i2]);
  __syncthreads();
#pragma unroll
  for (int i2 = 0; i2 < 2; ++i2)
#pragma unroll
    for (int r = 0; r < 16; ++r) ol[(32 * i2 + crow(r, hi)) * 136 + 32 * wv + r32] = f2bf(o[i2][r]);
  __syncthreads();
  {
    const size_t t0 = (size_t)b * S_ + c * 64;
    const int row = tid >> 2, q4 = tid & 3;
    const bf16_t* gzp = proj + (t0 + row) * PP + 3072 + h * 128 + 32 * q4;
    bf16_t* op = proj + (t0 + row) * PP + 1536 + h * 128 + 32 * q4;
    float ss = 0.f;
#pragma unroll
    for (int q = 0; q < 4; ++q) { const u32x4 w = *(const u32x4*)(ol + row * 136 + 32 * q4 + 8 * q);
#pragma unroll
      for (int e = 0; e < 4; ++e) { const float a0 = bflo(w[e]), a1 = bfhi(w[e]); ss += a0 * a0 + a1 * a1; } }
    ss += __uint_as_float((unsigned)__builtin_amdgcn_update_dpp(0, (int)__float_as_uint(ss), 0xB1, 0xF, 0xF, true));
    ss += __uint_as_float((unsigned)__builtin_amdgcn_update_dpp(0, (int)__float_as_uint(ss), 0x4E, 0xF, 0xF, true));
    const float rstd = rsqrtf(ss * (1.f / 128.f) + 1e-6f);
#pragma unroll
    for (int q = 0; q < 4; ++q) {
      const u32x4 w = *(const u32x4*)(ol + row * 136 + 32 * q4 + 8 * q), gz = *(const u32x4*)(gzp + 8 * q);
      const f32x4 n0 = *(const f32x4*)(p.gdn_norm_w + 32 * q4 + 8 * q), n1 = *(const f32x4*)(p.gdn_norm_w + 32 * q4 + 8 * q + 4);
      float y[8];
#pragma unroll
      for (int e = 0; e < 4; ++e) { const float z0 = bflo(gz[e]), z1 = bfhi(gz[e]);
        const float g0 = (2 * e < 4) ? n0[(2 * e) & 3] : n1[(2 * e) & 3], g1 = (2 * e + 1 < 4) ? n0[(2 * e + 1) & 3] : n1[(2 * e + 1) & 3];
        y[2 * e] = bflo(w[e]) * rstd * g0 * (z0 * sigmoidf_(z0));
        y[2 * e + 1] = bfhi(w[e]) * rstd * g1 * (z1 * sigmoidf_(z1)); }
      u32x4 wv4 = {pk2(y[0], y[1]), pk2(y[2], y[3]), pk2(y[4], y[5]), pk2(y[6], y[7])};
      *(u32x4*)(op + 8 * q) = wv4;
    }
  }
}
DI void phase_gdnout2(const Params& p, int bid, int nb, char* lds) {
  for (int U = bid; U < 2048; U += nb) gdn_out_unit(p, U, lds);
}
DI void phase_gdnout(const Params& p, int bid, int nb) {
  const int lane = tidx() & 63, gw = bid * 4 + (tidx() >> 6), nw = nb * 4;
  bf16_t* proj = (bf16_t*)(p.ws + WS_P);
  const f32x4 w0 = *(const f32x4*)(p.gdn_norm_w + (lane & 15) * 8), w1 = *(const f32x4*)(p.gdn_norm_w + (lane & 15) * 8 + 4);
  for (int row = gw; row < T_; row += nw) {
    bf16_t* op = proj + (size_t)row * PP + 1536 + lane * 8;
    const u32x4 ov = *(const u32x4*)op, zv = *(const u32x4*)(proj + (size_t)row * PP + 3072 + lane * 8);
    float o[8], z[8];
#pragma unroll
    for (int e = 0; e < 4; ++e) { o[2 * e] = bflo(ov[e]); o[2 * e + 1] = bfhi(ov[e]); z[2 * e] = bflo(zv[e]); z[2 * e + 1] = bfhi(zv[e]); }
    float ss = 0.f;
#pragma unroll
    for (int e = 0; e < 8; ++e) ss += o[e] * o[e];
    ss += __shfl_xor(ss, 1); ss += __shfl_xor(ss, 2); ss += __shfl_xor(ss, 4); ss += __shfl_xor(ss, 8);
    const float rstd = rsqrtf(ss * (1.f / 128.f) + 1e-6f);
    float y[8];
#pragma unroll
    for (int e = 0; e < 8; ++e) { const float w = e < 4 ? w0[e] : w1[e - 4]; y[e] = o[e] * rstd * w * (z[e] * sigmoidf_(z[e])); }
    u32x4 r = {pk2(y[0], y[1]), pk2(y[2], y[3]), pk2(y[4], y[5]), pk2(y[6], y[7])};
    *(u32x4*)op = r;
  }
}

struct EpiMergeA {
  const bf16_t* proj; bf16_t* mp;
  DI void operator()(int row, int col, f32x4 v, f32x4 w) const {
    const u32x4 g = *(const u32x4*)(proj + (size_t)row * PP + 3584 + col);
    u32x4 o = {pk2(v[0] * bflo(g[0]), v[1] * bfhi(g[0])), pk2(v[2] * bflo(g[1]), v[3] * bfhi(g[1])), pk2(w[0] * bflo(g[2]), w[1] * bfhi(g[2])), pk2(w[2] * bflo(g[3]), w[3] * bfhi(g[3]))};
    *(u32x4*)(mp + (size_t)row * 1024 + col) = o;
  }
};
struct EpiMergeB {
  const bf16_t* __restrict__ proj; const bf16_t* __restrict__ mpi; bf16_t* __restrict__ mpo;
  DI void operator()(int row, int col, f32x4 v, f32x4 w) const {
    const u32x4 g = *(const u32x4*)(proj + (size_t)row * PP + 4608 + col);
    const u32x4 q = *(const u32x4*)(mpi + (size_t)row * 1024 + col);
    u32x4 o = {pk2(bflo(q[0]) + v[0] * bflo(g[0]), bfhi(q[0]) + v[1] * bfhi(g[0])), pk2(bflo(q[1]) + v[2] * bflo(g[1]), bfhi(q[1]) + v[3] * bfhi(g[1])),
               pk2(bflo(q[2]) + w[0] * bflo(g[2]), bfhi(q[2]) + w[1] * bfhi(g[2])), pk2(bflo(q[3]) + w[2] * bflo(g[3]), bfhi(q[3]) + w[3] * bfhi(g[3]))};
    *(u32x4*)(mpo + (size_t)row * 1024 + col) = o;
  }
};
struct EpiF32 { float* out; int ld; DI void operator()(int row, int col, f32x4 v, f32x4 w) const { *(f32x4*)(out + (size_t)row * ld + col) = v; *(f32x4*)(out + (size_t)row * ld + col + 4) = w; } };
struct EpiBf16 { bf16_t* out; int ld; DI void operator()(int row, int col, f32x4 v, f32x4 w) const { u32x4 o = {pk2(v[0], v[1]), pk2(v[2], v[3]), pk2(w[0], w[1]), pk2(w[2], w[3])}; *(u32x4*)(out + (size_t)row * ld + col) = o; } };
DI void phase_merge(const Params& p, int bid, int nb, char* lds) {
  const bf16_t* proj = (const bf16_t*)(p.ws + WS_P);
  GemmArgs ga = {proj, PP, (const bf16_t*)(p.ws + WS_WFO), 512, 512};
  GemmArgs gb = {proj + 1536, PP, (const bf16_t*)(p.ws + WS_WGO), 512, 512};
  EpiMergeA ea = {proj, (bf16_t*)(p.ws + WS_H)};
  EpiMergeB eb = {proj, (const bf16_t*)(p.ws + WS_H), (bf16_t*)(p.ws + WS_H)};
  TileMap tm; tm.init(bid, nb, 8); int m, n; while (tm.next(m, n)) { gemm_tile(ga, m * 256, n * 128, lds, ea); gemm_tile(gb, m * 256, n * 128, lds, eb); }
}
DI void phase_wout(const Params& p, int bid, int nb, char* lds) {
  GemmArgs g = {(const bf16_t*)(p.ws + WS_H), 1024, (const bf16_t*)(p.ws + WS_WOUT), 1024, 1024};
  EpiF32 e = {p.out, 1024};
  TileMap tm; tm.init(bid, nb, 8); int m, n; while (tm.next(m, n)) gemm_tile(g, m * 256, n * 128, lds, e);
}
DI void phase_rows1(const Params& p, int bid, int nb) {
  const int lane = tidx() & 63, gw = bid * 4 + (tidx() >> 6), nw = nb * 4;
  const float* mod = (const float*)(p.ws + WS_MOD);
  bf16_t* h2 = (bf16_t*)(p.ws + WS_H);
  for (int row0 = gw * 2; row0 < T_; row0 += nw * 2) {
    const int b = row0 >> 13;
    f32x4 v[2][4], xv[2][4];
#pragma unroll
    for (int r = 0; r < 2; ++r)
#pragma unroll
      for (int i = 0; i < 4; ++i) { v[r][i] = ((const f32x4*)(p.out + (size_t)(row0 + r) * 1024))[lane + 64 * i]; xv[r][i] = ((const f32x4*)(p.x + (size_t)(row0 + r) * 1024))[lane + 64 * i]; }
#pragma unroll
    for (int r = 0; r < 2; ++r) {
      f32x4* mr = (f32x4*)(p.out + (size_t)(row0 + r) * 1024);
      float ss = 0.f;
#pragma unroll
      for (int i = 0; i < 4; ++i) ss += v[r][i][0] * v[r][i][0] + v[r][i][1] * v[r][i][1] + v[r][i][2] * v[r][i][2] + v[r][i][3] * v[r][i][3];
      ss = wave_sum(ss);
      const float rstd = rsqrtf(ss * (1.f / 1024.f) + 1e-6f);
      float s2 = 0.f;
#pragma unroll
      for (int i = 0; i < 4; ++i) {
        const int col = 4 * lane + 256 * i;
        const f32x4 g4 = *(const f32x4*)(p.g_post_mix + col), gt = *(const f32x4*)(mod + b * 6144 + 2048 + col);
        v[r][i] = xv[r][i] + gt * (v[r][i] * rstd * g4);
        mr[lane + 64 * i] = v[r][i];
        s2 += v[r][i][0] * v[r][i][0] + v[r][i][1] * v[r][i][1] + v[r][i][2] * v[r][i][2] + v[r][i][3] * v[r][i][3];
      }
      s2 = wave_sum(s2);
      const float rstd2 = rsqrtf(s2 * (1.f / 1024.f) + 1e-6f);
#pragma unroll
      for (int i = 0; i < 4; ++i) {
        const int col = 4 * lane + 256 * i;
        const f32x4 g4 = *(const f32x4*)(p.g_pre_ffn + col), sh = *(const f32x4*)(mod + b * 6144 + 3072 + col), sc = *(const f32x4*)(mod + b * 6144 + 4096 + col);
        const f32x4 y = (v[r][i] * rstd2 * g4) * (1.f + sc) + sh;
        u32x2 o = {pk2(y[0], y[1]), pk2(y[2], y[3])};
        *(u32x2*)(h2 + (size_t)(row0 + r) * 1024 + col) = o;
      }
    }
  }
}

DI void phase_peerq(const Params& p, int bid, int nb, char* lds) {
  GemmArgs g = {(const bf16_t*)(p.ws + WS_H), 1024, (const bf16_t*)(p.ws + WS_WQ), 1024, 1024};
  EpiBf16 e = {(bf16_t*)(p.ws + WS_QY), 2048};
  TileMap tm; tm.init(bid, nb, 16); int m, n; while (tm.next(m, n)) gemm_tile(g, m * 256, n * 128, lds, e);
}
DI unsigned ordkey(float f) { const unsigned u = __float_as_uint(f); return (u & 0x80000000u) ? ~u : (u | 0x80000000u); }
#define CE_DESC(x, y) do { const unsigned mx_ = (x) > (y) ? (x) : (y); const unsigned mn_ = (x) > (y) ? (y) : (x); (x) = mx_; (y) = mn_; } while (0)
DI void sort16_desc(unsigned (&a)[16]) {
#pragma unroll
  for (int k = 2; k <= 16; k <<= 1)
#pragma unroll
    for (int j = k >> 1; j > 0; j >>= 1)
#pragma unroll
      for (int i = 0; i < 16; ++i) {
        const int l = i ^ j;
        if (l > i) { if ((i & k) == 0) CE_DESC(a[i], a[l]); else CE_DESC(a[l], a[i]); }
      }
}
DI void merge16_desc(unsigned (&a)[16], const unsigned (&b)[16]) {
#pragma unroll
  for (int i = 0; i < 16; ++i) a[i] = a[i] > b[15 - i] ? a[i] : b[15 - i];
#pragma unroll
  for (int j = 8; j > 0; j >>= 1)
#pragma unroll
    for (int i = 0; i < 16; ++i) if ((i & j) == 0) CE_DESC(a[i], a[i + j]);
}
template <int CTRL> DI void dpp16(unsigned (&b)[16], const unsigned (&a)[16]) {
#pragma unroll
  for (int s = 0; s < 16; ++s) b[s] = (unsigned)__builtin_amdgcn_update_dpp(0, (int)a[s], CTRL, 0xF, 0xF, true);
}
__device__ const unsigned char PEER_CAND[64] = {
  0x00, 0x01, 0x02, 0x03, 0x04, 0x05, 0x06, 0x07, 0x08, 0x09, 0x0A, 0x0B, 0x0C, 0x0D, 0x0E, 0x0F,
  0x10, 0x11, 0x12, 0x13, 0x14, 0x15, 0x16, 0x17, 0x20, 0x21, 0x22, 0x23, 0x24, 0x80, 0x90, 0xA0,
  0x30, 0x31, 0x32, 0x33, 0x40, 0x41, 0x42, 0x50, 0x51, 0x60, 0x61, 0x70, 0x71, 0xB0, 0xC0, 0xD0,
  0xE0, 0xF0, 0xFF, 0xFF, 0xFF, 0xFF, 0xFF, 0xFF, 0xFF, 0xFF, 0xFF, 0xFF, 0xFF, 0xFF, 0xFF, 0xFF};
DI void peer_select_unit(const Params& p, int unit, char* lds, const bf16x8 (&kb)[4][4]) {
  const int tid = tidx(), lane = tid & 63, wid = tid >> 6, fr = lane & 15, fq = lane >> 4;
  const int h = unit & 7, t0 = (unit >> 3) * 32;
  float* sc = (float*)lds;
  float* topv = (float*)(lds + 64 * 132 * 4);
  int* topi = (int*)(lds + 64 * 132 * 4 + 64 * 16 * 4);
  const bf16_t* qy = (const bf16_t*)(p.ws + WS_QY);
  const bf16_t* keys = (const bf16_t*)(p.ws + WS_KEYS);
  __syncthreads();
  {
    const int set = wid >> 1, kh = wid & 1;
    bf16x8 qa[2][4];
#pragma unroll
    for (int mt = 0; mt < 2; ++mt)
#pragma unroll
      for (int kk = 0; kk < 4; ++kk) qa[mt][kk] = *(const bf16x8*)(qy + (size_t)(t0 + 16 * mt + fr) * 2048 + h * 256 + set * 128 + kk * 32 + fq * 8);
#pragma unroll
    for (int mt = 0; mt < 2; ++mt)
#pragma unroll
      for (int nj = 0; nj < 4; ++nj) {
        f32x4 d = {0.f, 0.f, 0.f, 0.f};
#pragma unroll
        for (int kk = 0; kk < 4; ++kk) d = MFMA16(qa[mt][kk], kb[nj][kk], d);
#pragma unroll
        for (int r = 0; r < 4; ++r) sc[(set * 32 + 16 * mt + 4 * fq + r) * 132 + 64 * kh + 16 * nj + fr] = d[r];
      }
  }
  __syncthreads();
#pragma unroll 1
  for (int pass = 0; pass < 2; ++pass) {
    const int rr = pass * 32 + (tid >> 3), part = tid & 7;
    unsigned a[16], bq[16];
    const float* srow = sc + rr * 132 + 16 * part;
#pragma unroll
    for (int j = 0; j < 4; ++j) {
      const f32x4 v = *(const f32x4*)(srow + 4 * j);
#pragma unroll
      for (int e = 0; e < 4; ++e) a[4 * j + e] = (ordkey(v[e]) & ~127u) | (unsigned)(127 - (16 * part + 4 * j + e));
    }
    sort16_desc(a);
    dpp16<0xB1>(bq, a); merge16_desc(a, bq);
    dpp16<0x4E>(bq, a); merge16_desc(a, bq);
    dpp16<0x141>(bq, a); merge16_desc(a, bq);
#pragma unroll
    for (int s = 0; s < 2; ++s) {
      unsigned k = 0u;
#pragma unroll
      for (int q = 0; q < 8; ++q) k = part == q ? a[2 * q + s] : k;
      const int idx = 127 - (int)(k & 127u);
      topv[rr * 16 + 2 * part + s] = sc[rr * 132 + idx]; topi[rr * 16 + 2 * part + s] = idx;
    }
  }
  __syncthreads();
  if (tid < 128) {
    const int tok = tid >> 2, q4 = tid & 3;
    unsigned c[16], bq[16];
#pragma unroll
    for (int i = 0; i < 16; ++i) {
      const unsigned code = PEER_CAND[16 * q4 + i];
      const float v = topv[tok * 16 + ((code >> 4) & 15)] + topv[(32 + tok) * 16 + (code & 15)];
      c[i] = code == 0xFFu ? 0u : ((ordkey(v) & ~255u) | (255u - code));
    }
    sort16_desc(c);
    dpp16<0xB1>(bq, c); merge16_desc(c, bq);
    dpp16<0x4E>(bq, c); merge16_desc(c, bq);
    float mx; { const int pos = 255 - (int)(c[0] & 255u); mx = topv[tok * 16 + (pos >> 4)] + topv[(32 + tok) * 16 + (pos & 15)]; }
    float val[4]; int ei[4]; float part = 0.f;
#pragma unroll
    for (int s = 0; s < 4; ++s) {
      unsigned k = 0u;
#pragma unroll
      for (int q = 0; q < 4; ++q) k = q4 == q ? c[4 * q + s] : k;
      const int pos = 255 - (int)(k & 255u); const int a = pos >> 4, b = pos & 15;
      const float v = topv[tok * 16 + a] + topv[(32 + tok) * 16 + b]; ei[s] = topi[tok * 16 + a] * 128 + topi[(32 + tok) * 16 + b];
      val[s] = __expf(v - mx); part += val[s];
    }
    part += __uint_as_float((unsigned)__builtin_amdgcn_update_dpp(0, (int)__float_as_uint(part), 0xB1, 0xF, 0xF, true));
    part += __uint_as_float((unsigned)__builtin_amdgcn_update_dpp(0, (int)__float_as_uint(part), 0x4E, 0xF, 0xF, true));
    const float rt = 1.f / part;
    int* eo = (int*)(p.ws + WS_EIDX) + ((size_t)(t0 + tok) * 8 + h) * 16 + 4 * q4; float* go = (float*)(p.ws + WS_GATE) + ((size_t)(t0 + tok) * 8 + h) * 16 + 4 * q4;
    *(f32x4*)go = (f32x4){val[0] * rt, val[1] * rt, val[2] * rt, val[3] * rt};
    typedef int i32x4 __attribute__((ext_vector_type(4)));
    *(i32x4*)eo = (i32x4){ei[0], ei[1], ei[2], ei[3]};
  }
}
DI void phase_peersel(const Params& p, int bid, int nb, char* lds) {
  const int lane = tidx() & 63, wid = tidx() >> 6, fr = lane & 15, fq = lane >> 4;
  const bf16_t* keys = (const bf16_t*)(p.ws + WS_KEYS) + (wid >> 1) * 16384 + (wid & 1) * 64 * 128;
  bf16x8 kb[4][4];
#pragma unroll
  for (int nj = 0; nj < 4; ++nj)
#pragma unroll
    for (int kk = 0; kk < 4; ++kk) kb[nj][kk] = *(const bf16x8*)(keys + (16 * nj + fr) * 128 + kk * 32 + fq * 8);
  for (int u = bid; u < 8192; u += nb) peer_select_unit(p, u, lds, kb);
}
DI float dpp_sum8(float d) {
  d += __uint_as_float((unsigned)__builtin_amdgcn_update_dpp(0, (int)__float_as_uint(d), 0xB1, 0xF, 0xF, true));
  d += __uint_as_float((unsigned)__builtin_amdgcn_update_dpp(0, (int)__float_as_uint(d), 0x4E, 0xF, 0xF, true));
  d += __uint_as_float((unsigned)__builtin_amdgcn_update_dpp(0, (int)__float_as_uint(d), 0x141, 0xF, 0xF, true));
  return d;
}
DI void unpack8x2_fp8(const u32x4 w, f32x2 (&f)[8]) {
#pragma unroll
  for (int i = 0; i < 4; ++i) { f[2 * i] = __builtin_amdgcn_cvt_pk_f32_fp8((int)w[i], false); f[2 * i + 1] = __builtin_amdgcn_cvt_pk_f32_fp8((int)w[i], true); }
}
DI void unpack16_fp8(const u32x4 w, float (&f)[16]) {
#pragma unroll
  for (int i = 0; i < 4; ++i) { const f32x2 lo = __builtin_amdgcn_cvt_pk_f32_fp8((int)w[i], false), hi = __builtin_amdgcn_cvt_pk_f32_fp8((int)w[i], true); f[4 * i] = lo[0]; f[4 * i + 1] = lo[1]; f[4 * i + 2] = hi[0]; f[4 * i + 3] = hi[1]; }
}
typedef int i32x4_t __attribute__((ext_vector_type(4)));
DI void phase_peerdown(const Params& p, int bid, int nb) {
  const int lane = tidx() & 63, wid = tidx() >> 6, e8 = lane >> 3, c = lane & 7;
  const int x = bid & 7, gw = (bid >> 3) * 4 + wid, nw = (nb >> 3) * 4;
  const bf16_t* h2 = (const bf16_t*)(p.ws + WS_H) + 128 * x + 16 * c;
  const char* tab = p.ws + WS_PU + (size_t)x * 16384 * 128 + 16 * c;
  const int* eidx = (const int*)(p.ws + WS_EIDX) + 16 * e8;
  float* pd = (float*)(p.ws + WS_PD) + (size_t)x * T_ * 128 + 16 * e8 + c;
#define PD_IDX(t, E, H) do { _Pragma("unroll") for (int q = 0; q < 4; ++q) E[q] = *(const i32x4_t*)(eidx + (size_t)(t) * 128 + 4 * q); \
    H[0] = *(const u32x4*)(h2 + (size_t)(t) * 1024); H[1] = *(const u32x4*)(h2 + (size_t)(t) * 1024 + 8); } while (0)
#define PD_TAB(E, W) do { _Pragma("unroll") for (int q = 0; q < 16; ++q) W[q] = *(const u32x4*)(tab + (size_t)E[q >> 2][q & 3] * 128); } while (0)
#define PD_MATH(t, W, H) do { f32x2 hx[8]; \
    _Pragma("unroll") for (int e = 0; e < 4; ++e) { hx[e] = (f32x2){bflo(H[0][e]), bfhi(H[0][e])}; hx[4 + e] = (f32x2){bflo(H[1][e]), bfhi(H[1][e])}; } \
    float k0 = 0.f, k1 = 0.f; \
    _Pragma("unroll") for (int q = 0; q < 16; ++q) { f32x2 f[8]; unpack8x2_fp8(W[q], f); f32x2 d2 = f[0] * hx[0]; \
      _Pragma("unroll") for (int i = 1; i < 8; ++i) d2 = __builtin_elementwise_fma(f[i], hx[i], d2); \
      const float d = dpp_sum8(d2[0] + d2[1]); if (c == (q & 7)) { if (q < 8) k0 = d; else k1 = d; } } \
    pd[(size_t)(t) * 128] = k0; pd[(size_t)(t) * 128 + 8] = k1; } while (0)
  i32x4_t eA[4], eB[4]; u32x4 hA[2], hB[2], w[16];
  int t = gw; if (t >= T_) return;
  PD_IDX(t, eA, hA);
  for (;;) {
    PD_TAB(eA, w);
    const int t1 = t + nw; if (t1 < T_) PD_IDX(t1, eB, hB);
    PD_MATH(t, w, hA);
    if (t1 >= T_) break;
    PD_TAB(eB, w);
    const int t2 = t1 + nw; if (t2 < T_) PD_IDX(t2, eA, hA);
    PD_MATH(t1, w, hB);
    if (t2 >= T_) break;
    t = t2;
  }
#undef PD_IDX
#undef PD_TAB
#undef PD_MATH
}
DI void phase_peercoef(const Params& p, int bid, int nb) {
  const float* pd = (const float*)(p.ws + WS_PD);
  const int* eidx = (const int*)(p.ws + WS_EIDX); const float* gate = (const float*)(p.ws + WS_GATE);
  const float* uinv = (const float*)(p.ws + WS_UINV); const float* vinv = (const float*)(p.ws + WS_VINV);
  float* coef = (float*)(p.ws + WS_COEF);
  for (size_t i4 = ((size_t)bid * NT + tidx()) * 4; i4 < (size_t)T_ * 128; i4 += (size_t)nb * NT * 4) {
    f32x4 d = {0.f, 0.f, 0.f, 0.f};
#pragma unroll
    for (int x = 0; x < 8; ++x) d += *(const f32x4*)(pd + (size_t)x * T_ * 128 + i4);
    typedef int i32x4 __attribute__((ext_vector_type(4)));
    const i32x4 e = *(const i32x4*)(eidx + i4); const f32x4 g = *(const f32x4*)(gate + i4);
    f32x4 o;
#pragma unroll
    for (int k = 0; k < 4; ++k) { const float dk = d[k] * uinv[e[k]]; o[k] = g[k] * 0.5f * dk * (1.f + erff(dk * 0.70710678118654752f)) * vinv[e[k]]; }
    *(f32x4*)(coef + i4) = o;
  }
}
DI void phase_peerup(const Params& p, int bid, int nb) {
  const int lane = tidx() & 63, wid = tidx() >> 6, e8 = lane >> 3, c = lane & 7;
  const int x = bid & 7, gw = (bid >> 3) * 4 + wid, nw = (nb >> 3) * 4;
  const char* tab = p.ws + WS_PV + (size_t)x * 16384 * 128 + 16 * c;
  const int* eidx = (const int*)(p.ws + WS_EIDX) + 16 * e8; const float* coef = (const float*)(p.ws + WS_COEF) + 16 * e8;
  float* y2 = (float*)(p.ws + WS_Y2) + 128 * x + 16 * c; float* ssq = (float*)(p.ws + WS_SSQ) + (size_t)x * T_;
#define PU_IDX(t, E, C) do { _Pragma("unroll") for (int q = 0; q < 4; ++q) { E[q] = *(const i32x4_t*)(eidx + (size_t)(t) * 128 + 4 * q); C[q] = *(const f32x4*)(coef + (size_t)(t) * 128 + 4 * q); } } while (0)
#define PU_TAB(E, W) do { _Pragma("unroll") for (int q = 0; q < 16; ++q) W[q] = *(const u32x4*)(tab + (size_t)E[q >> 2][q & 3] * 128); } while (0)
#define PU_MATH(t, W, C) do { f32x2 yp[8]; \
    _Pragma("unroll") for (int i = 0; i < 8; ++i) yp[i] = (f32x2){0.f, 0.f}; \
    _Pragma("unroll") for (int q = 0; q < 16; ++q) { f32x2 f[8]; unpack8x2_fp8(W[q], f); const float cq = C[q >> 2][q & 3]; const f32x2 cc = {cq, cq}; \
      _Pragma("unroll") for (int i = 0; i < 8; ++i) yp[i] = __builtin_elementwise_fma(f[i], cc, yp[i]); } \
    float y[16]; float ss = 0.f; \
    _Pragma("unroll") for (int i = 0; i < 8; ++i) { y[2 * i] = yp[i][0]; y[2 * i + 1] = yp[i][1]; } \
    _Pragma("unroll") for (int i = 0; i < 16; ++i) { y[i] += __shfl_xor(y[i], 8); y[i] += __shfl_xor(y[i], 16); y[i] += __shfl_xor(y[i], 32); ss += y[i] * y[i]; } \
    ss = dpp_sum8(ss); \
    if (e8 == 0) { float* yo = y2 + (size_t)(t) * 1024; \
      _Pragma("unroll") for (int q = 0; q < 4; ++q) *(f32x4*)(yo + 4 * q) = (f32x4){y[4 * q], y[4 * q + 1], y[4 * q + 2], y[4 * q + 3]}; \
      if (c == 0) ssq[t] = ss; } } while (0)
  i32x4_t eA[4], eB[4]; f32x4 cA[4], cB[4]; u32x4 w[16];
  int t = gw; if (t >= T_) return;
  PU_IDX(t, eA, cA);
  for (;;) {
    PU_TAB(eA, w);
    const int t1 = t + nw; if (t1 < T_) PU_IDX(t1, eB, cB);
    PU_MATH(t, w, cA);
    if (t1 >= T_) break;
    PU_TAB(eB, w);
    const int t2 = t1 + nw; if (t2 < T_) PU_IDX(t2, eA, cA);
    PU_MATH(t1, w, cB);
    if (t2 >= T_) break;
    t = t2;
  }
#undef PU_IDX
#undef PU_TAB
#undef PU_MATH
}
DI void phase_final(const Params& p, int bid, int nb) {
  const int lane = tidx() & 63, gw = bid * 4 + (tidx() >> 6), nw = nb * 4;
  const float* mod = (const float*)(p.ws + WS_MOD);
  const float* y2 = (const float*)(p.ws + WS_Y2); const float* ssq = (const float*)(p.ws + WS_SSQ);
  for (int row0 = gw * 2; row0 < T_; row0 += nw * 2) {
    const int b = row0 >> 13;
    f32x4 ov[2][4], yv[2][4]; float ss[2] = {0.f, 0.f};
#pragma unroll
    for (int r = 0; r < 2; ++r) {
#pragma unroll
      for (int i = 0; i < 4; ++i) { ov[r][i] = ((const f32x4*)(p.out + (size_t)(row0 + r) * 1024))[lane + 64 * i]; yv[r][i] = ((const f32x4*)(y2 + (size_t)(row0 + r) * 1024))[lane + 64 * i]; }
#pragma unroll
      for (int x = 0; x < 8; ++x) ss[r] += ssq[(size_t)x * T_ + row0 + r];
    }
#pragma unroll
    for (int r = 0; r < 2; ++r) {
      const float rstd = rsqrtf(ss[r] * (1.f / 1024.f) + 1e-6f);
      f32x4* orow = (f32x4*)(p.out + (size_t)(row0 + r) * 1024);
#pragma unroll
      for (int i = 0; i < 4; ++i) {
        const int col = 4 * lane + 256 * i;
        const f32x4 g4 = *(const f32x4*)(p.g_post_ffn + col), gt = *(const f32x4*)(mod + b * 6144 + 5120 + col);
        orow[lane + 64 * i] = ov[r][i] + gt * (yv[r][i] * rstd * g4);
      }
    }
  }
}

namespace cg = cooperative_groups;
constexpr int LDS_BYTES = 75776;
DI void phase_mixer(const Params& p, int bid, int nb, char* lds) {
  if (bid < 16) gdn_scan_seq(p, bid, lds);
  unsigned* ctr = (unsigned*)(p.ws + WS_CTL);
  int* slot = (int*)(lds + LDS_BYTES - 16);
  for (;;) {
    __syncthreads();
    if (tidx() == 0) *slot = (int)atomicAdd(ctr, 1u);
    __syncthreads();
    const int u = *slot;
    if (u >= 2048) break;
    attn_unit(p, u & 31, 63 - (u >> 5), lds);
  }
}
#define XB_TMO      128
#define XB_XCNT(j)  (256  + 64 * (j))
#define XB_XSUB(j)  (1280 + 64 * (j))
#define XB_XGEN(j)  (2304 + 64 * (j))
#define XB_TOP      3328
#define XB_TOPGEN   3392
#define XCD_BAR_WORDS 3456
#define XB_SPIN_CAP (1u << 22)
DI unsigned xb_ld(unsigned* p)              { return __hip_atomic_load(p, __ATOMIC_RELAXED, __HIP_MEMORY_SCOPE_AGENT); }
DI unsigned xb_add(unsigned* p, unsigned v) { return __hip_atomic_fetch_add(p, v, __ATOMIC_RELAXED, __HIP_MEMORY_SCOPE_AGENT); }
DI unsigned xb_xcc_id() { return (unsigned)__builtin_amdgcn_s_getreg((3 << 11) | 20) & 0xFu; }
#define XB_SPIN(cond, bar) do { unsigned _sp = 0; while (cond) { __builtin_amdgcn_s_sleep(1); \
    if ((++_sp & 255u) == 0u) { if (xb_ld(&(bar)[XB_TMO])) break; if (_sp > XB_SPIN_CAP) { atomicAdd(&(bar)[XB_TMO], 1u); break; } } } } while (0)
struct XcdBarrier { unsigned* bar; unsigned x; volatile LAS unsigned* st; };
DI XcdBarrier xcd_barrier_post(unsigned* bar, volatile LAS unsigned* st) {
  XcdBarrier b; b.bar = bar; b.x = xb_xcc_id(); b.st = st;
  if (threadIdx.x == 0) (void)xb_add(&bar[XB_XCNT(b.x)], 1u);
  return b;
}
DI void xcd_barrier_complete(unsigned* bar, unsigned x, unsigned& nloc, unsigned& nx) {
  const unsigned G = gridDim.x * gridDim.y * gridDim.z;
  unsigned sum, cnt, mine, sp = 0u;
  for (;;) {
    sum = 0u; cnt = 0u; mine = 0u;
#pragma unroll
    for (unsigned j = 0; j < 16; ++j) { const unsigned c = xb_ld(&bar[XB_XCNT(j)]); sum += c; cnt += (c > 0u) ? 1u : 0u; mine = (j == x) ? c : mine; }
    if (sum == G) break;
    __builtin_amdgcn_s_sleep(1);
    if ((++sp & 255u) == 0u) { if (xb_ld(&bar[XB_TMO])) break; if (sp > XB_SPIN_CAP) { atomicAdd(&bar[XB_TMO], 1u); break; } }
  }
  nloc = mine > 0u ? mine : 1u; nx = cnt > 0u ? cnt : 1u;
}
DI void xcd_barrier(const XcdBarrier& b) {
  asm volatile("s_waitcnt vmcnt(0)" ::: "memory");
  __syncthreads();
  if (threadIdx.x == 0) {
    unsigned* bar = b.bar;
    __builtin_amdgcn_s_waitcnt(0);
    unsigned nloc = b.st[0], nx = b.st[1];
    if (nloc == 0u) { xcd_barrier_complete(bar, b.x, nloc, nx); b.st[0] = nloc; b.st[1] = nx; }
    const unsigned old = xb_add(&bar[XB_XSUB(b.x)], 1u);
    const unsigned gen = old / nloc;
    if (old + 1u == (gen + 1u) * nloc) {
      __builtin_amdgcn_fence(__ATOMIC_RELEASE, "agent");
      asm volatile("s_waitcnt vmcnt(0)" ::: "memory");
      const unsigned og = xb_add(&bar[XB_TOP], 1u);
      const unsigned tg = og / nx;
      if (og + 1u == (tg + 1u) * nx) xb_add(&bar[XB_TOPGEN], 1u);
      else XB_SPIN(xb_ld(&bar[XB_TOPGEN]) == tg, bar);
      __builtin_amdgcn_fence(__ATOMIC_ACQUIRE, "agent");
      xb_add(&bar[XB_XGEN(b.x)], 1u);
      asm volatile("s_waitcnt vmcnt(0)" ::: "memory");
    } else {
      XB_SPIN(xb_ld(&bar[XB_XGEN(b.x)]) == gen, bar);
      __builtin_amdgcn_fence(__ATOMIC_ACQUIRE, "agent");
      asm volatile("s_waitcnt vmcnt(0)" ::: "memory");
    }
  }
  __syncthreads();
}

#ifndef PROBE_PHASE
#define PROBE_PHASE -1
#endif
__global__ void __launch_bounds__(NT, 2) fwd(Params p) {
  extern __shared__ __attribute__((aligned(16))) char lds[];
  cg::grid_group grid = cg::this_grid();
  const int bid = blockIdx.x, nb = gridDim.x;
  unsigned long long tprev = 0, tprobe = 0; int nph = 0;
  volatile LAS unsigned* xst = (volatile LAS unsigned*)(lds + LDS_BYTES - 12);
  if (threadIdx.x == 0) { xst[0] = 0u; xst[1] = 0u; }
  unsigned* xbar = (unsigned*)(p.ws + WS_CTL) + 1024;
  if (p.ws == nullptr) grid.sync();
  XcdBarrier xb = xcd_barrier_post(xbar, xst);
#define SEAM() do { xcd_barrier(xb); \
    if (PROBE_PHASE >= 0) { const unsigned long long tn = __builtin_amdgcn_s_memrealtime(); if (nph == PROBE_PHASE) tprobe = tn - tprev; tprev = tn; ++nph; } } while (0)
  if (PROBE_PHASE >= 0) tprev = __builtin_amdgcn_s_memrealtime();
  phase_mod(p, bid, nb, lds); phase_wconv(p, bid, nb, lds);
  SEAM();
  phase_xnorm(p, bid, nb);
  SEAM();
  phase_inproj(p, bid, nb, lds);
  SEAM();
  if (bid < 32) phase_foxcum(p, bid, 32, lds);
  phase_qknorm(p, bid, nb);
  phase_gdnprep(p, bid, nb, lds);
  SEAM();
  phase_mixer(p, bid, nb, lds);
  SEAM();
  phase_gdnout2(p, bid, nb, lds);
  SEAM();
  phase_merge(p, bid, nb, lds);
  SEAM();
  phase_wout(p, bid, nb, lds); phase_tabconv(p, bid, nb);
  SEAM();
  phase_rows1(p, bid, nb);
  SEAM();
  phase_peerq(p, bid, nb, lds);
  SEAM();
  phase_peersel(p, bid, nb, lds);
  SEAM();
  phase_peerdown(p, bid, nb);
  SEAM();
  phase_peercoef(p, bid, nb);
  SEAM();
  phase_peerup(p, bid, nb);
  SEAM();
  phase_final(p, bid, nb);
  if (PROBE_PHASE >= 0) {
    if (PROBE_PHASE == nph) { xcd_barrier(xb); tprobe = __builtin_amdgcn_s_memrealtime() - tprev; }
    if (bid == 0 && tidx() == 0) { const unsigned long long t0 = __builtin_amdgcn_s_memrealtime(); while (__builtin_amdgcn_s_memrealtime() - t0 < tprobe) __builtin_amdgcn_s_sleep(8); }
  }
}

extern "C" void kernel_launch(void* const* d_in, const int* in_sizes, int n_in, void* d_out, int out_size, void* d_ws, size_t ws_size, hipStream_t stream) {
  static int grid_blocks = 0;
  if (!grid_blocks) {
    int dev = 0, cus = 0, per_cu = 0;
    hipGetDevice(&dev);
    hipDeviceGetAttribute(&cus, hipDeviceAttributeMultiprocessorCount, dev);
    (void)hipFuncSetAttribute((const void*)fwd, hipFuncAttributeMaxDynamicSharedMemorySize, LDS_BYTES);
    hipOccupancyMaxActiveBlocksPerMultiprocessor(&per_cu, (const void*)fwd, NT, LDS_BYTES);
    if (per_cu < 1) per_cu = 1;
    if (per_cu > 2) per_cu = 2;
    grid_blocks = cus * per_cu;
  }
  Params p{};
  const float** f = (const float**)&p;
  for (int i = 0; i < 23; ++i) f[i] = (const float*)d_in[i];
  p.out = (float*)d_out; p.ws = (char*)d_ws;
  (void)hipMemsetAsync((char*)d_ws + WS_CTL, 0, 65536, stream);
  void* args[] = {&p};
  hipError_t e = hipLaunchCooperativeKernel((const void*)fwd, dim3(grid_blocks), dim3(NT), args, LDS_BYTES, stream);
  if (e != hipSuccess) fprintf(stderr, "cooperative launch failed: %s (grid %d)\n", hipGetErrorString(e), grid_blocks);
}
```
